# Optimizing an MI355X kernel written in HIP

```python
import functools
import jax, jax.numpy as jnp
from jax import lax
import numpy as np

D_MODEL = 2048
BATCH = 4
SEQ = 2048
DEPTH = 4
DEC_BATCH = 8
DEC_SEQ = 1
PAST_LEN = 16384
PAGE_SIZE = 128

HEAD_DIM = 64
ATT_W = D_MODEL // 4
RWKV_W = (3 * D_MODEL) // 8
CONV_W = D_MODEL - ATT_W - RWKV_W
ATT_HEADS = ATT_W // HEAD_DIM
RWKV_HEADS = RWKV_W // HEAD_DIM
W_LORA = 64
A_LORA = 64
G_LORA = 128
RWKV_PROJ = 3 * RWKV_W + W_LORA + A_LORA + G_LORA
MIX_PROJ = 3 * ATT_W + RWKV_PROJ + 3 * CONV_W
D_FF = ((8 * D_MODEL) // 3 + 255) // 256 * 256
CONV_K = 3
DILATION_GROUPS = ((128, 1), (512, 4), (2048, 16))
SWA_BUF = 2048
NORM_EPS = 1e-6
RWKV_GN_EPS = 64e-5

kernel_name = "hybrid_rwkv7_dilated_swa_shortconv_step"


def rms_norm(x, g):
    xf = x.astype(jnp.float32)
    xf = xf * lax.rsqrt(jnp.mean(xf * xf, axis=-1, keepdims=True) + NORM_EPS)
    return (xf * g.astype(jnp.float32)).astype(x.dtype)


def swiglu(h, w_gate, w_up, w_down):
    return (jax.nn.silu(h @ w_gate) * (h @ w_up)) @ w_down


def alibi_slopes():
    return 2.0 ** (-8.0 * jnp.arange(1, ATT_HEADS + 1, dtype=jnp.float32) / ATT_HEADS)


def dilated_group_prompt(q, k, v, window, dil, slopes):
    n, t, nh, e = q.shape
    span = window // dil
    sub = t // dil
    nb = -(-sub // span)
    sub_p = nb * span

    def to_blocks(a):
        a = a.reshape(n, sub, dil, nh, e).transpose(0, 2, 1, 3, 4)
        a = jnp.pad(a, ((0, 0), (0, 0), (0, sub_p - sub), (0, 0), (0, 0)))
        return a.reshape(n, dil, nb, span, nh, e)

    def with_prev_block(a):
        prev = jnp.pad(a, ((0, 0), (0, 0), (1, 0), (0, 0), (0, 0), (0, 0)))[:, :, :-1]
        return jnp.concatenate([prev, a], axis=3)

    qb = to_blocks(q)
    kb = with_prev_block(to_blocks(k))
    vb = with_prev_block(to_blocks(v))
    s = jnp.einsum('nrbqhe,nrbkhe->nrbhqk', qb, kb,
                   preferred_element_type=jnp.float32) * (HEAD_DIM ** -0.5)
    qi = jnp.arange(span)[:, None]
    ki = jnp.arange(2 * span)[None, :]
    steps = qi + span - ki
    key_sub = jnp.arange(nb)[:, None, None] * span + ki[None] - span
    valid = (steps >= 0) & (steps <= span) & (key_sub >= 0)
    s = s - slopes[:, None, None] * (dil * steps).astype(jnp.float32)
    s = jnp.where(valid[None, None, :, None], s, -jnp.inf)
    lse = jax.nn.logsumexp(s, axis=-1)
    p = jnp.exp(s - lse[..., None]).astype(v.dtype)
    o = jnp.einsum('nrbhqk,nrbkhe->nrbqhe', p, vb)
    o = o.reshape(n, dil, sub_p, nh, e)[:, :, :sub].transpose(0, 2, 1, 3, 4).reshape(n, t, nh, e)
    lse = lse.transpose(0, 1, 2, 4, 3).reshape(n, dil, sub_p, nh)[:, :, :sub]
    lse = lse.transpose(0, 2, 1, 3).reshape(n, t, nh)
    return o, lse


def dilated_group_sample(q, k_all, v_all, past, window, dil, slopes):
    tn = q.shape[1]
    span = window // dil
    j = jnp.arange(span + 1)
    idx = past + jnp.arange(tn)[:, None] - dil * j[None, :]
    valid = idx >= 0
    idx = jnp.maximum(idx, 0)
    kg = k_all[:, idx]
    vg = v_all[:, idx]
    s = jnp.einsum('nqhe,nqjhe->nqhj', q, kg,
                   preferred_element_type=jnp.float32) * (HEAD_DIM ** -0.5)
    s = s - slopes[:, None] * (dil * j).astype(jnp.float32)[None, :]
    s = jnp.where(valid[None, :, None, :], s, -jnp.inf)
    lse = jax.nn.logsumexp(s, axis=-1)
    p = jnp.exp(s - lse[..., None]).astype(v_all.dtype)
    o = jnp.einsum('nqhj,nqjhe->nqhe', p, vg)
    return o, lse


def merge_groups(outs, lses):
    wts = jax.nn.softmax(jnp.stack(lses, axis=-1), axis=-1)
    o = outs[0].astype(jnp.float32) * wts[..., 0:1]
    for g in range(1, len(outs)):
        o = o + outs[g].astype(jnp.float32) * wts[..., g:g + 1]
    return o.astype(outs[0].dtype)


def attend_prompt(q, k, v):
    slopes = alibi_slopes()
    outs, lses = [], []
    for window, dil in DILATION_GROUPS:
        o, l = dilated_group_prompt(q, k, v, window, dil, slopes)
        outs.append(o)
        lses.append(l)
    keep = min(SWA_BUF, q.shape[1])
    return merge_groups(outs, lses), k[:, -keep:], v[:, -keep:]


def attend_sample(q, k, v, buf_k, buf_v):
    slopes = alibi_slopes()
    past = buf_k.shape[1]
    k_all = jnp.concatenate([buf_k.astype(k.dtype), k], axis=1)
    v_all = jnp.concatenate([buf_v.astype(v.dtype), v], axis=1)
    outs, lses = [], []
    for window, dil in DILATION_GROUPS:
        o, l = dilated_group_sample(q, k_all, v_all, past, window, dil, slopes)
        outs.append(o)
        lses.append(l)
    return merge_groups(outs, lses), k, v


def wkv7_scan(s0, r, w, k, v, a, b):
    def step(s, inp):
        r_t, w_t, k_t, v_t, a_t, b_t = inp
        sa = jnp.einsum('nhvk,nhk->nhv', s, a_t)
        s = s * w_t[:, :, None, :] + sa[..., None] * b_t[:, :, None, :] + v_t[..., None] * k_t[:, :, None, :]
        return s, jnp.einsum('nhvk,nhk->nhv', s, r_t)
    xs = tuple(jnp.moveaxis(z, 1, 0) for z in (r, w, k, v, a, b))
    s, ys = lax.scan(step, s0, xs)
    return jnp.moveaxis(ys, 0, 1), s


def token_mixers(h, lp, shift_prev, wkv0, conv_prev, attend):
    n, t, _ = h.shape
    f32 = jnp.float32
    p = h @ lp['w_in']
    o1 = 3 * ATT_W
    o2 = o1 + RWKV_PROJ
    p_att, p_rwkv, p_conv = p[..., :o1], p[..., o1:o2], p[..., o2:]

    ah = (n, t, ATT_HEADS, HEAD_DIM)
    q = rms_norm(p_att[..., :ATT_W].reshape(ah), lp['q_norm'])
    k = rms_norm(p_att[..., ATT_W:2 * ATT_W].reshape(ah), lp['k_norm'])
    v = p_att[..., 2 * ATT_W:].reshape(ah)
    o_att, k_rows, v_rows = attend(q, k, v)

    prev = jnp.concatenate([shift_prev[:, None, :].astype(p_rwkv.dtype), p_rwkv[:, :-1]], axis=1)
    xm = p_rwkv + (prev - p_rwkv) * lp['rwkv_mu']
    c1, c2, c3 = RWKV_W, 2 * RWKV_W, 3 * RWKV_W
    r = xm[..., :c1]
    kr = xm[..., c1:c2]
    vr = xm[..., c2:c3]
    wl = xm[..., c3:c3 + W_LORA]
    al = xm[..., c3 + W_LORA:c3 + W_LORA + A_LORA]
    gl = xm[..., c3 + W_LORA + A_LORA:]
    w_log = -jax.nn.softplus(-(lp['rwkv_w0'] + jnp.tanh(wl) @ lp['rwkv_w2']).astype(f32)) - 0.5
    decay = jnp.exp(-jnp.exp(w_log))
    a = jax.nn.sigmoid((lp['rwkv_a0'] + al @ lp['rwkv_a2']).astype(f32))
    g = (jax.nn.sigmoid(gl) @ lp['rwkv_g2']).astype(f32)
    rh = (n, t, RWKV_HEADS, HEAD_DIM)
    krf = kr.astype(f32)
    kk = (krf * lp['rwkv_k_k']).reshape(rh)
    kk = kk / jnp.maximum(jnp.sqrt(jnp.sum(kk * kk, axis=-1, keepdims=True)), 1e-12)
    kmod = (krf * (1.0 + (a - 1.0) * lp['rwkv_k_a'])).reshape(rh)
    rf = r.astype(f32).reshape(rh)
    vf = vr.astype(f32).reshape(rh)
    y, wkv_new = wkv7_scan(wkv0.astype(f32), rf, decay.reshape(rh), kmod, vf, -kk, kk * a.reshape(rh))
    mu_y = jnp.mean(y, axis=-1, keepdims=True)
    var_y = jnp.mean(jnp.square(y - mu_y), axis=-1, keepdims=True)
    y = ((y - mu_y) * lax.rsqrt(var_y + RWKV_GN_EPS)).reshape(n, t, RWKV_W)
    y = y * lp['rwkv_ln_w'] + lp['rwkv_ln_b']
    bonus = jnp.sum(rf * kmod * lp['rwkv_r_k'], axis=-1, keepdims=True) * vf
    y_rwkv = ((y + bonus.reshape(n, t, RWKV_W)) * g).astype(h.dtype)
    shift_new = p_rwkv[:, -1]

    u = p_conv[..., :CONV_W]
    gate_b = p_conv[..., CONV_W:2 * CONV_W]
    gate_c = p_conv[..., 2 * CONV_W:]
    z = gate_c * u
    zc = jnp.concatenate([conv_prev.astype(z.dtype), z], axis=1)
    yc = lp['conv_b']
    for i in range(CONV_K):
        yc = yc + lp['conv_w'][i] * zc[:, i:i + t]
    y_conv = gate_b * yc
    conv_new = zc[:, -(CONV_K - 1):]

    mix = jnp.concatenate([o_att.reshape(n, t, ATT_W), y_rwkv, y_conv.astype(h.dtype)], axis=-1) @ lp['w_out']
    return mix, (k_rows, v_rows, wkv_new, shift_new, conv_new)


def trunk_layer(x, lp, shift_prev, wkv0, conv_prev, attend):
    x = x + 0.5 * swiglu(rms_norm(x, lp['ffn1_norm']), lp['ffn1_w_gate'], lp['ffn1_w_up'], lp['ffn1_w_down'])
    mix, new_state = token_mixers(rms_norm(x, lp['mix_norm']), lp, shift_prev, wkv0, conv_prev, attend)
    x = x + mix
    x = x + 0.5 * swiglu(rms_norm(x, lp['ffn2_norm']), lp['ffn2_w_gate'], lp['ffn2_w_up'], lp['ffn2_w_down'])
    return x, new_state


def setup_inputs(seed: int = 0) -> dict:
    key = jax.random.key(seed)
    keys = iter(jax.random.split(key, 40))
    f32 = jnp.float32

    def nrm(shape, scale=1.0):
        return scale * jax.random.normal(next(keys), shape, f32)

    def gain(shape):
        return 1.0 + 0.02 * jax.random.normal(next(keys), shape, f32)

    def unif(shape, lo, hi):
        return jax.random.uniform(next(keys), shape, f32, lo, hi)

    swa_len = min(SWA_BUF, PAST_LEN)
    return {
        'x_prompt': nrm((BATCH, SEQ, D_MODEL)),
        'x_sample': nrm((DEC_BATCH, DEC_SEQ, D_MODEL)),
        'cache_swa_k': nrm((DEPTH, DEC_BATCH, swa_len, ATT_HEADS, HEAD_DIM)),
        'cache_swa_v': nrm((DEPTH, DEC_BATCH, swa_len, ATT_HEADS, HEAD_DIM)),
        'state_wkv': nrm((DEPTH, DEC_BATCH, RWKV_HEADS, HEAD_DIM, HEAD_DIM), 0.3),
        'state_shift': nrm((DEPTH, DEC_BATCH, RWKV_PROJ)),
        'state_conv': nrm((DEPTH, DEC_BATCH, CONV_K - 1, CONV_W)),
        'ffn1_norm': gain((DEPTH, D_MODEL)),
        'ffn1_w_gate': nrm((DEPTH, D_MODEL, D_FF), D_MODEL ** -0.5),
        'ffn1_w_up': nrm((DEPTH, D_MODEL, D_FF), D_MODEL ** -0.5),
        'ffn1_w_down': nrm((DEPTH, D_FF, D_MODEL), D_FF ** -0.5),
        'mix_norm': gain((DEPTH, D_MODEL)),
        'w_in': nrm((DEPTH, D_MODEL, MIX_PROJ), D_MODEL ** -0.5),
        'q_norm': gain((DEPTH, HEAD_DIM)),
        'k_norm': gain((DEPTH, HEAD_DIM)),
        'rwkv_mu': unif((DEPTH, RWKV_PROJ), 0.0, 1.0),
        'rwkv_w0': unif((DEPTH, RWKV_W), -6.0, 1.0),
        'rwkv_w2': nrm((DEPTH, W_LORA, RWKV_W), 0.5 * W_LORA ** -0.5),
        'rwkv_a0': nrm((DEPTH, RWKV_W), 0.5),
        'rwkv_a2': nrm((DEPTH, A_LORA, RWKV_W), A_LORA ** -0.5),
        'rwkv_g2': nrm((DEPTH, G_LORA, RWKV_W), G_LORA ** -0.5),
        'rwkv_k_k': 0.85 + nrm((DEPTH, RWKV_W), 0.05),
        'rwkv_k_a': 1.0 + nrm((DEPTH, RWKV_W), 0.05),
        'rwkv_r_k': nrm((DEPTH, RWKV_HEADS, HEAD_DIM), 0.1),
        'rwkv_ln_w': gain((DEPTH, RWKV_W)),
        'rwkv_ln_b': nrm((DEPTH, RWKV_W), 0.02),
        'conv_w': nrm((DEPTH, CONV_K, CONV_W), CONV_K ** -0.5),
        'conv_b': nrm((DEPTH, CONV_W), 0.02),
        'w_out': nrm((DEPTH, D_MODEL, D_MODEL), D_MODEL ** -0.5),
        'ffn2_norm': gain((DEPTH, D_MODEL)),
        'ffn2_w_gate': nrm((DEPTH, D_MODEL, D_FF), D_MODEL ** -0.5),
        'ffn2_w_up': nrm((DEPTH, D_MODEL, D_FF), D_MODEL ** -0.5),
        'ffn2_w_down': nrm((DEPTH, D_FF, D_MODEL), D_FF ** -0.5),
    }


def reference(x_prompt, x_sample, cache_swa_k, cache_swa_v, state_wkv, state_shift, state_conv,
              ffn1_norm, ffn1_w_gate, ffn1_w_up, ffn1_w_down, mix_norm, w_in, q_norm, k_norm,
              rwkv_mu, rwkv_w0, rwkv_w2, rwkv_a0, rwkv_a2, rwkv_g2, rwkv_k_k, rwkv_k_a, rwkv_r_k,
              rwkv_ln_w, rwkv_ln_b, conv_w, conv_b, w_out,
              ffn2_norm, ffn2_w_gate, ffn2_w_up, ffn2_w_down):
    xp, xs = x_prompt, x_sample
    n_p = xp.shape[0]
    p_states, s_states = [], []
    for l in range(DEPTH):
        lp = {
            'ffn1_norm': ffn1_norm[l], 'ffn1_w_gate': ffn1_w_gate[l], 'ffn1_w_up': ffn1_w_up[l],
            'ffn1_w_down': ffn1_w_down[l], 'mix_norm': mix_norm[l], 'w_in': w_in[l],
            'q_norm': q_norm[l], 'k_norm': k_norm[l], 'rwkv_mu': rwkv_mu[l], 'rwkv_w0': rwkv_w0[l],
            'rwkv_w2': rwkv_w2[l], 'rwkv_a0': rwkv_a0[l], 'rwkv_a2': rwkv_a2[l], 'rwkv_g2': rwkv_g2[l],
            'rwkv_k_k': rwkv_k_k[l], 'rwkv_k_a': rwkv_k_a[l], 'rwkv_r_k': rwkv_r_k[l],
            'rwkv_ln_w': rwkv_ln_w[l], 'rwkv_ln_b': rwkv_ln_b[l], 'conv_w': conv_w[l],
            'conv_b': conv_b[l], 'w_out': w_out[l], 'ffn2_norm': ffn2_norm[l],
            'ffn2_w_gate': ffn2_w_gate[l], 'ffn2_w_up': ffn2_w_up[l], 'ffn2_w_down': ffn2_w_down[l],
        }
        xp, st_p = trunk_layer(xp, lp,
                               jnp.zeros((n_p, RWKV_PROJ), xp.dtype),
                               jnp.zeros((n_p, RWKV_HEADS, HEAD_DIM, HEAD_DIM), jnp.float32),
                               jnp.zeros((n_p, CONV_K - 1, CONV_W), xp.dtype),
                               attend_prompt)
        p_states.append(st_p)
        xs, st_s = trunk_layer(xs, lp, state_shift[l], state_wkv[l], state_conv[l],
                               functools.partial(attend_sample, buf_k=cache_swa_k[l], buf_v=cache_swa_v[l]))
        s_states.append(st_s)

    def stacked(states, i):
        return jnp.stack([st[i] for st in states], axis=0)

    prompt_swa_k = stacked(p_states, 0)
    prompt_swa_v = stacked(p_states, 1)
    prompt_wkv = stacked(p_states, 2)
    prompt_shift = stacked(p_states, 3)
    prompt_conv = stacked(p_states, 4)
    sample_swa_k = stacked(s_states, 0)
    sample_swa_v = stacked(s_states, 1)
    sample_wkv = stacked(s_states, 2)
    sample_shift = stacked(s_states, 3)
    sample_conv = stacked(s_states, 4)
    return (xp, xs, prompt_swa_k, prompt_swa_v, prompt_wkv, prompt_shift, prompt_conv,
            sample_swa_k, sample_swa_v, sample_wkv, sample_shift, sample_conv)
```

```cpp
#include <hip/hip_runtime.h>
#include <cstdio>
#include <cstdint>
#include <cmath>
namespace nv {
constexpr int D = 2048, NB = 4, T = 2048, MP = NB * T, NS = 8, R = MP + NS, L = 4;
constexpr int HD = 64, AW = 512, AH = 8, RW = 768, RH = 12, CW = 768;
constexpr int RP = 2560, MIXP = 6400, FF = 5632;
constexpr float EPS = 1e-6f, GN_EPS = 64e-5f;
constexpr size_t O_Y = 0, O_YS = 16777216, O_PK = 16793600, O_PV = 33570816, O_PWKV = 50348032, O_PSH = 51134464, O_PCV = 51175424,
                 O_SK = 51200000, O_SV = 51216384, O_SWKV = 51232768, O_SSH = 52805632, O_SCV = 52887552, O_END = 52936704;

__global__ void k_copy_x(const float* xp, const float* xs, float* x) {
    const size_t n = (size_t)R * D;
    for (size_t i = (size_t)blockIdx.x * blockDim.x + threadIdx.x; i < n; i += (size_t)gridDim.x * blockDim.x)
        x[i] = i < (size_t)MP * D ? xp[i] : xs[i - (size_t)MP * D];
}
__global__ void k_copy(const float* src, float* dst, size_t n) {
    for (size_t i = (size_t)blockIdx.x * blockDim.x + threadIdx.x; i < n; i += (size_t)gridDim.x * blockDim.x) dst[i] = src[i];
}
__global__ void k_rmsnorm(const float* x, const float* g, float* out) {
    __shared__ float red[256];
    const int r = blockIdx.x, tid = threadIdx.x;
    const float* xr = x + (size_t)r * D; float s = 0.f;
    for (int c = tid; c < D; c += 256) s += xr[c] * xr[c];
    red[tid] = s; __syncthreads();
    for (int o = 128; o > 0; o >>= 1) { if (tid < o) red[tid] += red[tid + o]; __syncthreads(); }
    const float rs = 1.0f / sqrtf(red[0] / (float)D + EPS);
    for (int c = tid; c < D; c += 256) out[(size_t)r * D + c] = xr[c] * rs * g[c];
}
__global__ void __launch_bounds__(256) k_gemm(const float* A, const float* B, float* C, int M, int N, int K) {
    __shared__ float As[16][65];
    __shared__ float Bs[16][64];
    const int tid = threadIdx.x, tx = tid & 15, ty = tid >> 4;
    const int m0 = blockIdx.y * 64, n0 = blockIdx.x * 64;
    float acc[4][4];
#pragma unroll
    for (int i = 0; i < 4; ++i)
#pragma unroll
        for (int j = 0; j < 4; ++j) acc[i][j] = 0.f;
    for (int k0 = 0; k0 < K; k0 += 16) {
#pragma unroll
        for (int i = 0; i < 4; ++i) {
            const int idx = tid + i * 256;
            { const int m = idx >> 4, kk = idx & 15; As[kk][m] = (m0 + m < M) ? A[(size_t)(m0 + m) * K + k0 + kk] : 0.f; }
            { const int kk = idx >> 6, n = idx & 63; Bs[kk][n] = B[(size_t)(k0 + kk) * N + n0 + n]; }
        }
        __syncthreads();
#pragma unroll
        for (int kk = 0; kk < 16; ++kk) {
            float a[4], b[4];
#pragma unroll
            for (int i = 0; i < 4; ++i) { a[i] = As[kk][ty * 4 + i]; b[i] = Bs[kk][tx * 4 + i]; }
#pragma unroll
            for (int i = 0; i < 4; ++i)
#pragma unroll
                for (int j = 0; j < 4; ++j) acc[i][j] += a[i] * b[j];
        }
        __syncthreads();
    }
#pragma unroll
    for (int i = 0; i < 4; ++i) { const int m = m0 + ty * 4 + i; if (m < M) {
#pragma unroll
        for (int j = 0; j < 4; ++j) C[(size_t)m * N + n0 + tx * 4 + j] = acc[i][j]; } }
}
__global__ void k_swiglu(const float* g, const float* u, float* h, size_t n) {
    for (size_t i = (size_t)blockIdx.x * blockDim.x + threadIdx.x; i < n; i += (size_t)gridDim.x * blockDim.x) { const float a = g[i]; h[i] = a / (1.0f + expf(-a)) * u[i]; }
}
__global__ void k_axpy(float* x, const float* y, float c, size_t n) {
    for (size_t i = (size_t)blockIdx.x * blockDim.x + threadIdx.x; i < n; i += (size_t)gridDim.x * blockDim.x) x[i] += c * y[i];
}
__global__ void k_qkv(const float* P, const float* qg, const float* kg, float* qn, float* kn, float* vb, float* out, int l) {
    const int r = blockIdx.x, tid = threadIdx.x, h = tid >> 6, d = tid & 63;
    const float* p = P + (size_t)r * MIXP;
    float q = p[h * 64 + d], k = p[AW + h * 64 + d], v = p[2 * AW + h * 64 + d];
    float sq = q * q, sk = k * k;
    for (int o = 32; o > 0; o >>= 1) { sq += __shfl_xor(sq, o); sk += __shfl_xor(sk, o); }
    q = q * (1.0f / sqrtf(sq / 64.f + EPS)) * qg[d];
    k = k * (1.0f / sqrtf(sk / 64.f + EPS)) * kg[d];
    qn[(size_t)r * AW + tid] = q; kn[(size_t)r * AW + tid] = k; vb[(size_t)r * AW + tid] = v;
    if (r < MP) { out[O_PK + (size_t)l * MP * AW + (size_t)r * AW + tid] = k; out[O_PV + (size_t)l * MP * AW + (size_t)r * AW + tid] = v; }
    else { const int n = r - MP; out[O_SK + (size_t)(l * NS + n) * AW + tid] = k; out[O_SV + (size_t)(l * NS + n) * AW + tid] = v; }
}
__global__ void __launch_bounds__(64) k_attn(const float* qn, const float* kn, const float* vb, const float* ck, const float* cv, float* og, float* lse, int g, int dil, int l) {
    const int gid = blockIdx.x * 64 + threadIdx.x; if (gid >= R * AH) return;
    const int r = gid / AH, h = gid % AH;
    const float slope = exp2f(-8.0f * (float)(h + 1) / (float)AH);
    float q[64], acc[64];
#pragma unroll
    for (int d = 0; d < 64; ++d) { q[d] = qn[(size_t)r * AW + h * 64 + d]; acc[d] = 0.f; }
    float m = -INFINITY, lsum = 0.f;
    const bool isS = r >= MP; const int n = isS ? r - MP : r / T, t = isS ? 0 : r % T;
    for (int j = 0; j <= 128; ++j) {
        const float* kp; const float* vp;
        if (!isS) { const int tp = t - j * dil; if (tp < 0) break; kp = kn + (size_t)(n * T + tp) * AW + h * 64; vp = vb + (size_t)(n * T + tp) * AW + h * 64; }
        else if (j == 0) { kp = kn + (size_t)r * AW + h * 64; vp = vb + (size_t)r * AW + h * 64; }
        else { const size_t ci = (((size_t)(l * NS + n) * 2048 + (2048 - dil * j)) * AH + h) * 64; kp = ck + ci; vp = cv + ci; }
        float s = 0.f;
#pragma unroll
        for (int d = 0; d < 64; ++d) s += q[d] * kp[d];
        s = s * 0.125f - slope * (float)(dil * j);
        const float mn = fmaxf(m, s), al = expf(m - mn), p = expf(s - mn);
        lsum = lsum * al + p;
#pragma unroll
        for (int d = 0; d < 64; ++d) acc[d] = acc[d] * al + p * vp[d];
        m = mn;
    }
    const float inv = 1.0f / lsum;
#pragma unroll
    for (int d = 0; d < 64; ++d) og[((size_t)g * R + r) * AW + h * 64 + d] = acc[d] * inv;
    lse[((size_t)g * R + r) * AH + h] = m + logf(lsum);
}
__global__ void k_attn_merge(const float* og, const float* lse, float* mix) {
    const size_t n = (size_t)R * AW;
    for (size_t i = (size_t)blockIdx.x * blockDim.x + threadIdx.x; i < n; i += (size_t)gridDim.x * blockDim.x) {
        const size_t r = i / AW; const int c = (int)(i % AW), h = c >> 6;
        const float l0 = lse[(0 * (size_t)R + r) * AH + h], l1 = lse[(1 * (size_t)R + r) * AH + h], l2 = lse[(2 * (size_t)R + r) * AH + h];
        const float mx = fmaxf(l0, fmaxf(l1, l2)); const float e0 = expf(l0 - mx), e1 = expf(l1 - mx), e2 = expf(l2 - mx), inv = 1.0f / (e0 + e1 + e2);
        mix[r * D + c] = og[(0 * (size_t)R + r) * AW + c] * (e0 * inv) + og[(1 * (size_t)R + r) * AW + c] * (e1 * inv) + og[(2 * (size_t)R + r) * AW + c] * (e2 * inv);
    }
}
__global__ void k_rwkv_xm(const float* P, const float* mu, const float* sshift, float* xm, float* out, int l) {
    const size_t n = (size_t)R * RP;
    for (size_t i = (size_t)blockIdx.x * blockDim.x + threadIdx.x; i < n; i += (size_t)gridDim.x * blockDim.x) {
        const int r = (int)(i / RP), c = (int)(i % RP);
        const float p = P[(size_t)r * MIXP + 3 * AW + c]; float prev;
        if (r >= MP) prev = sshift[(size_t)(l * NS + (r - MP)) * RP + c];
        else prev = (r % T == 0) ? 0.f : P[(size_t)(r - 1) * MIXP + 3 * AW + c];
        xm[i] = p + (prev - p) * mu[c];
        if (r >= MP) out[O_SSH + (size_t)(l * NS + (r - MP)) * RP + c] = p;
        else if (r % T == T - 1) out[O_PSH + (size_t)(l * NB + r / T) * RP + c] = p;
    }
}
__global__ void k_rwkv_lora(const float* xm, const float* w0, const float* w2, const float* a0, const float* a2, const float* g2, float* dec, float* av, float* gv) {
    const size_t n = (size_t)R * RW;
    for (size_t i = (size_t)blockIdx.x * blockDim.x + threadIdx.x; i < n; i += (size_t)gridDim.x * blockDim.x) {
        const int r = (int)(i / RW), c = (int)(i % RW);
        const float* x = xm + (size_t)r * RP;
        float sw = w0[c], sa = a0[c], sg = 0.f;
        for (int j = 0; j < 64; ++j) { sw += tanhf(x[2304 + j]) * w2[(size_t)j * RW + c]; sa += x[2368 + j] * a2[(size_t)j * RW + c]; }
        for (int j = 0; j < 128; ++j) sg += (1.0f / (1.0f + expf(-x[2432 + j]))) * g2[(size_t)j * RW + c];
        const float z = -sw; const float sp = (z > 0.f) ? z + log1pf(expf(-z)) : log1pf(expf(z));
        const float wlog = -sp - 0.5f;
        dec[i] = expf(-expf(wlog)); av[i] = 1.0f / (1.0f + expf(-sa)); gv[i] = sg;
    }
}
__global__ void __launch_bounds__(64) k_rwkv_kk(const float* xm, const float* av, const float* k_k, const float* k_a, const float* r_k, float* nkk, float* bv, float* kmod, float* bonus) {
    const int r = blockIdx.x / RH, h = blockIdx.x % RH, lane = threadIdx.x, c = h * 64 + lane;
    const float rr = xm[(size_t)r * RP + c], kr = xm[(size_t)r * RP + RW + c], a = av[(size_t)r * RW + c];
    float kk = kr * k_k[c]; float s = kk * kk;
    for (int o = 32; o > 0; o >>= 1) s += __shfl_xor(s, o);
    kk = kk / fmaxf(sqrtf(s), 1e-12f);
    const float km = kr * (1.0f + (a - 1.0f) * k_a[c]);
    float b = rr * km * r_k[c];
    for (int o = 32; o > 0; o >>= 1) b += __shfl_xor(b, o);
    nkk[(size_t)r * RW + c] = -kk; bv[(size_t)r * RW + c] = kk * a; kmod[(size_t)r * RW + c] = km;
    if (lane == 0) bonus[(size_t)r * RH + h] = b;
}
__global__ void __launch_bounds__(64) k_rwkv_scan(const float* xm, const float* dec, const float* kmod, const float* nkk, const float* bv, const float* swkv, float* y, float* out, int l) {
    const int seq = blockIdx.x / RH, h = blockIdx.x % RH, v = threadIdx.x;
    const bool isS = seq >= NB; const int steps = isS ? 1 : T; const int r0 = isS ? MP + (seq - NB) : seq * T;
    float s[64];
#pragma unroll
    for (int k = 0; k < 64; ++k) s[k] = isS ? swkv[(((size_t)(l * NS + (seq - NB)) * RH + h) * 64 + v) * 64 + k] : 0.f;
    for (int t = 0; t < steps; ++t) {
        const size_t r = (size_t)(r0 + t);
        const float* rp = xm + r * RP + h * 64; const float* wp = dec + r * RW + h * 64; const float* kp = kmod + r * RW + h * 64;
        const float* ap = nkk + r * RW + h * 64; const float* bp = bv + r * RW + h * 64;
        const float vv = xm[r * RP + 2 * RW + h * 64 + v];
        float sa = 0.f;
#pragma unroll
        for (int k = 0; k < 64; ++k) sa += s[k] * ap[k];
        float yy = 0.f;
#pragma unroll
        for (int k = 0; k < 64; ++k) { s[k] = s[k] * wp[k] + sa * bp[k] + vv * kp[k]; yy += s[k] * rp[k]; }
        y[r * RW + h * 64 + v] = yy;
    }
    float* so = isS ? out + O_SWKV + (((size_t)(l * NS + (seq - NB)) * RH + h) * 64 + v) * 64 : out + O_PWKV + (((size_t)(l * NB + seq) * RH + h) * 64 + v) * 64;
#pragma unroll
    for (int k = 0; k < 64; ++k) so[k] = s[k];
}
__global__ void __launch_bounds__(64) k_rwkv_post(const float* y, const float* xm, const float* gv, const float* bonus, const float* lnw, const float* lnb, float* mix) {
    const int r = blockIdx.x / RH, h = blockIdx.x % RH, lane = threadIdx.x, c = h * 64 + lane;
    const float yy = y[(size_t)r * RW + c]; float s = yy;
    for (int o = 32; o > 0; o >>= 1) s += __shfl_xor(s, o);
    const float mean = s / 64.f; const float dlt = yy - mean; float q = dlt * dlt;
    for (int o = 32; o > 0; o >>= 1) q += __shfl_xor(q, o);
    const float yn = dlt * (1.0f / sqrtf(q / 64.f + GN_EPS)) * lnw[c] + lnb[c];
    const float vr = xm[(size_t)r * RP + 2 * RW + c];
    mix[(size_t)r * D + AW + c] = (yn + bonus[(size_t)r * RH + h] * vr) * gv[(size_t)r * RW + c];
}
__global__ void k_conv(const float* P, const float* cw, const float* cb, const float* sconv, float* mix, float* out, int l) {
    const size_t n = (size_t)R * CW;
    for (size_t i = (size_t)blockIdx.x * blockDim.x + threadIdx.x; i < n; i += (size_t)gridDim.x * blockDim.x) {
        const int r = (int)(i / CW), c = (int)(i % CW); const int o2 = 3 * AW + RP;
        const float* p = P + (size_t)r * MIXP + o2;
        const float u = p[c], gb = p[CW + c], gc = p[2 * CW + c]; const float z0 = gc * u; float z1, z2;
        if (r >= MP) { const float* sc = sconv + (size_t)(l * NS + (r - MP)) * 2 * CW; z2 = sc[c]; z1 = sc[CW + c]; }
        else { const int t = r % T;
            z1 = (t >= 1) ? P[(size_t)(r - 1) * MIXP + o2 + 2 * CW + c] * P[(size_t)(r - 1) * MIXP + o2 + c] : 0.f;
            z2 = (t >= 2) ? P[(size_t)(r - 2) * MIXP + o2 + 2 * CW + c] * P[(size_t)(r - 2) * MIXP + o2 + c] : 0.f; }
        const float yc = cb[c] + cw[c] * z2 + cw[CW + c] * z1 + cw[2 * CW + c] * z0;
        mix[(size_t)r * D + AW + RW + c] = gb * yc;
        if (r >= MP) { float* o = out + O_SCV + (size_t)(l * NS + (r - MP)) * 2 * CW; o[c] = z1; o[CW + c] = z0; }
        else if (r % T == T - 1) { float* o = out + O_PCV + (size_t)(l * NB + r / T) * 2 * CW; o[c] = z1; o[CW + c] = z0; }
    }
}

struct WS { float *x, *hn, *g, *u, *f, *P, *qn, *kn, *vb, *og, *lse, *mix, *xm, *dec, *av, *gv, *nkk, *bv, *kmod, *bonus, *y; };
static inline WS carve(float* base) {
    WS w; size_t o = 0; auto take = [&](size_t n) { float* p = base + o; o += (n + 63) & ~(size_t)63; return p; };
    w.x = take((size_t)R * D); w.hn = take((size_t)R * D); w.g = take((size_t)R * FF); w.u = take((size_t)R * FF); w.f = take((size_t)R * D);
    w.P = take((size_t)R * MIXP); w.qn = take((size_t)R * AW); w.kn = take((size_t)R * AW); w.vb = take((size_t)R * AW);
    w.og = take((size_t)3 * R * AW); w.lse = take((size_t)3 * R * AH); w.mix = take((size_t)R * D); w.xm = take((size_t)R * RP);
    w.dec = take((size_t)R * RW); w.av = take((size_t)R * RW); w.gv = take((size_t)R * RW); w.nkk = take((size_t)R * RW); w.bv = take((size_t)R * RW); w.kmod = take((size_t)R * RW);
    w.bonus = take((size_t)R * RH); w.y = take((size_t)R * RW);
    return w;
}
static void gemm(const float* A, const float* B, float* C, int M, int N, int K, hipStream_t st) { k_gemm<<<dim3(N / 64, (M + 63) / 64), 256, 0, st>>>(A, B, C, M, N, K); }
static void ffn(const WS& w, const float* norm, const float* wg, const float* wu, const float* wd, hipStream_t st) {
    k_rmsnorm<<<R, 256, 0, st>>>(w.x, norm, w.hn);
    gemm(w.hn, wg, w.g, R, FF, D, st); gemm(w.hn, wu, w.u, R, FF, D, st);
    k_swiglu<<<2048, 256, 0, st>>>(w.g, w.u, w.g, (size_t)R * FF);
    gemm(w.g, wd, w.f, R, D, FF, st);
    k_axpy<<<2048, 256, 0, st>>>(w.x, w.f, 0.5f, (size_t)R * D);
}
static void forward(void* const* d_in, float* out, float* base, hipStream_t st) {
    const WS w = carve(base);
    auto in = [&](int i) { return (const float*)d_in[i]; };
    k_copy_x<<<2048, 256, 0, st>>>(in(0), in(1), w.x);
    for (int l = 0; l < L; ++l) {
        ffn(w, in(7) + (size_t)l * D, in(8) + (size_t)l * D * FF, in(9) + (size_t)l * D * FF, in(10) + (size_t)l * FF * D, st);
        k_rmsnorm<<<R, 256, 0, st>>>(w.x, in(11) + (size_t)l * D, w.hn);
        gemm(w.hn, in(12) + (size_t)l * D * MIXP, w.P, R, MIXP, D, st);
        k_qkv<<<R, 512, 0, st>>>(w.P, in(13) + l * 64, in(14) + l * 64, w.qn, w.kn, w.vb, out, l);
        const int dils[3] = {1, 4, 16};
        for (int g = 0; g < 3; ++g) k_attn<<<(R * AH + 63) / 64, 64, 0, st>>>(w.qn, w.kn, w.vb, in(2), in(3), w.og, w.lse, g, dils[g], l);
        k_attn_merge<<<2048, 256, 0, st>>>(w.og, w.lse, w.mix);
        k_rwkv_xm<<<2048, 256, 0, st>>>(w.P, in(15) + (size_t)l * RP, in(5), w.xm, out, l);
        k_rwkv_lora<<<2048, 256, 0, st>>>(w.xm, in(16) + (size_t)l * RW, in(17) + (size_t)l * 64 * RW, in(18) + (size_t)l * RW, in(19) + (size_t)l * 64 * RW, in(20) + (size_t)l * 128 * RW, w.dec, w.av, w.gv);
        k_rwkv_kk<<<R * RH, 64, 0, st>>>(w.xm, w.av, in(21) + (size_t)l * RW, in(22) + (size_t)l * RW, in(23) + (size_t)l * RW, w.nkk, w.bv, w.kmod, w.bonus);
        k_rwkv_scan<<<(NB + NS) * RH, 64, 0, st>>>(w.xm, w.dec, w.kmod, w.nkk, w.bv, in(4), w.y, out, l);
        k_rwkv_post<<<R * RH, 64, 0, st>>>(w.y, w.xm, w.gv, w.bonus, in(24) + (size_t)l * RW, in(25) + (size_t)l * RW, w.mix);
        k_conv<<<2048, 256, 0, st>>>(w.P, in(26) + (size_t)l * 3 * CW, in(27) + (size_t)l * CW, in(6), w.mix, out, l);
        gemm(w.mix, in(28) + (size_t)l * D * D, w.f, R, D, D, st);
        k_axpy<<<2048, 256, 0, st>>>(w.x, w.f, 1.0f, (size_t)R * D);
        ffn(w, in(29) + (size_t)l * D, in(30) + (size_t)l * D * FF, in(31) + (size_t)l * D * FF, in(32) + (size_t)l * FF * D, st);
    }
    k_copy<<<2048, 256, 0, st>>>(w.x, out + O_Y, (size_t)MP * D);
    k_copy<<<64, 256, 0, st>>>(w.x + (size_t)MP * D, out + O_YS, (size_t)NS * D);
}
}
extern "C" void kernel_launch(void* const* d_in, const int* in_sizes, int n_in, void* d_out, int out_size, void* d_ws, size_t ws_size, hipStream_t stream) {
    if (n_in != 33 || out_size != (int)nv::O_END || ws_size < (size_t)1400 * 1024 * 1024) { fprintf(stderr, "kernel_launch: unexpected sizes n_in %d out %d ws %zu\n", n_in, out_size, ws_size); return; }
    nv::forward(d_in, (float*)d_out, (float*)d_ws, stream);
}
```

```cpp
#include <hip/hip_runtime.h>
#include <hip/hip_bf16.h>
#include <cstdio>
#include <cstdint>
#include <cmath>
#include <cstring>
#define KMODE 1
#define PROBE_ONE_LAUNCH 0
namespace fk {
#define GAS __attribute__((address_space(1)))
#define LAS __attribute__((address_space(3)))
typedef unsigned short bf16;
typedef unsigned v4u __attribute__((ext_vector_type(4)));
typedef unsigned v2u __attribute__((ext_vector_type(2)));
typedef float f32x4 __attribute__((ext_vector_type(4)));
typedef float f32x2 __attribute__((ext_vector_type(2)));
typedef float f32x16 __attribute__((ext_vector_type(16)));
typedef short bf16x8 __attribute__((ext_vector_type(8)));
typedef short s16x4 __attribute__((ext_vector_type(4)));
typedef GAS unsigned gu32;

constexpr int D = 2048, NB = 4, T = 2048, MP = NB * T, NS = 8, L = 4;
constexpr int AW = 512, AH = 8, RW = 768, RH = 12, CW = 768, RP = 2560, MIXP = 6400, FF = 5632, PRW = RP + 3 * CW  ;
constexpr int NGU = 2 * FF;
constexpr float EPS = 1e-6f, GN_EPS = 64e-5f;
constexpr int NWAVES = 8, NTHREADS = 512;
constexpr int NCH = 32, CH = 64;
constexpr int NTASK = NB * RH * NCH;

constexpr size_t O_Y = 0, O_YS = 16777216, O_PK = 16793600, O_PV = 33570816, O_PWKV = 50348032, O_PSH = 51134464, O_PCV = 51175424,
                 O_SK = 51200000, O_SV = 51216384, O_SWKV = 51232768, O_SSH = 52805632, O_SCV = 52887552, O_END = 52936704;

constexpr size_t alignup(size_t x) { return (x + 4095) & ~(size_t)4095; }
constexpr int CW_TMO = 0;
constexpr int CW_BAR = 4096;
constexpr int CW_QUEUE = 8192;
constexpr size_t CTL_U32 = 16384;
constexpr size_t WS_CTL = 0;
constexpr size_t WS_SS = WS_CTL + CTL_U32 * 4;
constexpr size_t WS_SACC = WS_SS + (size_t)12 * MP * 8;
constexpr int SA_GU1 = 0, SA_D1 = 8 * NGU, SA_P = SA_D1 + 8 * D, SA_O = SA_P + 8 * MIXP, SA_GU2 = SA_O + 8 * D, SA_D2 = SA_GU2 + 8 * NGU, SA_LAYER = SA_D2 + 8 * D;
constexpr size_t CTL_ZERO_BYTES = alignup(WS_SACC + (size_t)L * SA_LAYER * 8);
constexpr size_t WS_XS = CTL_ZERO_BYTES;
constexpr size_t WS_RSTD = WS_XS + (size_t)13 * NS * D * 4;
constexpr size_t WS_MIXS = alignup(WS_RSTD + 13 * 8 * 4);
constexpr size_t WB_GU = (size_t)NGU * D * 2, WB_D = (size_t)D * FF * 2, WB_IN = (size_t)MIXP * D * 2, WB_OUT = (size_t)D * D * 2;
constexpr size_t WL_GU1 = 0, WL_D1 = WL_GU1 + WB_GU, WL_IN = WL_D1 + WB_D, WL_OUT = WL_IN + WB_IN, WL_GU2 = WL_OUT + WB_OUT, WL_D2 = WL_GU2 + WB_GU, WL_W2T = WL_D2 + WB_D,
                 WL_A2T = WL_W2T + (size_t)RW * 64 * 2, WL_G2T = WL_A2T + (size_t)RW * 64 * 2, WL_LAYER = alignup(WL_G2T + (size_t)RW * 128 * 2);
constexpr size_t WS_W = alignup(WS_MIXS + (size_t)L * NS * D * 4);
constexpr size_t WS_XB = WS_W + (size_t)L * WL_LAYER;
constexpr size_t WS_H = WS_XB + (size_t)MP * D * 2;
constexpr size_t WS_QN = WS_H + (size_t)MP * FF * 2;
constexpr size_t WS_KN = WS_QN + (size_t)MP * AW * 2;
constexpr size_t WS_VB = WS_KN + (size_t)MP * AW * 2;
constexpr size_t WS_PR = WS_VB + (size_t)MP * AW * 2;
constexpr size_t WS_MIX = WS_PR + (size_t)MP * PRW * 2;
constexpr size_t WS_OG = WS_MIX + (size_t)MP * D * 2;
constexpr size_t WS_LSE = WS_OG + (size_t)3 * MP * AW * 4;
constexpr size_t WS_PC = WS_LSE + (size_t)3 * MP * AH * 4;
constexpr size_t WS_RT = WS_PC + (size_t)NTASK * 2 * 4096 * 4;
constexpr size_t WS_YZ = WS_RT + (size_t)48 * T * 64 * 4;
constexpr size_t WS_GG = WS_YZ + (size_t)48 * T * 64 * 4;
constexpr size_t WS_BON = WS_GG + (size_t)48 * T * 64 * 4;
constexpr size_t WS_SC = WS_BON + (size_t)48 * T * 64 * 4;
constexpr size_t WS_FAST_END = WS_SC + (size_t)NTASK * 4096 * 4;

constexpr int LDS_BYTES = 147456;
constexpr int RING_BYTES = 131072;
constexpr int MISC_OFF = LDS_BYTES - 256;
constexpr int PTAB_OFF = LDS_BYTES - 1024;

#define RLX_AGENT __ATOMIC_RELAXED, __HIP_MEMORY_SCOPE_AGENT
#define LDS_WAIT() asm volatile("s_waitcnt lgkmcnt(0)" ::: "memory")
#define VM_WAIT() asm volatile("s_waitcnt vmcnt(0)" ::: "memory")
__device__ __forceinline__ unsigned f2bf(float f) { unsigned u = __builtin_bit_cast(unsigned, f); return (u + 0x7fffu + ((u >> 16) & 1u)) >> 16; }
__device__ __forceinline__ unsigned pk2(float lo, float hi) { return f2bf(lo) | (f2bf(hi) << 16); }
__device__ __forceinline__ float bf2f(unsigned short b) { return __builtin_bit_cast(float, (unsigned)b << 16); }
__device__ __forceinline__ float bflo(unsigned w) { return __builtin_bit_cast(float, w << 16); }
__device__ __forceinline__ float bfhi(unsigned w) { return __builtin_bit_cast(float, w & 0xffff0000u); }
typedef unsigned long long u64;
constexpr float SS_SCALE = 16777216.0f, SS_INV = 1.0f / 16777216.0f;
__device__ __forceinline__ u64 ss_enc(float s) { return (u64)((double)s * 16777216.0); }
__device__ __forceinline__ float ss_dec(u64 v) { return (float)v * SS_INV; }
__device__ __forceinline__ u64 fx_enc(float a) { return (u64)(long long)__double2ll_rn((double)a * 4294967296.0); }
__device__ __forceinline__ float fx_dec(u64 v) { return (float)((double)(long long)v * 2.3283064365386963e-10); }
__device__ __forceinline__ float sigmoidf_(float x) { return 1.0f / (1.0f + __expf(-x)); }
__device__ __forceinline__ float wave_sum(float v) {
#pragma unroll
    for (int o = 1; o < 64; o <<= 1) v += __shfl_xor(v, o);
    return v;
}
__device__ __forceinline__ float dpp_x1(float x) { return __builtin_bit_cast(float, __builtin_amdgcn_update_dpp(0, __builtin_bit_cast(int, x), 0xB1, 0xF, 0xF, true)); }
__device__ __forceinline__ float dpp_x2(float x) { return __builtin_bit_cast(float, __builtin_amdgcn_update_dpp(0, __builtin_bit_cast(int, x), 0x4E, 0xF, 0xF, true)); }
__device__ __forceinline__ float dpp_hm(float x) { return __builtin_bit_cast(float, __builtin_amdgcn_update_dpp(0, __builtin_bit_cast(int, x), 0x141, 0xF, 0xF, true)); }
__device__ __forceinline__ float dpp_rm(float x) { return __builtin_bit_cast(float, __builtin_amdgcn_update_dpp(0, __builtin_bit_cast(int, x), 0x140, 0xF, 0xF, true)); }
__device__ __forceinline__ float sum8(float x) { x += dpp_x1(x); x += dpp_x2(x); x += dpp_hm(x); return x; }
__device__ __forceinline__ float sum16(float x) { x = sum8(x); x += dpp_rm(x); return x; }

#define XB_TMO      128
#define XB_XCNT(j)  (256  + 64 * (j))
#define XB_XSUB(j)  (1280 + 64 * (j))
#define XB_XGEN(j)  (2304 + 64 * (j))
#define XB_TOP      3328
#define XB_TOPGEN   3392
#define XCD_BAR_WORDS 3456
#define XB_SPIN_CAP (1u << 20)
__device__ __forceinline__ unsigned xb_ld(unsigned* p)              { return __hip_atomic_load(p, __ATOMIC_RELAXED, __HIP_MEMORY_SCOPE_AGENT); }
__device__ __forceinline__ unsigned xb_add(unsigned* p, unsigned v) { return __hip_atomic_fetch_add(p, v, __ATOMIC_RELAXED, __HIP_MEMORY_SCOPE_AGENT); }
__device__ __forceinline__ unsigned xb_xcc_id() { return (unsigned)__builtin_amdgcn_s_getreg((3 << 11) | 20) & 0xFu; }
#define XB_SPIN(cond, bar) do { unsigned _sp = 0; while (cond) { __builtin_amdgcn_s_sleep(1); \
    if ((++_sp & 255u) == 0u) { if (xb_ld(&(bar)[XB_TMO])) break; if (_sp > XB_SPIN_CAP) { atomicAdd(&(bar)[XB_TMO], 1u); break; } } } } while (0)
struct XcdBarrier { unsigned* bar; unsigned x; volatile LAS unsigned* st; };
__device__ __forceinline__ XcdBarrier xcd_barrier_post(unsigned* bar, volatile LAS unsigned* st) {
    XcdBarrier b; b.bar = bar; b.x = xb_xcc_id(); b.st = st;
    if (threadIdx.x == 0) (void)xb_add(&bar[XB_XCNT(b.x)], 1u);
    return b;
}
__device__ __forceinline__ void xcd_barrier_complete(unsigned* bar, unsigned x, unsigned& nloc, unsigned& nx) {
    const unsigned G = gridDim.x * gridDim.y * gridDim.z;
    unsigned sum, cnt, mine, sp = 0u;
    for (;;) {
        sum = 0u; cnt = 0u; mine = 0u;
#pragma unroll
        for (unsigned j = 0; j < 16; ++j) { const unsigned c = xb_ld(&bar[XB_XCNT(j)]); sum += c; cnt += (c > 0u) ? 1u : 0u; mine = (j == x) ? c : mine; }
        if (sum == G) break;
        __builtin_amdgcn_s_sleep(1);
        if ((++sp & 255u) == 0u) { if (xb_ld(&bar[XB_TMO])) break; if (sp > XB_SPIN_CAP) { atomicAdd(&bar[XB_TMO], 1u); break; } }
    }
    nloc = mine > 0u ? mine : 1u; nx = cnt > 0u ? cnt : 1u;
}
__device__ __forceinline__ void xcd_barrier(const XcdBarrier& b) {
    asm volatile("s_waitcnt vmcnt(0)" ::: "memory");
    __syncthreads();
    if (threadIdx.x == 0) {
        unsigned* bar = b.bar;
        __builtin_amdgcn_s_waitcnt(0);
        unsigned nloc = b.st[0], nx = b.st[1];
        if (nloc == 0u) { xcd_barrier_complete(bar, b.x, nloc, nx); b.st[0] = nloc; b.st[1] = nx; }
        const unsigned old = xb_add(&bar[XB_XSUB(b.x)], 1u);
        const unsigned gen = old / nloc;
        if (old + 1u == (gen + 1u) * nloc) {
            __builtin_amdgcn_fence(__ATOMIC_RELEASE, "agent");
            asm volatile("s_waitcnt vmcnt(0)" ::: "memory");
            const unsigned og = xb_add(&bar[XB_TOP], 1u);
            const unsigned tg = og / nx;
            if (og + 1u == (tg + 1u) * nx) xb_add(&bar[XB_TOPGEN], 1u);
            else XB_SPIN(xb_ld(&bar[XB_TOPGEN]) == tg, bar);
            __builtin_amdgcn_fence(__ATOMIC_ACQUIRE, "agent");
            xb_add(&bar[XB_XGEN(b.x)], 1u);
            asm volatile("s_waitcnt vmcnt(0)" ::: "memory");
        } else {
            XB_SPIN(xb_ld(&bar[XB_XGEN(b.x)]) == gen, bar);
            __builtin_amdgcn_fence(__ATOMIC_ACQUIRE, "agent");
            asm volatile("s_waitcnt vmcnt(0)" ::: "memory");
        }
    }
    __syncthreads();
}
}
namespace pg8 {
#define PG8_LAS __attribute__((address_space(3)))
typedef unsigned short bf16_t;
typedef short bf16x8 __attribute__((ext_vector_type(8)));
typedef float f32x4 __attribute__((ext_vector_type(4)));
typedef unsigned u32x4 __attribute__((ext_vector_type(4)));
constexpr int BM = 256, BK = 64, HALF = 128, HTB = HALF * BK * 2  , STAGE_BYTES = 8 * HTB, NXCD = 8, WGM = 8;

__host__ __device__ __forceinline__ int lds_byte(int r, int c) { const int st = (r >> 4) * 2 + (c >> 5), rr = r & 15, cc = c & 31, ob = rr * 64 + cc * 2; return st * 1024 + (ob ^ (((ob >> 9) & 1) << 5)); }
__host__ __device__ __forceinline__ void stage_rc(int b, int& R, int& C) { const int st = b / 1024, sb = b % 1024, swz = sb ^ (((sb >> 9) & 1) << 5); R = (st >> 1) * 16 + swz / 64; C = (st & 1) * 32 + (swz % 64) / 2; }
__host__ __device__ __forceinline__ int perm32(int rho) { const int n = rho >> 4, i = rho & 15; return 8 * (i >> 2) + 4 * n + (i & 3); }

struct Unit { int pm, pn; };
struct Gemm { const bf16_t* A; const bf16_t* Bt; int M, N, K; };

struct StaticOrder {
    int nM, nN, nwg, G, c;
    __host__ __device__ void init(int M, int N, int G_, int c_) { nM = M / BM; nN = N / BM; nwg = nM * nN; G = G_; c = c_; }
    __host__ __device__ bool next(int i, Unit& u) const {
        const long L = (long)i * G + c; if (L >= nwg) return false;
        int wgid = (int)L; { const int q = nwg / NXCD, r = nwg % NXCD, xcd = wgid % NXCD, off = wgid / NXCD; wgid = (xcd < r ? xcd * (q + 1) : r * (q + 1) + (xcd - r) * q) + off; }
        const int nig = WGM * nN, gid = wgid / nig, fm = gid * WGM, gsz = (nM - fm) < WGM ? (nM - fm) : WGM;
        u.pm = fm + ((wgid % nig) % gsz); u.pn = (wgid % nig) / gsz; return true;
    }
    __device__ __forceinline__ void a_ready(const Unit&) const {}
    __device__ __forceinline__ void done(const Unit&) const {}
};

__device__ __forceinline__ unsigned cvt_pk_bf16(float lo, float hi) { unsigned r; asm volatile("v_cvt_pk_bf16_f32 %0, %1, %2" : "=v"(r) : "v"(lo), "v"(hi)); return r; }
__device__ __forceinline__ u32x4 pack8(const f32x4& a, const f32x4& b) { u32x4 w; w.x = cvt_pk_bf16(a[0], a[1]); w.y = cvt_pk_bf16(a[2], a[3]); w.z = cvt_pk_bf16(b[0], b[1]); w.w = cvt_pk_bf16(b[2], b[3]); return w; }
__device__ __forceinline__ float silu_f(float g) { return g * __builtin_amdgcn_rcpf(1.0f + __expf(-g)); }
constexpr float kEps = 1e-6f;

struct EpiSwiglu {
    static constexpr bool PERM = true, AFTER_DRAIN = false;
    bf16_t* H; const unsigned long long* ss; int ldh;
    __device__ __forceinline__ void operator()(const f32x4 (&acc)[2][2][4][2], const Unit& u, int wr, int wc, int fr, int fq) const {
        const int row0 = u.pm * BM + wr * 64 + fr, col0 = u.pn * HALF + wc * 32 + 8 * fq;
#pragma unroll
        for (int ai = 0; ai < 2; ++ai)
#pragma unroll
            for (int m = 0; m < 4; ++m) { const int row = row0 + ai * HALF + m * 16; const float rs = __builtin_amdgcn_rsqf((float)ss[row] * (1.0f / (16777216.0f * 2048.0f)) + kEps);
                f32x4 h0, h1;
#pragma unroll
                for (int j = 0; j < 4; ++j) { h0[j] = silu_f(acc[ai][0][m][0][j] * rs) * (acc[ai][1][m][0][j] * rs); h1[j] = silu_f(acc[ai][0][m][1][j] * rs) * (acc[ai][1][m][1][j] * rs); }
                *(u32x4*)(H + (size_t)row * ldh + col0) = pack8(h0, h1); }
    }
};
struct EpiResid {
    static constexpr bool PERM = true, AFTER_DRAIN = false;
    float* X; bf16_t* XB; unsigned long long* ssn; float coef;
    __device__ __forceinline__ void operator()(const f32x4 (&acc)[2][2][4][2], const Unit& u, int wr, int wc, int fr, int fq) const {
        const int row0 = u.pm * BM + wr * 64 + fr, col0 = u.pn * BM + wc * 32 + 8 * fq;
#pragma unroll
        for (int ai = 0; ai < 2; ++ai)
#pragma unroll
            for (int m = 0; m < 4; ++m) { const int row = row0 + ai * HALF + m * 16; float part = 0.f;
#pragma unroll
                for (int bj = 0; bj < 2; ++bj) { float* xp = X + (size_t)row * 2048 + col0 + bj * HALF;
                    f32x4 x0 = *(const f32x4*)xp, x1 = *(const f32x4*)(xp + 4);
                    x0 = x0 + acc[ai][bj][m][0] * coef; x1 = x1 + acc[ai][bj][m][1] * coef;
                    *(f32x4*)xp = x0; *(f32x4*)(xp + 4) = x1;
                    *(u32x4*)(XB + (size_t)row * 2048 + col0 + bj * HALF) = pack8(x0, x1);
                    part += (x0[0] * x0[0] + x0[1] * x0[1]) + (x0[2] * x0[2] + x0[3] * x0[3]) + (x1[0] * x1[0] + x1[1] * x1[1]) + (x1[2] * x1[2] + x1[3] * x1[3]); }
                part += __shfl_xor(part, 16); part += __shfl_xor(part, 32);
                if (ssn != nullptr && fq == 0) (void)__hip_atomic_fetch_add(ssn + row, (unsigned long long)((double)part * 16777216.0), __ATOMIC_RELAXED, __HIP_MEMORY_SCOPE_AGENT); }
    }
};
struct EpiWin {
    static constexpr bool PERM = true, AFTER_DRAIN = false;
    const unsigned long long* ss; bf16_t *QN, *PR; float *outK, *outSh; const float *qg, *kg; size_t qkv_stride, kv_out_stride;
    __device__ __forceinline__ void operator()(const f32x4 (&acc)[2][2][4][2], const Unit& u, int wr, int wc, int fr, int fq) const {
        const int row0 = u.pm * BM + wr * 64 + fr;
        if (u.pn < 6) {
            const int type = u.pn >> 1, head = 4 * (u.pn & 1) + wc;
            f32x4 gn[2][2];
#pragma unroll
            for (int bj = 0; bj < 2; ++bj)
#pragma unroll
                for (int n = 0; n < 2; ++n) { const int d = 32 * bj + 8 * fq + 4 * n;
                    const f32x4 gq = *(const f32x4*)(qg + d) * 0.125f, gk = *(const f32x4*)(kg + d);
                    gn[bj][n] = type == 0 ? gq : (type == 1 ? gk : (f32x4){1.f, 1.f, 1.f, 1.f}); }
            bf16_t* const dst = QN + (size_t)type * qkv_stride;
            float* const od = outK + (size_t)(type >> 1) * kv_out_stride;
#pragma unroll
            for (int ai = 0; ai < 2; ++ai)
#pragma unroll
                for (int m = 0; m < 4; ++m) { const int row = row0 + ai * HALF + m * 16; const float rs = __builtin_amdgcn_rsqf((float)ss[row] * (1.0f / (16777216.0f * 2048.0f)) + kEps);
                    f32x4 v[2][2]; float q = 0.f;
#pragma unroll
                    for (int bj = 0; bj < 2; ++bj)
#pragma unroll
                        for (int n = 0; n < 2; ++n) { v[bj][n] = acc[ai][bj][m][n] * rs; q += (v[bj][n][0] * v[bj][n][0] + v[bj][n][1] * v[bj][n][1]) + (v[bj][n][2] * v[bj][n][2] + v[bj][n][3] * v[bj][n][3]); }
                    q += __shfl_xor(q, 16); q += __shfl_xor(q, 32);
                    const float hn = type < 2 ? __builtin_amdgcn_rsqf(q * (1.0f / 64.0f) + kEps) : 1.0f;
#pragma unroll
                    for (int bj = 0; bj < 2; ++bj) { const f32x4 a = v[bj][0] * hn * gn[bj][0], b = v[bj][1] * hn * gn[bj][1];
                        const size_t o = (size_t)row * 512 + head * 64 + 32 * bj + 8 * fq;
                        *(u32x4*)(dst + o) = pack8(a, b);
                        if (type >= 1) { *(f32x4*)(od + o) = a; *(f32x4*)(od + o + 4) = b; } } }
        } else {
            const int colp = u.pn * BM + wc * 32 + 8 * fq - 1536;
#pragma unroll
            for (int ai = 0; ai < 2; ++ai)
#pragma unroll
                for (int m = 0; m < 4; ++m) { const int row = row0 + ai * HALF + m * 16; const float rs = __builtin_amdgcn_rsqf((float)ss[row] * (1.0f / (16777216.0f * 2048.0f)) + kEps);
#pragma unroll
                    for (int bj = 0; bj < 2; ++bj) { const f32x4 a = acc[ai][bj][m][0] * rs, b = acc[ai][bj][m][1] * rs; const int c = colp + bj * HALF;
                        *(u32x4*)(PR + (size_t)row * 4864 + c) = pack8(a, b);
                        if (u.pn < 16 && (row & 2047) == 2047) { float* o = outSh + (size_t)(row >> 11) * 2560 + c; *(f32x4*)o = a; *(f32x4*)(o + 4) = b; } } }
        }
    }
};
template <class Epi, class Sched, bool ALIGN_EPI = false, bool SP2 = false>
__device__ __forceinline__ void gemm_phase(PG8_LAS unsigned char* lds, const Gemm g, const Sched& S, const Epi& E, const int tid) {
    const int wid = __builtin_amdgcn_readfirstlane(tid >> 6), lane = tid & 63, wr = wid >> 2, wc = wid & 3, fr = lane & 15, fq = lane >> 4;
    const int K = g.K, nt = K / BK;
    unsigned voffA[2], voffB[2];
#pragma unroll
    for (int i = 0; i < 2; ++i) { int R, C; stage_rc(tid * 16 + i * 8192, R, C); const int Rb = Epi::PERM ? ((R & ~31) + perm32(R & 31)) : R;
        voffA[i] = (unsigned)(R * K + C) * 2u; voffB[i] = (unsigned)(Rb * K + C) * 2u; }
    const size_t kstep = (size_t)(BK * 2);
    const size_t hstep = (size_t)HALF * K * 2;
    const size_t tstep = 2 * hstep;
    const unsigned ldsw = (unsigned)wid * 1024u;
    const int aoff = lds_byte(wr * 64 + fr, fq * 8), boff = lds_byte(wc * 32 + fr, fq * 8);
#define PG8_SA(b, h) (((b) * 2 + (h)) * HTB)
#define PG8_SB(b, h) ((4 + (b) * 2 + (h)) * HTB)
#define PG8_STAGE(bufoff, gbase, voff) do { _Pragma("unroll") for (int _i = 0; _i < 2; ++_i) \
        __builtin_amdgcn_global_load_lds((const unsigned*)((const char*)(gbase) + (voff)[_i]), (PG8_LAS unsigned*)(lds + (bufoff) + ldsw + _i * 8192), 16, 0, 0); } while (0)
#define PG8_LDA(dst, b, h) do { _Pragma("unroll") for (int m = 0; m < 4; ++m) _Pragma("unroll") for (int k = 0; k < 2; ++k) dst[m][k] = *(const PG8_LAS bf16x8*)(lds + PG8_SA(b, h) + aoff + m * 2048 + k * 1024); } while (0)
#define PG8_LDB(dst, b, h) do { _Pragma("unroll") for (int n = 0; n < 2; ++n) _Pragma("unroll") for (int k = 0; k < 2; ++k) dst[n][k] = *(const PG8_LAS bf16x8*)(lds + PG8_SB(b, h) + boff + n * 2048 + k * 1024); } while (0)
#define PG8_MMA(ai, bj, At, Bt) do { __builtin_amdgcn_s_setprio(1); _Pragma("unroll") for (int m = 0; m < 4; ++m) _Pragma("unroll") for (int n = 0; n < 2; ++n) _Pragma("unroll") for (int k = 0; k < 2; ++k) \
        acc[ai][bj][m][n] = __builtin_amdgcn_mfma_f32_16x16x32_bf16(Bt[n][k], At[m][k], acc[ai][bj][m][n], 0, 0, 0); __builtin_amdgcn_s_setprio(0); } while (0)
#define PG8_WAIT_V(n) asm volatile("s_waitcnt vmcnt(" #n ")" ::: "memory")
#define PG8_WAIT_L(n) asm volatile("s_waitcnt lgkmcnt(" #n ")" ::: "memory")
#define PG8_BAR __builtin_amdgcn_s_barrier()
#define PG8_SCHED __builtin_amdgcn_sched_barrier(0)
    Unit cur, nxt; int ui = 0;
    if (!S.next(0, cur)) return;
    f32x4 acc[2][2][4][2];
#pragma unroll
    for (int a = 0; a < 2; ++a)
#pragma unroll
        for (int b = 0; b < 2; ++b)
#pragma unroll
            for (int m = 0; m < 4; ++m)
#pragma unroll
                for (int n = 0; n < 2; ++n) acc[a][b][m][n] = (f32x4){0.f, 0.f, 0.f, 0.f};
    bf16x8 At[4][2], B0[2][2], B1[2][2];
    const char* cA = (const char*)g.A + (size_t)cur.pm * tstep; const char* cB = (const char*)g.Bt + (size_t)cur.pn * tstep;
    S.a_ready(cur);
    if constexpr (SP2) {
        PG8_STAGE(PG8_SB(0, 0), cB, voffB); PG8_STAGE(PG8_SB(0, 1), cB + hstep, voffB); PG8_STAGE(PG8_SA(0, 0), cA, voffA); PG8_STAGE(PG8_SA(0, 1), cA + hstep, voffA);
        if (wr == 1) PG8_BAR;
        PG8_WAIT_V(2); PG8_BAR;
        PG8_STAGE(PG8_SB(1, 0), cB + kstep, voffB); PG8_STAGE(PG8_SA(1, 0), cA + kstep, voffA); PG8_STAGE(PG8_SB(1, 1), cB + hstep + kstep, voffB);
        PG8_WAIT_V(6); PG8_BAR;
    } else {
        PG8_STAGE(PG8_SB(0, 0), cB, voffB); PG8_STAGE(PG8_SA(0, 0), cA, voffA); PG8_STAGE(PG8_SB(0, 1), cB + hstep, voffB); PG8_STAGE(PG8_SA(0, 1), cA + hstep, voffA);
        if (wr == 1) PG8_BAR;
        PG8_WAIT_V(4); PG8_BAR;
        PG8_STAGE(PG8_SB(1, 0), cB + kstep, voffB); PG8_STAGE(PG8_SA(1, 0), cA + kstep, voffA); PG8_STAGE(PG8_SB(1, 1), cB + hstep + kstep, voffB);
        PG8_WAIT_V(6); PG8_BAR;
    }
    for (;;) {
        const bool has_next = S.next(ui + 1, nxt);
        const char* nA = has_next ? (const char*)g.A + (size_t)nxt.pm * tstep : cA; const char* nB = has_next ? (const char*)g.Bt + (size_t)nxt.pn * tstep : cB;
        for (int t = 0; t < nt; t += 2) {
            const bool last = (t == nt - 2);
            const char* a1 = cA + (size_t)(t + 1) * kstep;
            const char* a2 = last ? nA : cA + (size_t)(t + 2) * kstep; const char* b2 = last ? nB : cB + (size_t)(t + 2) * kstep;
            const char* a3 = a2 + kstep; const char* b3 = b2 + kstep;
            if (last && has_next) S.a_ready(nxt);
            if constexpr (SP2) {
            PG8_LDB(B0, 0, 0); PG8_LDB(B1, 0, 1); PG8_SCHED; PG8_LDA(At, 0, 0); PG8_STAGE(PG8_SA(1, 1), a1 + hstep, voffA);
            PG8_WAIT_V(8); PG8_WAIT_L(0); PG8_BAR; PG8_MMA(0, 0, At, B0); PG8_MMA(0, 1, At, B1); PG8_BAR; PG8_SCHED;
            PG8_LDA(At, 0, 1); PG8_STAGE(PG8_SB(0, 0), b2, voffB); PG8_STAGE(PG8_SB(0, 1), b2 + hstep, voffB); PG8_STAGE(PG8_SA(0, 0), a2, voffA);
            PG8_WAIT_V(8); PG8_WAIT_L(0); PG8_BAR; PG8_MMA(1, 0, At, B0); PG8_MMA(1, 1, At, B1); PG8_BAR; PG8_SCHED;
            PG8_LDB(B0, 1, 0); PG8_LDB(B1, 1, 1); PG8_SCHED; PG8_LDA(At, 1, 0); PG8_STAGE(PG8_SA(0, 1), a2 + hstep, voffA);
            PG8_WAIT_V(8); PG8_WAIT_L(0); PG8_BAR; PG8_MMA(0, 0, At, B0); PG8_MMA(0, 1, At, B1); PG8_BAR; PG8_SCHED;
            PG8_LDA(At, 1, 1); PG8_STAGE(PG8_SB(1, 0), b3, voffB); PG8_STAGE(PG8_SB(1, 1), b3 + hstep, voffB); PG8_STAGE(PG8_SA(1, 0), a3, voffA);
            PG8_WAIT_V(8); PG8_WAIT_L(0); PG8_BAR; PG8_MMA(1, 0, At, B0); PG8_MMA(1, 1, At, B1); PG8_BAR; PG8_SCHED;
            } else {
            PG8_LDB(B0, 0, 0); PG8_SCHED; PG8_LDA(At, 0, 0); PG8_STAGE(PG8_SA(1, 1), a1 + hstep, voffA);
            PG8_WAIT_L(8); PG8_BAR; PG8_WAIT_L(0); PG8_MMA(0, 0, At, B0); PG8_BAR; PG8_SCHED;
            PG8_LDB(B1, 0, 1); PG8_STAGE(PG8_SB(0, 0), b2, voffB);
            PG8_BAR; PG8_WAIT_L(0); PG8_MMA(0, 1, At, B1); PG8_BAR;
            PG8_LDA(At, 0, 1); PG8_STAGE(PG8_SA(0, 0), a2, voffA);
            PG8_BAR; PG8_WAIT_L(0); PG8_MMA(1, 0, At, B0); PG8_BAR; PG8_SCHED;
            PG8_STAGE(PG8_SB(0, 1), b2 + hstep, voffB);
            PG8_WAIT_V(6); PG8_BAR; PG8_MMA(1, 1, At, B1); PG8_BAR;
            PG8_LDB(B0, 1, 0); PG8_SCHED; PG8_LDA(At, 1, 0); PG8_STAGE(PG8_SA(0, 1), a2 + hstep, voffA);
            PG8_WAIT_L(8); PG8_BAR; PG8_WAIT_L(0); PG8_MMA(0, 0, At, B0); PG8_BAR; PG8_SCHED;
            PG8_LDB(B1, 1, 1); PG8_STAGE(PG8_SB(1, 0), b3, voffB);
            PG8_BAR; PG8_WAIT_L(0); PG8_MMA(0, 1, At, B1); PG8_BAR;
            PG8_LDA(At, 1, 1); PG8_STAGE(PG8_SA(1, 0), a3, voffA);
            PG8_BAR; PG8_WAIT_L(0); PG8_MMA(1, 0, At, B0); PG8_BAR; PG8_SCHED;
            PG8_STAGE(PG8_SB(1, 1), b3 + hstep, voffB);
            PG8_WAIT_V(6); PG8_BAR; PG8_MMA(1, 1, At, B1); PG8_BAR;
            }
        }
        if constexpr (ALIGN_EPI) { if (wr == 0) PG8_BAR; }
        if constexpr (!Epi::AFTER_DRAIN) { E(acc, cur, wr, wc, fr, fq); S.done(cur); }
        if (!has_next) break;
#pragma unroll
        for (int a = 0; a < 2; ++a)
#pragma unroll
            for (int b = 0; b < 2; ++b)
#pragma unroll
                for (int m = 0; m < 4; ++m)
#pragma unroll
                    for (int n = 0; n < 2; ++n) acc[a][b][m][n] = (f32x4){0.f, 0.f, 0.f, 0.f};
        cur = nxt; cA = nA; cB = nB; ++ui;
        if constexpr (ALIGN_EPI) { if (wr == 1) PG8_BAR; }
    }
    PG8_WAIT_V(0);
    if constexpr (!ALIGN_EPI) { if (wr == 0) PG8_BAR; }
    PG8_BAR;
    if constexpr (Epi::AFTER_DRAIN) { E.fused(acc, cur, wr, wc, fr, fq, lds, wid, lane); S.done(cur); }
#undef PG8_SA
#undef PG8_SB
#undef PG8_STAGE
#undef PG8_LDA
#undef PG8_LDB
#undef PG8_MMA
#undef PG8_WAIT_V
#undef PG8_WAIT_L
#undef PG8_BAR
#undef PG8_SCHED
}
}
namespace fk {
struct Frame {
    LAS unsigned char* lds;
    volatile LAS unsigned* MISC;
    gu32* ctl;
    int tid, lane, wave, G, bid;
    const LAS unsigned* ptab;
    float* out;
    unsigned char* ws;
};
__device__ __forceinline__ const float* inp(const Frame& F, int i) { const unsigned lo = __builtin_amdgcn_readfirstlane(F.ptab[2 * i]), hi = __builtin_amdgcn_readfirstlane(F.ptab[2 * i + 1]); return (const float*)(((unsigned long long)hi << 32) | lo); }
__device__ __forceinline__ unsigned char* wlayer(const Frame& F, int l) { return F.ws + WS_W + (size_t)l * WL_LAYER; }
__device__ __forceinline__ u64* ssarr(const Frame& F, int j) { return (u64*)(F.ws + WS_SS) + (size_t)j * MP; }
__device__ __forceinline__ u64* sacc(const Frame& F, int l, int off) { return (u64*)(F.ws + WS_SACC) + (size_t)l * SA_LAYER + off; }
__device__ __forceinline__ float* xsbuf(const Frame& F, int j) { return (float*)(F.ws + WS_XS) + (size_t)j * NS * D; }
__device__ __forceinline__ float* rstdbuf(const Frame& F, int j) { return (float*)(F.ws + WS_RSTD) + j * 8; }

#define RELAUNDER(F) do { int t_ = threadIdx.x; asm volatile("" : "+v"(t_)); (F).tid = t_; (F).lane = t_ & 63; (F).wave = __builtin_amdgcn_readfirstlane(t_ >> 6); } while (0)
template <int MAP> __device__ __forceinline__ int dest_row(int n) {
    if (MAP == 1) return (n >> 7) * 256 + (n & 127);
    if (MAP == 2) return (n >> 7) * 256 + 128 + (n & 127);
    if (MAP == 3) { if (n >= 1536) return n; const int tile = n >> 8, loc = n & 255, hh = loc >> 6, d = loc & 63; return tile * 256 + (d >> 5) * 128 + hh * 32 + (d & 31); }
    return n;
}
template <int MAP> __device__ __forceinline__ void transpose_item(const float* W, const float* gk, int K, int N, bf16* WT, LAS float* scr, int item, int lane) {
    const int nblk = N >> 6, kb = item / nblk, nb = item - kb * nblk, k0 = kb * 64, n0 = nb * 64;
    const int lr = lane >> 4, lc = (lane & 15) * 4;
#pragma unroll 4
    for (int i = 0; i < 16; ++i) { const int kk = 4 * i + lr; f32x4 v = *(const GAS f32x4*)(W + (size_t)(k0 + kk) * N + n0 + lc);
        if (gk != nullptr) v = v * gk[k0 + kk];
        LAS float* s = scr + kk * 65 + lc; s[0] = v[0]; s[1] = v[1]; s[2] = v[2]; s[3] = v[3]; }
    LDS_WAIT(); asm volatile("" ::: "memory");
    const int c = lane & 7;
#pragma unroll
    for (int jj = 0; jj < 8; ++jj) { const int n = (lane >> 3) + 8 * jj; const LAS float* s = scr + (8 * c) * 65 + n;
        v4u o; o.x = pk2(s[0], s[65]); o.y = pk2(s[2 * 65], s[3 * 65]); o.z = pk2(s[4 * 65], s[5 * 65]); o.w = pk2(s[6 * 65], s[7 * 65]);
        *(GAS v4u*)(WT + (size_t)dest_row<MAP>(n0 + n) * K + k0 + 8 * c) = o; }
    LDS_WAIT(); asm volatile("" ::: "memory");
}
__device__ __forceinline__ void p0_prologue(Frame& F) {
    LAS float* scr = (LAS float*)(F.lds + F.wave * 16640);
    const int gw = F.bid * NWAVES + F.wave, NGW = F.G * NWAVES;
    constexpr int I_GU = (D / 64) * (FF / 64), I_DN = (FF / 64) * (D / 64), I_IN = (D / 64) * (MIXP / 64), I_OUT = (D / 64) * (D / 64);
    constexpr int PER_LAYER = 6 * I_GU + I_IN + I_OUT;
    static_assert(I_GU == I_DN, "item counts");
    for (int it = gw; it < L * PER_LAYER; it += NGW) {
        const int l = it / PER_LAYER; int r = it - l * PER_LAYER;
        unsigned char* wl = wlayer(F, l);
        const size_t o1 = (size_t)l * D * FF, o2 = (size_t)l * D;
        if (r < I_GU) { transpose_item<1>(inp(F, 8) + o1, inp(F, 7) + o2, D, FF, (bf16*)(wl + WL_GU1), scr, r, F.lane); continue; } r -= I_GU;
        if (r < I_GU) { transpose_item<2>(inp(F, 9) + o1, inp(F, 7) + o2, D, FF, (bf16*)(wl + WL_GU1), scr, r, F.lane); continue; } r -= I_GU;
        if (r < I_DN) { transpose_item<0>(inp(F, 10) + o1, nullptr, FF, D, (bf16*)(wl + WL_D1), scr, r, F.lane); continue; } r -= I_DN;
        if (r < I_IN) { transpose_item<3>(inp(F, 12) + (size_t)l * D * MIXP, inp(F, 11) + o2, D, MIXP, (bf16*)(wl + WL_IN), scr, r, F.lane); continue; } r -= I_IN;
        if (r < I_OUT) { transpose_item<0>(inp(F, 28) + (size_t)l * D * D, nullptr, D, D, (bf16*)(wl + WL_OUT), scr, r, F.lane); continue; } r -= I_OUT;
        if (r < I_GU) { transpose_item<1>(inp(F, 30) + o1, inp(F, 29) + o2, D, FF, (bf16*)(wl + WL_GU2), scr, r, F.lane); continue; } r -= I_GU;
        if (r < I_GU) { transpose_item<2>(inp(F, 31) + o1, inp(F, 29) + o2, D, FF, (bf16*)(wl + WL_GU2), scr, r, F.lane); continue; } r -= I_GU;
        transpose_item<0>(inp(F, 32) + o1, nullptr, FF, D, (bf16*)(wl + WL_D2), scr, r, F.lane);
    }
    const int gt = F.bid * NTHREADS + F.tid, NGT = F.G * NTHREADS;
    for (int i = gt; i < L * RW * 256; i += NGT) { const int l = i / (RW * 256), r = i - l * RW * 256, c = r >> 8, j = r & 255;
        unsigned char* wl = wlayer(F, l);
        if (j < 64) ((bf16*)(wl + WL_W2T))[c * 64 + j] = (bf16)f2bf(inp(F, 17)[((size_t)l * 64 + j) * RW + c]);
        else if (j < 128) ((bf16*)(wl + WL_A2T))[c * 64 + (j - 64)] = (bf16)f2bf(inp(F, 19)[((size_t)l * 64 + (j - 64)) * RW + c]);
        else ((bf16*)(wl + WL_G2T))[c * 128 + (j - 128)] = (bf16)f2bf(inp(F, 20)[((size_t)l * 128 + (j - 128)) * RW + c]); }
    u64* ss0 = ssarr(F, 0); bf16* XB = (bf16*)(F.ws + WS_XB);
    for (int m = gw; m < MP; m += NGW) { const GAS f32x4* xr = (const GAS f32x4*)(inp(F, 0) + (size_t)m * D) + F.lane; GAS f32x4* xo = (GAS f32x4*)(F.out + O_Y + (size_t)m * D) + F.lane;
        GAS v2u* xb = (GAS v2u*)(XB + (size_t)m * D) + F.lane; float s = 0.f;
#pragma unroll
        for (int j = 0; j < 8; ++j) { const f32x4 v = xr[64 * j]; xo[64 * j] = v; v2u p; p.x = pk2(v[0], v[1]); p.y = pk2(v[2], v[3]); xb[64 * j] = p; s += (v[0] * v[0] + v[1] * v[1]) + (v[2] * v[2] + v[3] * v[3]); }
        s = wave_sum(s); if (F.lane == 0) ss0[m] = ss_enc(s); }
}

__device__ __forceinline__ void sample_x_prep(Frame& F, int j, const float* xprev, const u64* accprev, float c, LAS bf16* Alds, LAS float* red) {
    f32x4 v[8]; float sq[8];
#pragma unroll
    for (int i = 0; i < 8; ++i) { v[i] = *(const GAS f32x4*)(xprev + i * D + 4 * F.tid);
        if (accprev != nullptr) { const u64* ap = accprev + i * D + 4 * F.tid; v[i] = v[i] + (f32x4){fx_dec(ap[0]), fx_dec(ap[1]), fx_dec(ap[2]), fx_dec(ap[3])} * c; }
        sq[i] = wave_sum((v[i][0] * v[i][0] + v[i][1] * v[i][1]) + (v[i][2] * v[i][2] + v[i][3] * v[i][3]));
        v2u p; p.x = pk2(v[i][0], v[i][1]); p.y = pk2(v[i][2], v[i][3]); *(LAS v2u*)(Alds + i * D + 4 * F.tid) = p; }
    if (F.lane == 0) {
#pragma unroll
        for (int i = 0; i < 8; ++i) red[F.wave * 8 + i] = sq[i]; }
    __syncthreads();
    if (F.bid == 0) {
        if (j > 0) {
#pragma unroll
            for (int i = 0; i < 8; ++i) *(GAS f32x4*)(xsbuf(F, j) + i * D + 4 * F.tid) = v[i]; }
        if (F.tid < 8) { float s = 0.f;
#pragma unroll
            for (int w = 0; w < 8; ++w) s += red[w * 8 + F.tid];
            rstdbuf(F, j)[F.tid] = 1.0f / sqrtf(s * (1.0f / D) + EPS); }
    }
}
__device__ __forceinline__ void skinny_task(const bf16* Bt, int K, int cg, int k0, int nks, const LAS bf16* Alds, int lda, int a_k0, u64* accout, int N, int lane) {
    const bf16* brow = Bt + (size_t)(cg * 16 + (lane & 15)) * K + k0 + 8 * (lane >> 4);
    const LAS bf16* arow = Alds + (lane & 7) * lda + (k0 - a_k0) + 8 * (lane >> 4);
    f32x4 acc = (f32x4){0.f, 0.f, 0.f, 0.f};
#pragma unroll 4
    for (int ks = 0; ks < nks; ++ks) { const bf16x8 w = *(const GAS bf16x8*)(brow + 32 * ks); const bf16x8 x = *(const LAS bf16x8*)(arow + 32 * ks);
        acc = __builtin_amdgcn_mfma_f32_16x16x32_bf16(w, x, acc, 0, 0, 0); }
    if ((lane & 15) < 8) { u64* o = accout + (size_t)(lane & 15) * N + cg * 16 + 4 * (lane >> 4);
#pragma unroll
        for (int r = 0; r < 4; ++r) (void)__hip_atomic_fetch_add(o + r, fx_enc(acc[r]), __ATOMIC_RELAXED, __HIP_MEMORY_SCOPE_AGENT); }
}
__device__ __forceinline__ void skinny_gemm(Frame& F, const bf16* Bt, int N, int K, int KS, const LAS bf16* Alds, int lda, bool a_is_slice, u64* accout) {
    const int ks = F.bid % KS, jj = F.bid / KS, per = F.G / KS;
    const int klen = K / KS, k0 = ks * klen;
    for (int cg = jj * NWAVES + F.wave; cg < N / 16; cg += per * NWAVES) skinny_task(Bt, K, cg, k0, klen / 32, Alds, lda, a_is_slice ? k0 : 0, accout, N, F.lane);
}
__device__ __forceinline__ void sample_proj(Frame& F, int j, const float* xprev, const u64* accprev, float c, const bf16* Bt, int N, u64* accout) {
    LAS bf16* Alds = (LAS bf16*)F.lds; LAS float* red = (LAS float*)(F.lds + 65536);
    sample_x_prep(F, j, xprev, accprev, c, Alds, red);
    __syncthreads();
    skinny_gemm(F, Bt, N, D, 4, Alds, D, false, accout);
    __syncthreads();
}
__device__ __forceinline__ void sample_down(Frame& F, const u64* accgu, const float* rstd, const bf16* Bt, u64* accout) {
    LAS bf16* Alds = (LAS bf16*)F.lds; constexpr int KS = 16, KL = FF / KS;
    const int k0 = (F.bid % KS) * KL;
    for (int e = F.tid; e < 8 * KL; e += NTHREADS) { const int r = e / KL, kk = e - r * KL, k = k0 + kk; const float rs = rstd[r];
        const int rho = (k >> 7) * 256 + (k & 127); const float g = fx_dec(accgu[(size_t)r * NGU + rho]) * rs, u = fx_dec(accgu[(size_t)r * NGU + rho + 128]) * rs;
        Alds[r * KL + kk] = (bf16)f2bf(g / (1.0f + __expf(-g)) * u); }
    __syncthreads();
    skinny_gemm(F, Bt, D, FF, KS, Alds, KL, true, accout);
    __syncthreads();
}
__device__ __forceinline__ void sample_wout(Frame& F, const float* mixs, const bf16* Bt, u64* accout) {
    LAS bf16* Alds = (LAS bf16*)F.lds;
#pragma unroll
    for (int i = 0; i < 8; ++i) { const f32x4 v = *(const GAS f32x4*)(mixs + i * D + 4 * F.tid); v2u p; p.x = pk2(v[0], v[1]); p.y = pk2(v[2], v[3]); *(LAS v2u*)(Alds + i * D + 4 * F.tid) = p; }
    __syncthreads();
    skinny_gemm(F, Bt, D, D, 16, Alds, D, false, accout);
    __syncthreads();
}

constexpr int M1_TASK_LDS = 40960 + 512;
constexpr int LORS = 264;
__device__ __forceinline__ void m1_phase(Frame& F, int l) {
    RELAUNDER(F);
    const int half = F.wave >> 2, wv = F.wave & 3, tid2 = F.tid & 255, lane = F.lane, kg = lane & 7, rg = lane >> 3;
    LAS unsigned char* tb = F.lds + half * M1_TASK_LDS;
    LAS float* VW = (LAS float*)tb;
    LAS float* VA = VW + 1024;
    LAS float* VBv = VW + 2048;
    LAS float* VK = VW + 3072;
    LAS float* VR = VW + 4096;
    LAS float* VV = VW + 5120;
    LAS bf16* LOR = (LAS bf16*)(tb + 24576);
    constexpr int KR_OFF = (24576 + 16 * LORS * 2) / 4;
    LAS float* KR = VW + KR_OFF;
    LAS float* AS = KR + 1024;
    const bf16* PR = (const bf16*)(F.ws + WS_PR);
    const unsigned char* wl = wlayer(F, l);
    const bf16* w2T = (const bf16*)(wl + WL_W2T); const bf16* a2T = (const bf16*)(wl + WL_A2T); const bf16* g2T = (const bf16*)(wl + WL_G2T);
    const float* mu = inp(F, 15) + (size_t)l * RP; const float* w0 = inp(F, 16) + (size_t)l * RW; const float* a0 = inp(F, 18) + (size_t)l * RW;
    const float* k_k = inp(F, 21) + (size_t)l * RW; const float* k_a = inp(F, 22) + (size_t)l * RW; const float* r_k = inp(F, 23) + (size_t)l * RW;
    float* RT = (float*)(F.ws + WS_RT); float* YZ = (float*)(F.ws + WS_YZ); float* GG = (float*)(F.ws + WS_GG); float* BON = (float*)(F.ws + WS_BON); float* PC = (float*)(F.ws + WS_PC);
    for (int item = F.bid; item < NTASK / 2; item += F.G) {
        const int task = item * 2 + half, nh = task / NCH, c = task - nh * NCH, n = nh / RH, h = nh - n * RH;
        float S[4][8];
#pragma unroll
        for (int i = 0; i < 4; ++i)
#pragma unroll
            for (int j = 0; j < 8; ++j) S[i][j] = (wv < 2 && (32 * wv + 4 * rg + i) == (8 * kg + j)) ? 1.0f : 0.0f;
        for (int sc = 0; sc < 4; ++sc) {
            const int t0 = c * CH + sc * 16;
            for (int q = tid2; q < 16 * 56; q += 256) { const int tok = q / 56, ch = q - tok * 56;
                const int col = ch < 8 ? 64 * h + 8 * ch : (ch < 16 ? RW + 64 * h + 8 * (ch - 8) : (ch < 24 ? 2 * RW + 64 * h + 8 * (ch - 16) : 3 * RW + 8 * (ch - 24)));
                const size_t row = (size_t)n * T + t0 + tok;
                const v4u p8 = *(const GAS v4u*)(PR + row * PRW + col);
                v4u q8 = (v4u){0u, 0u, 0u, 0u}; if (t0 + tok > 0) q8 = *(const GAS v4u*)(PR + (row - 1) * PRW + col);
                const f32x4 m0 = *(const GAS f32x4*)(mu + col), m1 = *(const GAS f32x4*)(mu + col + 4);
                float xm[8];
                { const unsigned pw[4] = {p8.x, p8.y, p8.z, p8.w}, qw[4] = {q8.x, q8.y, q8.z, q8.w};
#pragma unroll
                  for (int e = 0; e < 4; ++e) { const float pl = bflo(pw[e]), ph = bfhi(pw[e]), ql = bflo(qw[e]), qh = bfhi(qw[e]);
                      const float ml = e < 2 ? m0[2 * e] : m1[2 * e - 4], mh = e < 2 ? m0[2 * e + 1] : m1[2 * e - 3];
                      xm[2 * e] = pl + (ql - pl) * ml; xm[2 * e + 1] = ph + (qh - ph) * mh; } }
                if (ch < 24) { LAS float* dst = VW + (ch < 8 ? 4096 : (ch < 16 ? KR_OFF : 5120)) + tok * 64 + 8 * (ch & 7);
                    *(LAS f32x4*)dst = (f32x4){xm[0], xm[1], xm[2], xm[3]}; *(LAS f32x4*)(dst + 4) = (f32x4){xm[4], xm[5], xm[6], xm[7]}; }
                else { const int jc = 8 * (ch - 24);
#pragma unroll
                    for (int e = 0; e < 8; ++e) { if (jc < 64) xm[e] = 1.0f - 2.0f / (1.0f + __expf(2.0f * xm[e])); else if (jc >= 128) xm[e] = sigmoidf_(xm[e]); }
                    v4u o; o.x = pk2(xm[0], xm[1]); o.y = pk2(xm[2], xm[3]); o.z = pk2(xm[4], xm[5]); o.w = pk2(xm[6], xm[7]);
                    *(LAS v4u*)(LOR + tok * LORS + jc) = o; }
            }
            __syncthreads();
            { const int ci = 16 * wv + (lane & 15), c768 = 64 * h + ci, kq = 8 * (lane >> 4);
              f32x4 aw = (f32x4){0.f, 0.f, 0.f, 0.f}, aa = aw, ag = aw;
              const LAS bf16* arow = LOR + (lane & 15) * LORS + kq;
#pragma unroll
              for (int ks = 0; ks < 2; ++ks) { const bf16x8 a = *(const LAS bf16x8*)(arow + 32 * ks); const bf16x8 b = *(const GAS bf16x8*)(w2T + (size_t)c768 * 64 + 32 * ks + kq);
                  aw = __builtin_amdgcn_mfma_f32_16x16x32_bf16(a, b, aw, 0, 0, 0); }
#pragma unroll
              for (int ks = 0; ks < 2; ++ks) { const bf16x8 a = *(const LAS bf16x8*)(arow + 64 + 32 * ks); const bf16x8 b = *(const GAS bf16x8*)(a2T + (size_t)c768 * 64 + 32 * ks + kq);
                  aa = __builtin_amdgcn_mfma_f32_16x16x32_bf16(a, b, aa, 0, 0, 0); }
#pragma unroll
              for (int ks = 0; ks < 4; ++ks) { const bf16x8 a = *(const LAS bf16x8*)(arow + 128 + 32 * ks); const bf16x8 b = *(const GAS bf16x8*)(g2T + (size_t)c768 * 128 + 32 * ks + kq);
                  ag = __builtin_amdgcn_mfma_f32_16x16x32_bf16(a, b, ag, 0, 0, 0); }
              const float w0c = w0[c768], a0c = a0[c768];
#pragma unroll
              for (int r = 0; r < 4; ++r) { const int tok = 4 * (lane >> 4) + r;
                  VW[tok * 64 + ci] = __expf(-0.60653065971f * sigmoidf_(w0c + aw[r]));
                  AS[tok * 64 + ci] = sigmoidf_(a0c + aa[r]);
                  GG[((size_t)nh * T + t0 + tok) * 64 + ci] = ag[r]; } }
            __syncthreads();
            { const int tok = tid2 >> 4, i4 = 4 * (tid2 & 15), cc = 64 * h + i4;
              const f32x4 kr = *(const LAS f32x4*)(KR + tok * 64 + i4), as = *(const LAS f32x4*)(AS + tok * 64 + i4), rr = *(const LAS f32x4*)(VR + tok * 64 + i4), vv = *(const LAS f32x4*)(VV + tok * 64 + i4);
              const f32x4 kkw = *(const GAS f32x4*)(k_k + cc), kaw = *(const GAS f32x4*)(k_a + cc), rkw = *(const GAS f32x4*)(r_k + cc);
              f32x4 kk = kr * kkw; float sq = (kk[0] * kk[0] + kk[1] * kk[1]) + (kk[2] * kk[2] + kk[3] * kk[3]); sq = sum16(sq);
              kk = kk * (1.0f / fmaxf(sqrtf(sq), 1e-12f));
              const f32x4 km = kr * ((as - 1.0f) * kaw + 1.0f);
              float bs = (rr[0] * km[0] * rkw[0] + rr[1] * km[1] * rkw[1]) + (rr[2] * km[2] * rkw[2] + rr[3] * km[3] * rkw[3]); bs = sum16(bs);
              *(LAS f32x4*)(VA + tok * 64 + i4) = -kk; *(LAS f32x4*)(VBv + tok * 64 + i4) = kk * as; *(LAS f32x4*)(VK + tok * 64 + i4) = km;
              *(GAS f32x4*)(BON + ((size_t)nh * T + t0 + tok) * 64 + i4) = vv * bs; }
            __syncthreads();
            { float* yout = RT + (size_t)(wv >> 1) * ((WS_YZ - WS_RT) / 4) + ((size_t)nh * T + t0) * 64 + 32 * (wv & 1) + 4 * rg;
              const int vofs = 32 * (wv & 1) + 4 * rg;
              for (int st = 0; st < 16; ++st) {
                  const f32x4 a0v = *(const LAS f32x4*)(VA + st * 64 + 8 * kg), a1v = *(const LAS f32x4*)(VA + st * 64 + 8 * kg + 4);
                  float sa[4];
#pragma unroll
                  for (int i = 0; i < 4; ++i) { float s = S[i][0] * a0v[0]; s += S[i][1] * a0v[1]; s += S[i][2] * a0v[2]; s += S[i][3] * a0v[3]; s += S[i][4] * a1v[0]; s += S[i][5] * a1v[1]; s += S[i][6] * a1v[2]; s += S[i][7] * a1v[3]; sa[i] = sum8(s); }
                  const f32x4 w0v = *(const LAS f32x4*)(VW + st * 64 + 8 * kg), w1v = *(const LAS f32x4*)(VW + st * 64 + 8 * kg + 4);
                  const f32x4 b0v = *(const LAS f32x4*)(VBv + st * 64 + 8 * kg), b1v = *(const LAS f32x4*)(VBv + st * 64 + 8 * kg + 4);
                  const f32x4 k0v = *(const LAS f32x4*)(VK + st * 64 + 8 * kg), k1v = *(const LAS f32x4*)(VK + st * 64 + 8 * kg + 4);
                  f32x4 vv = (f32x4){0.f, 0.f, 0.f, 0.f}; if (wv >= 2) vv = *(const LAS f32x4*)(VV + st * 64 + vofs);
                  const f32x4 r0v = *(const LAS f32x4*)(VR + st * 64 + 8 * kg), r1v = *(const LAS f32x4*)(VR + st * 64 + 8 * kg + 4);
                  f32x4 y;
#pragma unroll
                  for (int i = 0; i < 4; ++i) { float yy = 0.f;
#pragma unroll
                      for (int j = 0; j < 8; ++j) { const float wj = j < 4 ? w0v[j] : w1v[j - 4], bj = j < 4 ? b0v[j] : b1v[j - 4], kj = j < 4 ? k0v[j] : k1v[j - 4], rj = j < 4 ? r0v[j] : r1v[j - 4];
                          const float sn = S[i][j] * wj + sa[i] * bj + vv[i] * kj; S[i][j] = sn; yy += sn * rj; }
                      y[i] = sum8(yy); }
                  if (kg == 0) *(GAS f32x4*)(yout + st * 64) = y;
              } }
            __syncthreads();
        }
        { float* pc = PC + ((size_t)task * 2 + (wv >> 1)) * 4096 + (size_t)(32 * (wv & 1) + 4 * rg) * 64 + 8 * kg;
#pragma unroll
          for (int i = 0; i < 4; ++i) { *(GAS f32x4*)(pc + i * 64) = (f32x4){S[i][0], S[i][1], S[i][2], S[i][3]}; *(GAS f32x4*)(pc + i * 64 + 4) = (f32x4){S[i][4], S[i][5], S[i][6], S[i][7]}; } }
    }
}

__device__ __forceinline__ void m2_carry(Frame& F, int l) {
    RELAUNDER(F);
    const int nh = F.bid >> 2, qv = F.bid & 3, i = F.tid >> 5, x = F.tid & 31;
    LAS float* Sl = (LAS float*)F.lds;
    LAS float* Pl = (LAS float*)(F.lds + 8192);
    const float* PC = (const float*)(F.ws + WS_PC); float* SC = (float*)(F.ws + WS_SC);
    float zz = 0.f; asm volatile("" : "+v"(zz));
    f32x2 s = (f32x2){zz, zz};
    *(LAS f32x2*)(Sl + i * 64 + 2 * x) = s;
    int cur = 0;
    f32x4 p0, p1; f32x2 z;
    { const float* pc = PC + (size_t)(nh * NCH) * 2 * 4096; p0 = *(const GAS f32x4*)(pc + 8 * F.tid); p1 = *(const GAS f32x4*)(pc + 8 * F.tid + 4); z = *(const GAS f32x2*)(pc + 4096 + (16 * qv + i) * 64 + 2 * x); }
    for (int c = 0; c < NCH; ++c) {
        const int task = nh * NCH + c;
        *(GAS f32x2*)(SC + (size_t)task * 4096 + (16 * qv + i) * 64 + 2 * x) = s;
        *(LAS f32x4*)(Pl + 8 * F.tid) = p0; *(LAS f32x4*)(Pl + 8 * F.tid + 4) = p1;
        __syncthreads();
        f32x2 o = z;
        if (c + 1 < NCH) { const float* pc = PC + (size_t)(task + 1) * 2 * 4096; p0 = *(const GAS f32x4*)(pc + 8 * F.tid); p1 = *(const GAS f32x4*)(pc + 8 * F.tid + 4); z = *(const GAS f32x2*)(pc + 4096 + (16 * qv + i) * 64 + 2 * x); }
        const LAS float* sr = Sl + cur * 1024 + i * 64;
#pragma unroll 8
        for (int k = 0; k < 64; ++k) { const float sv = sr[k]; const f32x2 pp = *(const LAS f32x2*)(Pl + k * 64 + 2 * x); o[0] += sv * pp[0]; o[1] += sv * pp[1]; }
        s = o; cur ^= 1;
        *(LAS f32x2*)(Sl + cur * 1024 + i * 64 + 2 * x) = s;
        __syncthreads();
    }
    const int n = nh / RH, h = nh - n * RH;
    *(GAS f32x2*)(F.out + O_PWKV + ((((size_t)l * NB + n) * RH + h) * 64 + 16 * qv + i) * 64 + 2 * x) = s;
}
__device__ __forceinline__ int crow(int r, int hi) { return (r & 3) + 8 * (r >> 2) + 4 * hi; }
typedef __bf16 bf16x2_t __attribute__((ext_vector_type(2)));
__device__ __forceinline__ unsigned cvtpk_s(float lo, float hi) { f32x2 v = {lo, hi}; bf16x2_t b = __builtin_convertvector(v, bf16x2_t); return __builtin_bit_cast(unsigned, b); }
typedef short v4i16_t __attribute__((ext_vector_type(4)));
__device__ __forceinline__ s16x4 vtr(const LAS unsigned char* p) { return __builtin_bit_cast(s16x4, __builtin_amdgcn_ds_read_tr16_b64_v4i16((LAS v4i16_t*)p)); }
__device__ __forceinline__ void m2_attn_item(Frame& F, int it) {
    const int half = F.wave >> 2, wv = F.wave & 3, tid2 = F.tid & 255, lane = F.lane, l31 = lane & 31, hi = lane >> 5;
    const int unit = it * 2 + half, g = unit >> 9, rem = unit & 511, nh = rem >> 4, idx = rem & 15, n = nh >> 3, h = nh & 7;
    const int dil = g == 0 ? 1 : (g == 1 ? 4 : 16), r = g == 0 ? 0 : (g == 1 ? (idx >> 2) : idx), b = g == 0 ? idx : (g == 1 ? (idx & 3) : 0);
    LAS unsigned char* Vl = F.lds + half * 32768;
    const bf16* QN = (const bf16*)(F.ws + WS_QN); const bf16* KN = (const bf16*)(F.ws + WS_KN); const bf16* VB = (const bf16*)(F.ws + WS_VB);
    const size_t rowbase = (size_t)n * T + r;
    for (int q = tid2; q < 2048; q += 256) { const int key = q >> 3, ch = q & 7, sp = 128 * (b - 1) + key; v4u v = (v4u){0u, 0u, 0u, 0u};
        if (sp >= 0) v = *(const GAS v4u*)(VB + (rowbase + (size_t)dil * sp) * AW + h * 64 + 8 * ch);
        *(LAS v4u*)(Vl + key * 128 + ch * 16) = v; }
    const int sq = 128 * b + 32 * wv + l31;
    bf16x8 qf[4];
    { const bf16* qp = QN + (rowbase + (size_t)dil * sq) * AW + h * 64 + 8 * hi;
#pragma unroll
      for (int ks = 0; ks < 4; ++ks) qf[ks] = *(const GAS bf16x8*)(qp + 16 * ks); }
    const float slope = exp2f(-(float)(h + 1)) * (float)dil;
    f32x16 sc[5];
#pragma unroll
    for (int kt = 0; kt < 5; ++kt) {
        const int kl0 = 32 * wv + 32 * kt;
        int sp = 128 * (b - 1) + kl0 + l31; sp = sp < 0 ? 0 : sp;
        const bf16* kp = KN + (rowbase + (size_t)dil * sp) * AW + h * 64 + 8 * hi;
        f32x16 a;
#pragma unroll
        for (int e = 0; e < 16; ++e) a[e] = 0.f;
#pragma unroll
        for (int ks = 0; ks < 4; ++ks) { const bf16x8 kf = *(const GAS bf16x8*)(kp + 16 * ks); a = __builtin_amdgcn_mfma_f32_32x32x16_bf16(kf, qf[ks], a, 0, 0, 0); }
#pragma unroll
        for (int e = 0; e < 16; ++e) { const int kl = kl0 + crow(e, hi), delta = 128 + 32 * wv + l31 - kl; const bool ok = delta >= 0 && delta <= 128 && (128 * (b - 1) + kl) >= 0;
            a[e] = ok ? a[e] - slope * (float)delta : -INFINITY; }
        sc[kt] = a;
    }
    float m = -INFINITY;
#pragma unroll
    for (int kt = 0; kt < 5; ++kt)
#pragma unroll
        for (int e = 0; e < 16; ++e) m = fmaxf(m, sc[kt][e]);
    m = fmaxf(m, __shfl_xor(m, 32));
    float lsum = 0.f;
#pragma unroll
    for (int kt = 0; kt < 5; ++kt)
#pragma unroll
        for (int e = 0; e < 16; ++e) { const float p = __expf(sc[kt][e] - m); sc[kt][e] = p; lsum += p; }
    lsum += __shfl_xor(lsum, 32);
    __syncthreads();
    f32x16 o[2];
#pragma unroll
    for (int e = 0; e < 16; ++e) { o[0][e] = 0.f; o[1][e] = 0.f; }
    const int i16 = lane & 15, qq = i16 >> 2, pp = i16 & 3, blk = (lane >> 4) & 1;
#pragma unroll
    for (int kt = 0; kt < 5; ++kt) {
        const int kl0 = 32 * wv + 32 * kt;
#pragma unroll
        for (int s2 = 0; s2 < 2; ++s2) {
            v4u pw; pw.x = cvtpk_s(sc[kt][8 * s2], sc[kt][8 * s2 + 1]); pw.y = cvtpk_s(sc[kt][8 * s2 + 2], sc[kt][8 * s2 + 3]); pw.z = cvtpk_s(sc[kt][8 * s2 + 4], sc[kt][8 * s2 + 5]); pw.w = cvtpk_s(sc[kt][8 * s2 + 6], sc[kt][8 * s2 + 7]);
            const bf16x8 pf = __builtin_bit_cast(bf16x8, pw);
#pragma unroll
            for (int dt = 0; dt < 2; ++dt) {
                const LAS unsigned char* base = Vl + (kl0 + 16 * s2 + 4 * hi + qq) * 128 + (32 * dt + 16 * blk + 4 * pp) * 2;
                const s16x4 lo = vtr(base), hh = vtr(base + 8 * 128);
                const bf16x8 vf = (bf16x8){lo[0], lo[1], lo[2], lo[3], hh[0], hh[1], hh[2], hh[3]};
                o[dt] = __builtin_amdgcn_mfma_f32_32x32x16_bf16(vf, pf, o[dt], 0, 0, 0);
            }
        }
    }
    const float inv = 1.0f / lsum;
    float* og = (float*)(F.ws + WS_OG) + ((size_t)g * MP + rowbase + (size_t)dil * sq) * AW + h * 64;
#pragma unroll
    for (int dt = 0; dt < 2; ++dt)
#pragma unroll
        for (int rq = 0; rq < 4; ++rq) *(GAS f32x4*)(og + 32 * dt + 8 * rq + 4 * hi) = (f32x4){o[dt][4 * rq] * inv, o[dt][4 * rq + 1] * inv, o[dt][4 * rq + 2] * inv, o[dt][4 * rq + 3] * inv};
    if (hi == 0) ((float*)(F.ws + WS_LSE))[((size_t)g * MP + rowbase + (size_t)dil * sq) * AH + h] = m + __logf(lsum);
    __syncthreads();
}
__device__ __forceinline__ void ld8f(const bf16* p, float (&o)[8]) { const v4u v = *(const GAS v4u*)p; o[0] = bflo(v.x); o[1] = bfhi(v.x); o[2] = bflo(v.y); o[3] = bfhi(v.y); o[4] = bflo(v.z); o[5] = bfhi(v.z); o[6] = bflo(v.w); o[7] = bfhi(v.w); }
__device__ __forceinline__ void m2_conv_item(Frame& F, int l, int it) {
    if (F.tid >= 384) return;
    const int c8 = F.tid % 96, rs = F.tid / 96, c = 8 * c8;
    const bf16* PR = (const bf16*)(F.ws + WS_PR) + RP; bf16* MIX = (bf16*)(F.ws + WS_MIX);
    const float* cw = inp(F, 26) + (size_t)l * 3 * CW; const float* cb = inp(F, 27) + (size_t)l * CW;
    float w0[8], w1[8], w2[8], bb[8];
#pragma unroll
    for (int e = 0; e < 8; ++e) { w0[e] = cw[c + e]; w1[e] = cw[CW + c + e]; w2[e] = cw[2 * CW + c + e]; bb[e] = cb[c + e]; }
    const int row0 = it * 64 + rs * 16, t00 = row0 & (T - 1);
    float z1[8], z2[8];
#pragma unroll
    for (int e = 0; e < 8; ++e) { z1[e] = 0.f; z2[e] = 0.f; }
    if (t00 >= 1) { float u[8], gc[8]; ld8f(PR + (size_t)(row0 - 1) * PRW + (c), u); ld8f(PR + (size_t)(row0 - 1) * PRW + (2 * CW + c), gc);
#pragma unroll
        for (int e = 0; e < 8; ++e) z1[e] = gc[e] * u[e]; }
    if (t00 >= 2) { float u[8], gc[8]; ld8f(PR + (size_t)(row0 - 2) * PRW + (c), u); ld8f(PR + (size_t)(row0 - 2) * PRW + (2 * CW + c), gc);
#pragma unroll
        for (int e = 0; e < 8; ++e) z2[e] = gc[e] * u[e]; }
    for (int rr = 0; rr < 16; ++rr) { const size_t row = (size_t)row0 + rr; float u[8], gb[8], gc[8], y[8]; ld8f(PR + (size_t)(row) * PRW + (c), u); ld8f(PR + (size_t)(row) * PRW + (CW + c), gb); ld8f(PR + (size_t)(row) * PRW + (2 * CW + c), gc);
#pragma unroll
        for (int e = 0; e < 8; ++e) { const float z0 = gc[e] * u[e]; y[e] = gb[e] * (bb[e] + w0[e] * z2[e] + w1[e] * z1[e] + w2[e] * z0); z2[e] = z1[e]; z1[e] = z0; }
        v4u o; o.x = pk2(y[0], y[1]); o.y = pk2(y[2], y[3]); o.z = pk2(y[4], y[5]); o.w = pk2(y[6], y[7]);
        *(GAS v4u*)(MIX + row * D + AW + RW + c) = o;
        if ((row & (T - 1)) == T - 1) { float* oc = F.out + O_PCV + ((size_t)l * NB + (row >> 11)) * 2 * CW + c;
#pragma unroll
            for (int e = 0; e < 8; ++e) { oc[e] = z2[e]; oc[CW + e] = z1[e]; } }
    }
}
__device__ __forceinline__ void m2_sample_item(Frame& F, int l, int n) {
    LAS float* P = (LAS float*)F.lds;
    LAS float* XM = P + 6400;
    LAS float* SCO = XM + 2560;
    LAS float* VEC = SCO + 8 * 3 * 132;
    LAS float* RED = VEC + 12 * 6 * 64;
    const u64* accp = sacc(F, l, SA_P) + (size_t)n * MIXP; const float rs = rstdbuf(F, 3 * l + 1)[n];
    for (int c = F.tid; c < MIXP; c += NTHREADS) P[c] = fx_dec(accp[dest_row<3>(c)]) * rs;
    __syncthreads();
    float* out = F.out; float* mixs = (float*)(F.ws + WS_MIXS) + ((size_t)l * NS + n) * D;
    { const int h = F.wave, lane = F.lane;
      float q = P[h * 64 + lane], k = P[AW + h * 64 + lane], v = P[2 * AW + h * 64 + lane];
      q = q * (1.0f / sqrtf(wave_sum(q * q) * (1.0f / 64.f) + EPS)) * inp(F, 13)[l * 64 + lane];
      k = k * (1.0f / sqrtf(wave_sum(k * k) * (1.0f / 64.f) + EPS)) * inp(F, 14)[l * 64 + lane];
      out[O_SK + ((size_t)l * NS + n) * AW + h * 64 + lane] = k; out[O_SV + ((size_t)l * NS + n) * AW + h * 64 + lane] = v;
      LAS float* qs = VEC + h * 192; qs[lane] = q; qs[64 + lane] = k; qs[128 + lane] = v;
      LDS_WAIT(); asm volatile("" ::: "memory");
      const float slope = exp2f(-(float)(h + 1));
      const float* ck = inp(F, 2) + ((size_t)(l * NS + n) * 2048) * AW + h * 64; const float* cv = inp(F, 3) + ((size_t)(l * NS + n) * 2048) * AW + h * 64;
      LAS float* sc = SCO + h * 396;
      float mx = -INFINITY;
      for (int g = 0; g < 3; ++g) { const int dil = g == 0 ? 1 : (g == 1 ? 4 : 16);
          for (int j = lane; j <= 128; j += 64) { float s = 0.f;
              if (j == 0) { for (int d = 0; d < 64; ++d) s += qs[d] * qs[64 + d]; }
              else { const float* kp = ck + (size_t)(2048 - dil * j) * AW; for (int d = 0; d < 64; d += 4) { const f32x4 kk4 = *(const GAS f32x4*)(kp + d); s += qs[d] * kk4[0] + qs[d + 1] * kk4[1] + qs[d + 2] * kk4[2] + qs[d + 3] * kk4[3]; } }
              s = s * 0.125f - slope * (float)(dil * j); sc[g * 132 + j] = s; mx = fmaxf(mx, s); } }
#pragma unroll
      for (int o = 1; o < 64; o <<= 1) mx = fmaxf(mx, __shfl_xor(mx, o));
      float ls = 0.f;
      for (int g = 0; g < 3; ++g) for (int j = lane; j <= 128; j += 64) { const float p = __expf(sc[g * 132 + j] - mx); sc[g * 132 + j] = p; ls += p; }
      ls = wave_sum(ls);
      LDS_WAIT(); asm volatile("" ::: "memory");
      float acc = 0.f;
      for (int g = 0; g < 3; ++g) { const int dil = g == 0 ? 1 : (g == 1 ? 4 : 16);
          acc += sc[g * 132] * qs[128 + lane];
          for (int j = 1; j <= 128; ++j) acc += sc[g * 132 + j] * cv[(size_t)(2048 - dil * j) * AW + lane]; }
      mixs[h * 64 + lane] = acc / ls; }
    __syncthreads();
    RELAUNDER(F);
    { const float* sh = inp(F, 5) + ((size_t)l * NS + n) * RP; const float* mu = inp(F, 15) + (size_t)l * RP;
      for (int c = F.tid; c < RP; c += NTHREADS) { const float p = P[3 * AW + c]; XM[c] = p + (sh[c] - p) * mu[c]; out[O_SSH + ((size_t)l * NS + n) * RP + c] = p; } }
    __syncthreads();
#pragma unroll 1
    for (int h = F.wave; h < RH; h += NWAVES) { RELAUNDER(F); const int lane = F.lane, c = h * 64 + lane;
        float sw = inp(F, 16)[(size_t)l * RW + c], sa = inp(F, 18)[(size_t)l * RW + c], sg = 0.f;
        const float* w2 = inp(F, 17) + (size_t)l * 64 * RW; const float* a2 = inp(F, 19) + (size_t)l * 64 * RW; const float* g2 = inp(F, 20) + (size_t)l * 128 * RW;
        for (int j = 0; j < 64; ++j) { const float tw = 1.0f - 2.0f / (1.0f + __expf(2.0f * XM[2304 + j])); sw += tw * w2[(size_t)j * RW + c]; sa += XM[2368 + j] * a2[(size_t)j * RW + c]; }
        for (int j = 0; j < 128; ++j) sg += sigmoidf_(XM[2432 + j]) * g2[(size_t)j * RW + c];
        const float dec = __expf(-0.60653065971f * sigmoidf_(sw)), a = sigmoidf_(sa);
        const float rr = XM[c], kr = XM[RW + c], vr = XM[2 * RW + c];
        float kk = kr * inp(F, 21)[(size_t)l * RW + c]; kk = kk / fmaxf(sqrtf(wave_sum(kk * kk)), 1e-12f);
        const float km = kr * (1.0f + (a - 1.0f) * inp(F, 22)[(size_t)l * RW + c]);
        const float bon = wave_sum(rr * km * inp(F, 23)[(size_t)l * RW + c]);
        LAS float* ve = VEC + h * 384; ve[lane] = -kk; ve[64 + lane] = kk * a; ve[128 + lane] = km; ve[192 + lane] = rr; ve[256 + lane] = dec;
        LDS_WAIT(); asm volatile("" ::: "memory");
        const float* s0 = inp(F, 4) + ((((size_t)l * NS + n) * RH + h) * 64 + lane) * 64; float* so = out + O_SWKV + ((((size_t)l * NS + n) * RH + h) * 64 + lane) * 64;
        float sdot = 0.f;
        for (int k = 0; k < 64; k += 4) { const f32x4 s4 = *(const GAS f32x4*)(s0 + k); sdot += s4[0] * ve[k] + s4[1] * ve[k + 1] + s4[2] * ve[k + 2] + s4[3] * ve[k + 3]; }
        float y = 0.f;
        for (int k = 0; k < 64; k += 4) { const f32x4 s4 = *(const GAS f32x4*)(s0 + k); f32x4 sn;
#pragma unroll
            for (int e = 0; e < 4; ++e) { sn[e] = s4[e] * ve[256 + k + e] + sdot * ve[64 + k + e] + vr * ve[128 + k + e]; y += sn[e] * ve[192 + k + e]; }
            *(GAS f32x4*)(so + k) = sn; }
        const float mean = wave_sum(y) * (1.0f / 64.f), dl = y - mean, var = wave_sum(dl * dl) * (1.0f / 64.f);
        const float yn = dl * (1.0f / sqrtf(var + GN_EPS)) * inp(F, 24)[(size_t)l * RW + c] + inp(F, 25)[(size_t)l * RW + c];
        mixs[AW + c] = (yn + bon * vr) * sg;
    }
    RELAUNDER(F);
    { const float* scv = inp(F, 6) + ((size_t)l * NS + n) * 2 * CW; const float* cw = inp(F, 26) + (size_t)l * 3 * CW; const float* cb = inp(F, 27) + (size_t)l * CW;
      for (int c = F.tid; c < CW; c += NTHREADS) { const float u = P[4096 + c], gb = P[4096 + CW + c], gc = P[4096 + 2 * CW + c], z0 = gc * u, z2 = scv[c], z1 = scv[CW + c];
          mixs[AW + RW + c] = gb * (cb[c] + cw[c] * z2 + cw[CW + c] * z1 + cw[2 * CW + c] * z0);
          float* oc = out + O_SCV + ((size_t)l * NS + n) * 2 * CW; oc[c] = z1; oc[CW + c] = z0; } }
    __syncthreads();
}
__device__ __forceinline__ void m2_phase(Frame& F, int l) {
    if (F.bid < 192) m2_carry(F, l);
    constexpr int N_ATT = 768, N_CONV = MP / 64, N_ITEMS = N_ATT + N_CONV + NS;
    for (;;) {
        __syncthreads();
        if (F.tid == 0) F.MISC[16] = __hip_atomic_fetch_add((unsigned*)(F.ctl + CW_QUEUE + 64 * l), 1u, RLX_AGENT);
        __syncthreads();
        const int it = (int)F.MISC[16];
        if (it >= N_ITEMS) break;
        RELAUNDER(F);
        if (it < N_ATT) m2_attn_item(F, it);
        else if (it < N_ATT + N_CONV) m2_conv_item(F, l, it - N_ATT);
        else m2_sample_item(F, l, it - N_ATT - N_CONV);
    }
}

__device__ __forceinline__ void m3_phase(Frame& F, int l) {
    const int lane = F.lane;
    bf16* MIX = (bf16*)(F.ws + WS_MIX);
    LAS float* RTl = (LAS float*)(F.lds + F.wave * 16384);
    const float* RT = (const float*)(F.ws + WS_RT); const float* YZ = (const float*)(F.ws + WS_YZ); const float* GG = (const float*)(F.ws + WS_GG); const float* BON = (const float*)(F.ws + WS_BON); const float* SC = (const float*)(F.ws + WS_SC);
    for (int task = F.bid * NWAVES + F.wave; task < NTASK; task += F.G * NWAVES) {
        RELAUNDER(F);
        const int nh = task / NCH, c = task - nh * NCH, n = nh / RH, h = nh - n * RH;
        const size_t tb = ((size_t)nh * T + c * CH) * 64;
        float sr[64];
        if (c > 0) {
#pragma unroll
            for (int k = 0; k < 64; k += 4) { const f32x4 s4 = *(const GAS f32x4*)(SC + (size_t)task * 4096 + lane * 64 + k); sr[k] = s4[0]; sr[k + 1] = s4[1]; sr[k + 2] = s4[2]; sr[k + 3] = s4[3]; }
#pragma unroll
            for (int i = 0; i < 16; ++i) *(LAS f32x4*)(RTl + (i * 64 + lane) * 4) = *(const GAS f32x4*)(RT + tb + (size_t)(i * 64 + lane) * 4);
            LDS_WAIT(); asm volatile("" ::: "memory");
        } else {
#pragma unroll
            for (int k = 0; k < 64; ++k) sr[k] = 0.f;
        }
        const float lw = inp(F, 24)[(size_t)l * RW + h * 64 + lane], lb = inp(F, 25)[(size_t)l * RW + h * 64 + lane];
        for (int t = 0; t < CH; ++t) {
            float y = YZ[tb + t * 64 + lane];
            if (c > 0) {
#pragma unroll
                for (int k = 0; k < 64; k += 4) { const f32x4 r4 = *(const LAS f32x4*)(RTl + t * 64 + k); y += sr[k] * r4[0] + sr[k + 1] * r4[1] + sr[k + 2] * r4[2] + sr[k + 3] * r4[3]; } }
            const float mean = wave_sum(y) * (1.0f / 64.f), dl = y - mean, var = wave_sum(dl * dl) * (1.0f / 64.f);
            const float yn = dl * __builtin_amdgcn_rsqf(var + GN_EPS) * lw + lb;
            const float o = (yn + BON[tb + t * 64 + lane]) * GG[tb + t * 64 + lane];
            MIX[((size_t)n * T + c * CH + t) * D + AW + h * 64 + lane] = (bf16)f2bf(o);
        }
        LDS_WAIT(); asm volatile("" ::: "memory");
    }
    const float* OG = (const float*)(F.ws + WS_OG); const float* LSE = (const float*)(F.ws + WS_LSE);
    for (int q = F.bid * NTHREADS + F.tid; q < MP * 64; q += F.G * NTHREADS) { const int row = q >> 6, c8 = (q & 63) * 8, h = c8 >> 6;
        const float l0 = LSE[(size_t)row * AH + h], l1 = LSE[((size_t)MP + row) * AH + h], l2 = LSE[((size_t)2 * MP + row) * AH + h];
        const float mx = fmaxf(l0, fmaxf(l1, l2)), e0 = __expf(l0 - mx), e1 = __expf(l1 - mx), e2 = __expf(l2 - mx), inv = 1.0f / (e0 + e1 + e2);
        f32x4 a = (f32x4){0.f, 0.f, 0.f, 0.f}, b = a;
        { const float* p = OG + (size_t)row * AW + c8; a = a + *(const GAS f32x4*)p * (e0 * inv); b = b + *(const GAS f32x4*)(p + 4) * (e0 * inv); }
        { const float* p = OG + ((size_t)MP + row) * AW + c8; a = a + *(const GAS f32x4*)p * (e1 * inv); b = b + *(const GAS f32x4*)(p + 4) * (e1 * inv); }
        { const float* p = OG + ((size_t)2 * MP + row) * AW + c8; a = a + *(const GAS f32x4*)p * (e2 * inv); b = b + *(const GAS f32x4*)(p + 4) * (e2 * inv); }
        v4u o; o.x = pk2(a[0], a[1]); o.y = pk2(a[2], a[3]); o.z = pk2(b[0], b[1]); o.w = pk2(b[2], b[3]);
        *(GAS v4u*)(MIX + (size_t)row * D + c8) = o; }
}
__device__ __forceinline__ void final_phase(Frame& F) {
    const float* xp = xsbuf(F, 3 * (L - 1) + 2); const u64* ac = sacc(F, L - 1, SA_D2);
    for (int i = F.bid * NTHREADS + F.tid; i < NS * D; i += F.G * NTHREADS) F.out[O_YS + i] = xp[i] + 0.5f * fx_dec(ac[i]);
}
}
namespace fk {
struct Args { const float* in[33]; float* out; unsigned char* ws; int ph_lo, ph_hi; };
constexpr int N_PHASES = 1 + 8 * 2 + L * 5 + 1;
__global__ void __launch_bounds__(NTHREADS, 2) mega(Args args) {
    extern __shared__ __attribute__((aligned(16))) unsigned char lds[];
    Frame F;
    F.lds = (LAS unsigned char*)lds;
    F.MISC = (volatile LAS unsigned*)(F.lds + MISC_OFF);
    F.tid = threadIdx.x; F.lane = F.tid & 63; F.wave = __builtin_amdgcn_readfirstlane(F.tid >> 6);
    F.G = gridDim.x; F.bid = blockIdx.x;
    F.ws = args.ws; F.out = args.out; F.ctl = (gu32*)(args.ws + WS_CTL);
    F.ptab = (const LAS unsigned*)(F.lds + PTAB_OFF);
    if (F.tid < 64) F.MISC[F.tid] = 0u;
    if (F.tid < 33) { const unsigned long long pv = (unsigned long long)args.in[F.tid]; ((LAS unsigned*)(F.lds + PTAB_OFF))[2 * F.tid] = (unsigned)pv; ((LAS unsigned*)(F.lds + PTAB_OFF))[2 * F.tid + 1] = (unsigned)(pv >> 32); }
    __syncthreads();
    const int lo = args.ph_lo, hi = args.ph_hi;
    const bool one_launch = (hi - lo) > 1;
    XcdBarrier bar; bar.bar = (unsigned*)(F.ctl + CW_BAR); bar.x = 0; bar.st = nullptr;
    if (one_launch) bar = xcd_barrier_post((unsigned*)(F.ctl + CW_BAR), F.MISC + 8);
    int ph = 0;
#define PHASE_BEGIN if (ph >= lo && ph < hi) { { int t_ = threadIdx.x; asm volatile("" : "+v"(t_)); F.tid = t_; F.lane = t_ & 63; F.wave = __builtin_amdgcn_readfirstlane(t_ >> 6); int b_ = blockIdx.x; asm volatile("" : "+s"(b_)); F.bid = b_; }
#define PHASE_END   if (ph + 1 < hi) xcd_barrier(bar); } ++ph;
    bf16* XB = (bf16*)(F.ws + WS_XB); bf16* HB = (bf16*)(F.ws + WS_H); bf16* MIX = (bf16*)(F.ws + WS_MIX);
    float* X = F.out + O_Y;

    PHASE_BEGIN p0_prologue(F); PHASE_END

    for (int s = 0; s < 2 * L; ++s) {
        const int l = s >> 1, second = s & 1;
        unsigned char* wl = wlayer(F, l);
        PHASE_BEGIN
            const int j = 3 * l + (second ? 2 : 0);
            const float* xprev = j == 0 ? inp(F, 1) : (j == 1 ? inp(F, 1) : xsbuf(F, j - 1));
            const u64* accprev = j == 0 ? nullptr : (second ? sacc(F, l, SA_O) : sacc(F, l - 1, SA_D2));
            sample_proj(F, j, xprev, accprev, second ? 1.0f : 0.5f, (const bf16*)(wl + (second ? WL_GU2 : WL_GU1)), NGU, sacc(F, l, second ? SA_GU2 : SA_GU1));
            pg8::Gemm g{XB, (const bf16*)(wl + (second ? WL_GU2 : WL_GU1)), MP, NGU, D}; pg8::StaticOrder S; S.init(MP, NGU, F.G, F.bid);
            pg8::EpiSwiglu E{HB, ssarr(F, j), FF};
            pg8::gemm_phase<pg8::EpiSwiglu, pg8::StaticOrder, true, true>(F.lds, g, S, E, F.tid);
        PHASE_END
        PHASE_BEGIN
            const int j = 3 * l + (second ? 2 : 0);
            sample_down(F, sacc(F, l, second ? SA_GU2 : SA_GU1), rstdbuf(F, j), (const bf16*)(wl + (second ? WL_D2 : WL_D1)), sacc(F, l, second ? SA_D2 : SA_D1));
            pg8::Gemm g{HB, (const bf16*)(wl + (second ? WL_D2 : WL_D1)), MP, D, FF}; pg8::StaticOrder S; S.init(MP, D, F.G, F.bid);
            u64* ssn = second ? (l + 1 < L ? ssarr(F, 3 * (l + 1)) : nullptr) : ssarr(F, 3 * l + 1);
            pg8::EpiResid E{X, XB, ssn, 0.5f};
            pg8::gemm_phase<pg8::EpiResid, pg8::StaticOrder, true, true>(F.lds, g, S, E, F.tid);
        PHASE_END
        if (!second) {
            PHASE_BEGIN
                const int j = 3 * l + 1;
                sample_proj(F, j, l == 0 ? inp(F, 1) : xsbuf(F, j - 1), sacc(F, l, SA_D1), 0.5f, (const bf16*)(wl + WL_IN), MIXP, sacc(F, l, SA_P));
                pg8::Gemm g{XB, (const bf16*)(wl + WL_IN), MP, MIXP, D}; pg8::StaticOrder S; S.init(MP, MIXP, F.G, F.bid);
                static_assert(WS_KN - WS_QN == WS_VB - WS_KN, "QN | KN | VB equally spaced");
                pg8::EpiWin E{ssarr(F, j), (bf16*)(F.ws + WS_QN), (bf16*)(F.ws + WS_PR), F.out + O_PK + (size_t)l * MP * AW, F.out + O_PSH + (size_t)l * NB * RP,
                              inp(F, 13) + l * 64, inp(F, 14) + l * 64, (WS_KN - WS_QN) / 2, O_PV - O_PK};
                pg8::gemm_phase<pg8::EpiWin, pg8::StaticOrder, true, true>(F.lds, g, S, E, F.tid);
            PHASE_END
            PHASE_BEGIN m1_phase(F, l); PHASE_END
            PHASE_BEGIN m2_phase(F, l); PHASE_END
            PHASE_BEGIN m3_phase(F, l); PHASE_END
            PHASE_BEGIN
                sample_wout(F, (const float*)(F.ws + WS_MIXS) + (size_t)l * NS * D, (const bf16*)(wl + WL_OUT), sacc(F, l, SA_O));
                pg8::Gemm g{MIX, (const bf16*)(wl + WL_OUT), MP, D, D}; pg8::StaticOrder S; S.init(MP, D, F.G, F.bid);
                pg8::EpiResid E{X, XB, ssarr(F, 3 * l + 2), 1.0f};
                pg8::gemm_phase<pg8::EpiResid, pg8::StaticOrder, true, true>(F.lds, g, S, E, F.tid);
            PHASE_END
        }
    }
    PHASE_BEGIN final_phase(F); PHASE_END
#undef PHASE_BEGIN
#undef PHASE_END
}

static int g_grid = 0;
static bool fast_setup() {
    if (g_grid != 0) return g_grid > 0;
    int dev = 0, cus = 0, per_cu = 0;
    if (hipGetDevice(&dev) != hipSuccess || hipDeviceGetAttribute(&cus, hipDeviceAttributeMultiprocessorCount, dev) != hipSuccess) { fprintf(stderr, "fast_setup: device query failed\n"); g_grid = -1; return false; }
    if (hipFuncSetAttribute((const void*)mega, hipFuncAttributeMaxDynamicSharedMemorySize, LDS_BYTES) != hipSuccess) { fprintf(stderr, "fast_setup: hipFuncSetAttribute failed\n"); g_grid = -1; return false; }
    if (hipOccupancyMaxActiveBlocksPerMultiprocessor(&per_cu, (const void*)mega, NTHREADS, LDS_BYTES) != hipSuccess || per_cu < 1) fprintf(stderr, "fast_setup: occupancy query reports %d blocks per CU\n", per_cu);
    (void)hipGetLastError();
    g_grid = cus;
    fprintf(stderr, "fast_setup: grid %d, occupancy %d\n", g_grid, per_cu);
    return true;
}
static void launch_range(void* const* d_in, float* out, void* d_ws, int lo, int hi, hipStream_t stream) {
    Args a; memset(&a, 0, sizeof(a));
    for (int i = 0; i < 33; ++i) a.in[i] = (const float*)d_in[i];
    a.out = out; a.ws = (unsigned char*)d_ws; a.ph_lo = lo; a.ph_hi = hi;
    hipLaunchKernelGGL(mega, dim3(g_grid), dim3(NTHREADS), LDS_BYTES, stream, a);
    const hipError_t le = hipPeekAtLastError();
    if (le != hipSuccess) fprintf(stderr, "launch_range [%d,%d) failed: %s\n", lo, hi, hipGetErrorName(le));
}
}
#ifndef KMODE
#define KMODE 1
#endif
#ifndef PROBE_ONE_LAUNCH
#define PROBE_ONE_LAUNCH 0
#endif
extern "C" void kernel_launch(void* const* d_in, const int* in_sizes, int n_in, void* d_out, int out_size, void* d_ws, size_t ws_size, hipStream_t stream) {
    constexpr size_t MiB = 1u << 20;
    if (n_in != 33 || out_size != (int)fk::O_END || ws_size < fk::WS_FAST_END) { fprintf(stderr, "kernel_launch: unexpected sizes n_in %d out %d ws %zu\n", n_in, out_size, ws_size); return; }
    if (!fk::fast_setup()) return;
#if KMODE == 2
    constexpr size_t OFF_OUT2 = 1137 * MiB, OFF_SNAP = 1340 * MiB, OFF_FMIX = 1405 * MiB, OFF_END = 1440 * MiB;
    static_assert(OFF_OUT2 >= fk::WS_FAST_END && OFF_OUT2 + fk::O_END * 4 <= OFF_SNAP && OFF_SNAP + (size_t)nv::R * 2048 * 4 <= OFF_FMIX && OFF_FMIX + (size_t)8192 * 2048 * 2 <= OFF_END, "probe map");
    if (ws_size < OFF_END) { fprintf(stderr, "kernel_launch: PROBE needs %zu bytes of workspace, got %zu\n", (size_t)OFF_END, ws_size); return; }
    float* out2 = (float*)((char*)d_ws + OFF_OUT2); float* snap = (float*)((char*)d_ws + OFF_SNAP); unsigned short* fmix = (unsigned short*)((char*)d_ws + OFF_FMIX);
    nv::forward(d_in, (float*)d_out, (float*)d_ws, stream, snap);
    float* fout = out2;
#else
    float* fout = (float*)d_out;
#endif
    hipMemsetAsync((char*)d_ws + fk::WS_CTL, 0, fk::CTL_ZERO_BYTES, stream);
#if KMODE == 0 || (KMODE == 2 && PROBE_ONE_LAUNCH)
    fk::launch_range(d_in, fout, d_ws, 0, fk::N_PHASES, stream);
#if KMODE == 2
#endif
#else
    for (int p = 0; p < fk::N_PHASES; ++p) {
        fk::launch_range(d_in, fout, d_ws, p, p + 1, stream);
#if KMODE == 2
        if (p == 1 + 2 + 4 - 1) hipMemcpyAsync(fmix, (char*)d_ws + fk::WS_MIX, (size_t)8192 * 2048 * 2, hipMemcpyDeviceToDevice, stream);
#endif
    }
#endif
#if KMODE == 2
    {   float* slots = (float*)((char*)d_ws + fk::WS_CTL) + 12288;
        const float* o = (const float*)d_out; int s = 0;
        auto cmpo = [&](size_t off, size_t n) { pb::cmp(false, out2 + off, n, o + off, n, 1, (int)n, slots, s++, stream); };
        for (int l = 0; l < 4; ++l) {
            cmpo(fk::O_PK + (size_t)l * 8192 * 512, (size_t)8192 * 512); cmpo(fk::O_PV + (size_t)l * 8192 * 512, (size_t)8192 * 512);
            cmpo(fk::O_SK + (size_t)l * 8 * 512, 8 * 512); cmpo(fk::O_SV + (size_t)l * 8 * 512, 8 * 512);
            cmpo(fk::O_PSH + (size_t)l * 4 * 2560, 4 * 2560); cmpo(fk::O_SSH + (size_t)l * 8 * 2560, 8 * 2560);
            cmpo(fk::O_PCV + (size_t)l * 4 * 1536, 4 * 1536); cmpo(fk::O_SCV + (size_t)l * 8 * 1536, 8 * 1536);
            cmpo(fk::O_PWKV + (size_t)l * 4 * 12 * 4096, (size_t)4 * 12 * 4096); cmpo(fk::O_SWKV + (size_t)l * 8 * 12 * 4096, (size_t)8 * 12 * 4096);
            if (l == 0) {
#if !PROBE_ONE_LAUNCH
                pb::cmp(true, fmix, 2048, snap, 2048, 8192, 512, slots, s++, stream);
                pb::cmp(true, fmix + 512, 2048, snap + 512, 2048, 8192, 768, slots, s++, stream);
                pb::cmp(true, fmix + 1280, 2048, snap + 1280, 2048, 8192, 768, slots, s++, stream);
#else
                s += 3;
#endif
                pb::cmp(false, (const float*)((char*)d_ws + fk::WS_MIXS), 2048, snap + (size_t)8192 * 2048, 2048, 8, 2048, slots, s++, stream);
            }
        }
        cmpo(fk::O_Y, (size_t)8192 * 2048); cmpo(fk::O_YS, 8 * 2048);
        pb::k_encode<<<1, 256, 0, stream>>>(slots, s, (float*)d_out + fk::O_YS, 8 * 2048, 1e-3f);
    }
#endif
}
```

```cpp
#include <hip/hip_runtime.h>
#include <hip/hip_bf16.h>
#include <cstdio>
#include <cstdint>
#include <cmath>
#include <cstring>
#define KMODE 0
#define PROBE_ONE_LAUNCH 0
namespace fk {
#define GAS __attribute__((address_space(1)))
#define LAS __attribute__((address_space(3)))
typedef unsigned short bf16;
typedef unsigned v4u __attribute__((ext_vector_type(4)));
typedef unsigned v2u __attribute__((ext_vector_type(2)));
typedef float f32x4 __attribute__((ext_vector_type(4)));
typedef float f32x2 __attribute__((ext_vector_type(2)));
typedef float f32x16 __attribute__((ext_vector_type(16)));
typedef short bf16x8 __attribute__((ext_vector_type(8)));
typedef short s16x4 __attribute__((ext_vector_type(4)));
typedef GAS unsigned gu32;

constexpr int D = 2048, NB = 4, T = 2048, MP = NB * T, NS = 8, L = 4;
constexpr int AW = 512, AH = 8, RW = 768, RH = 12, CW = 768, RP = 2560, MIXP = 6400, FF = 5632, PRW = RP + 3 * CW  ;
constexpr int NGU = 2 * FF;
constexpr float EPS = 1e-6f, GN_EPS = 64e-5f;
constexpr int NWAVES = 8, NTHREADS = 512;
constexpr int NCH = 32, CH = 64;
constexpr int NTASK = NB * RH * NCH;

constexpr size_t O_Y = 0, O_YS = 16777216, O_PK = 16793600, O_PV = 33570816, O_PWKV = 50348032, O_PSH = 51134464, O_PCV = 51175424,
                 O_SK = 51200000, O_SV = 51216384, O_SWKV = 51232768, O_SSH = 52805632, O_SCV = 52887552, O_END = 52936704;

constexpr size_t alignup(size_t x) { return (x + 4095) & ~(size_t)4095; }
constexpr int CW_TMO = 0;
constexpr int CW_BAR = 4096;
constexpr int CW_QUEUE = 8192;
constexpr size_t CTL_U32 = 16384;
constexpr size_t WS_CTL = 0;
constexpr size_t WS_SS = WS_CTL + CTL_U32 * 4;
constexpr size_t WS_SACC = WS_SS + (size_t)12 * MP * 8;
constexpr int SA_GU1 = 0, SA_D1 = 8 * NGU, SA_P = SA_D1 + 8 * D, SA_O = SA_P + 8 * MIXP, SA_GU2 = SA_O + 8 * D, SA_D2 = SA_GU2 + 8 * NGU, SA_LAYER = SA_D2 + 8 * D;
constexpr size_t CTL_ZERO_BYTES = alignup(WS_SACC + (size_t)L * SA_LAYER * 8);
constexpr size_t WS_XS = CTL_ZERO_BYTES;
constexpr size_t WS_RSTD = WS_XS + (size_t)13 * NS * D * 4;
constexpr size_t WS_MIXS = alignup(WS_RSTD + 13 * 8 * 4);
constexpr size_t WB_GU = (size_t)NGU * D * 2, WB_D = (size_t)D * FF * 2, WB_IN = (size_t)MIXP * D * 2, WB_OUT = (size_t)D * D * 2;
constexpr size_t WL_GU1 = 0, WL_D1 = WL_GU1 + WB_GU, WL_IN = WL_D1 + WB_D, WL_OUT = WL_IN + WB_IN, WL_GU2 = WL_OUT + WB_OUT, WL_D2 = WL_GU2 + WB_GU, WL_W2T = WL_D2 + WB_D,
                 WL_A2T = WL_W2T + (size_t)RW * 64 * 2, WL_G2T = WL_A2T + (size_t)RW * 64 * 2, WL_LAYER = alignup(WL_G2T + (size_t)RW * 128 * 2);
constexpr size_t WS_W = alignup(WS_MIXS + (size_t)L * NS * D * 4);
constexpr size_t WS_XB = WS_W + (size_t)L * WL_LAYER;
constexpr size_t WS_H = WS_XB + (size_t)MP * D * 2;
constexpr size_t WS_QN = WS_H + (size_t)MP * FF * 2;
constexpr size_t WS_KN = WS_QN + (size_t)MP * AW * 2;
constexpr size_t WS_VB = WS_KN + (size_t)MP * AW * 2;
constexpr size_t WS_PR = WS_VB + (size_t)MP * AW * 2;
constexpr size_t WS_MIX = WS_PR + (size_t)MP * PRW * 2;
constexpr size_t WS_OG = WS_MIX + (size_t)MP * D * 2;
constexpr size_t WS_LSE = WS_OG + (size_t)3 * MP * AW * 4;
constexpr size_t WS_PC = WS_LSE + (size_t)3 * MP * AH * 4;
constexpr size_t WS_RT = WS_PC + (size_t)NTASK * 2 * 4096 * 4;
constexpr size_t WS_YZ = WS_RT + (size_t)48 * T * 64 * 4;
constexpr size_t WS_GG = WS_YZ + (size_t)48 * T * 64 * 4;
constexpr size_t WS_BON = WS_GG + (size_t)48 * T * 64 * 4;
constexpr size_t WS_SC = WS_BON + (size_t)48 * T * 64 * 4;
constexpr size_t WS_FAST_END = WS_SC + (size_t)NTASK * 4096 * 4;

constexpr int LDS_BYTES = 147456;
constexpr int RING_BYTES = 131072;
constexpr int MISC_OFF = LDS_BYTES - 256;
constexpr int PTAB_OFF = LDS_BYTES - 1024;

#define RLX_AGENT __ATOMIC_RELAXED, __HIP_MEMORY_SCOPE_AGENT
#define LDS_WAIT() asm volatile("s_waitcnt lgkmcnt(0)" ::: "memory")
#define VM_WAIT() asm volatile("s_waitcnt vmcnt(0)" ::: "memory")
__device__ __forceinline__ unsigned f2bf(float f) { unsigned u = __builtin_bit_cast(unsigned, f); return (u + 0x7fffu + ((u >> 16) & 1u)) >> 16; }
__device__ __forceinline__ unsigned pk2(float lo, float hi) { return f2bf(lo) | (f2bf(hi) << 16); }
__device__ __forceinline__ float bf2f(unsigned short b) { return __builtin_bit_cast(float, (unsigned)b << 16); }
__device__ __forceinline__ float bflo(unsigned w) { return __builtin_bit_cast(float, w << 16); }
__device__ __forceinline__ float bfhi(unsigned w) { return __builtin_bit_cast(float, w & 0xffff0000u); }
typedef unsigned long long u64;
constexpr float SS_SCALE = 16777216.0f, SS_INV = 1.0f / 16777216.0f;
__device__ __forceinline__ u64 ss_enc(float s) { return (u64)((double)s * 16777216.0); }
__device__ __forceinline__ float ss_dec(u64 v) { return (float)v * SS_INV; }
__device__ __forceinline__ u64 fx_enc(float a) { return (u64)(long long)__double2ll_rn((double)a * 4294967296.0); }
__device__ __forceinline__ float fx_dec(u64 v) { return (float)((double)(long long)v * 2.3283064365386963e-10); }
__device__ __forceinline__ float sigmoidf_(float x) { return 1.0f / (1.0f + __expf(-x)); }
__device__ __forceinline__ float wave_sum(float v) {
#pragma unroll
    for (int o = 1; o < 64; o <<= 1) v += __shfl_xor(v, o);
    return v;
}
__device__ __forceinline__ float dpp_x1(float x) { return __builtin_bit_cast(float, __builtin_amdgcn_update_dpp(0, __builtin_bit_cast(int, x), 0xB1, 0xF, 0xF, true)); }
__device__ __forceinline__ float dpp_x2(float x) { return __builtin_bit_cast(float, __builtin_amdgcn_update_dpp(0, __builtin_bit_cast(int, x), 0x4E, 0xF, 0xF, true)); }
__device__ __forceinline__ float dpp_hm(float x) { return __builtin_bit_cast(float, __builtin_amdgcn_update_dpp(0, __builtin_bit_cast(int, x), 0x141, 0xF, 0xF, true)); }
__device__ __forceinline__ float dpp_rm(float x) { return __builtin_bit_cast(float, __builtin_amdgcn_update_dpp(0, __builtin_bit_cast(int, x), 0x140, 0xF, 0xF, true)); }
__device__ __forceinline__ float sum8(float x) { x += dpp_x1(x); x += dpp_x2(x); x += dpp_hm(x); return x; }
__device__ __forceinline__ float sum16(float x) { x = sum8(x); x += dpp_rm(x); return x; }

#define XB_TMO      128
#define XB_XCNT(j)  (256  + 64 * (j))
#define XB_XSUB(j)  (1280 + 64 * (j))
#define XB_XGEN(j)  (2304 + 64 * (j))
#define XB_TOP      3328
#define XB_TOPGEN   3392
#define XCD_BAR_WORDS 3456
#define XB_SPIN_CAP (1u << 20)
__device__ __forceinline__ unsigned xb_ld(unsigned* p)              { return __hip_atomic_load(p, __ATOMIC_RELAXED, __HIP_MEMORY_SCOPE_AGENT); }
__device__ __forceinline__ unsigned xb_add(unsigned* p, unsigned v) { return __hip_atomic_fetch_add(p, v, __ATOMIC_RELAXED, __HIP_MEMORY_SCOPE_AGENT); }
__device__ __forceinline__ unsigned xb_xcc_id() { return (unsigned)__builtin_amdgcn_s_getreg((3 << 11) | 20) & 0xFu; }
#define XB_SPIN(cond, bar) do { unsigned _sp = 0; while (cond) { __builtin_amdgcn_s_sleep(1); \
    if ((++_sp & 255u) == 0u) { if (xb_ld(&(bar)[XB_TMO])) break; if (_sp > XB_SPIN_CAP) { atomicAdd(&(bar)[XB_TMO], 1u); break; } } } } while (0)
struct XcdBarrier { unsigned* bar; unsigned x; volatile LAS unsigned* st; };
__device__ __forceinline__ XcdBarrier xcd_barrier_post(unsigned* bar, volatile LAS unsigned* st) {
    XcdBarrier b; b.bar = bar; b.x = xb_xcc_id(); b.st = st;
    if (threadIdx.x == 0) (void)xb_add(&bar[XB_XCNT(b.x)], 1u);
    return b;
}
__device__ __forceinline__ void xcd_barrier_complete(unsigned* bar, unsigned x, unsigned& nloc, unsigned& nx) {
    const unsigned G = gridDim.x * gridDim.y * gridDim.z;
    unsigned sum, cnt, mine, sp = 0u;
    for (;;) {
        sum = 0u; cnt = 0u; mine = 0u;
#pragma unroll
        for (unsigned j = 0; j < 16; ++j) { const unsigned c = xb_ld(&bar[XB_XCNT(j)]); sum += c; cnt += (c > 0u) ? 1u : 0u; mine = (j == x) ? c : mine; }
        if (sum == G) break;
        __builtin_amdgcn_s_sleep(1);
        if ((++sp & 255u) == 0u) { if (xb_ld(&bar[XB_TMO])) break; if (sp > XB_SPIN_CAP) { atomicAdd(&bar[XB_TMO], 1u); break; } }
    }
    nloc = mine > 0u ? mine : 1u; nx = cnt > 0u ? cnt : 1u;
}
__device__ __forceinline__ void xcd_barrier(const XcdBarrier& b) {
    asm volatile("s_waitcnt vmcnt(0)" ::: "memory");
    __syncthreads();
    if (threadIdx.x == 0) {
        unsigned* bar = b.bar;
        __builtin_amdgcn_s_waitcnt(0);
        unsigned nloc = b.st[0], nx = b.st[1];
        if (nloc == 0u) { xcd_barrier_complete(bar, b.x, nloc, nx); b.st[0] = nloc; b.st[1] = nx; }
        const unsigned old = xb_add(&bar[XB_XSUB(b.x)], 1u);
        const unsigned gen = old / nloc;
        if (old + 1u == (gen + 1u) * nloc) {
            __builtin_amdgcn_fence(__ATOMIC_RELEASE, "agent");
            asm volatile("s_waitcnt vmcnt(0)" ::: "memory");
            const unsigned og = xb_add(&bar[XB_TOP], 1u);
            const unsigned tg = og / nx;
            if (og + 1u == (tg + 1u) * nx) xb_add(&bar[XB_TOPGEN], 1u);
            else XB_SPIN(xb_ld(&bar[XB_TOPGEN]) == tg, bar);
            __builtin_amdgcn_fence(__ATOMIC_ACQUIRE, "agent");
            xb_add(&bar[XB_XGEN(b.x)], 1u);
            asm volatile("s_waitcnt vmcnt(0)" ::: "memory");
        } else {
            XB_SPIN(xb_ld(&bar[XB_XGEN(b.x)]) == gen, bar);
            __builtin_amdgcn_fence(__ATOMIC_ACQUIRE, "agent");
            asm volatile("s_waitcnt vmcnt(0)" ::: "memory");
        }
    }
    __syncthreads();
}
}
namespace pg8 {
#define PG8_LAS __attribute__((address_space(3)))
typedef unsigned short bf16_t;
typedef short bf16x8 __attribute__((ext_vector_type(8)));
typedef float f32x4 __attribute__((ext_vector_type(4)));
typedef unsigned u32x4 __attribute__((ext_vector_type(4)));
constexpr int BM = 256, BK = 64, HALF = 128, HTB = HALF * BK * 2  , STAGE_BYTES = 8 * HTB, NXCD = 8, WGM = 8;

__host__ __device__ __forceinline__ int lds_byte(int r, int c) { const int st = (r >> 4) * 2 + (c >> 5), rr = r & 15, cc = c & 31, ob = rr * 64 + cc * 2; return st * 1024 + (ob ^ (((ob >> 9) & 1) << 5)); }
__host__ __device__ __forceinline__ void stage_rc(int b, int& R, int& C) { const int st = b / 1024, sb = b % 1024, swz = sb ^ (((sb >> 9) & 1) << 5); R = (st >> 1) * 16 + swz / 64; C = (st & 1) * 32 + (swz % 64) / 2; }
__host__ __device__ __forceinline__ int perm32(int rho) { const int n = rho >> 4, i = rho & 15; return 8 * (i >> 2) + 4 * n + (i & 3); }

struct Unit { int pm, pn; };
struct Gemm { const bf16_t* A; const bf16_t* Bt; int M, N, K; };

struct StaticOrder {
    int nM, nN, nwg, G, c;
    __host__ __device__ void init(int M, int N, int G_, int c_) { nM = M / BM; nN = N / BM; nwg = nM * nN; G = G_; c = c_; }
    __host__ __device__ bool next(int i, Unit& u) const {
        const long L = (long)i * G + c; if (L >= nwg) return false;
        int wgid = (int)L; { const int q = nwg / NXCD, r = nwg % NXCD, xcd = wgid % NXCD, off = wgid / NXCD; wgid = (xcd < r ? xcd * (q + 1) : r * (q + 1) + (xcd - r) * q) + off; }
        const int nig = WGM * nN, gid = wgid / nig, fm = gid * WGM, gsz = (nM - fm) < WGM ? (nM - fm) : WGM;
        u.pm = fm + ((wgid % nig) % gsz); u.pn = (wgid % nig) / gsz; return true;
    }
    __device__ __forceinline__ void a_ready(const Unit&) const {}
    __device__ __forceinline__ void done(const Unit&) const {}
};

__device__ __forceinline__ unsigned cvt_pk_bf16(float lo, float hi) { unsigned r; asm volatile("v_cvt_pk_bf16_f32 %0, %1, %2" : "=v"(r) : "v"(lo), "v"(hi)); return r; }
__device__ __forceinline__ u32x4 pack8(const f32x4& a, const f32x4& b) { u32x4 w; w.x = cvt_pk_bf16(a[0], a[1]); w.y = cvt_pk_bf16(a[2], a[3]); w.z = cvt_pk_bf16(b[0], b[1]); w.w = cvt_pk_bf16(b[2], b[3]); return w; }
__device__ __forceinline__ float silu_f(float g) { return g * __builtin_amdgcn_rcpf(1.0f + __expf(-g)); }
constexpr float kEps = 1e-6f;

struct EpiSwiglu {
    static constexpr bool PERM = true, AFTER_DRAIN = false;
    bf16_t* H; const unsigned long long* ss; int ldh;
    __device__ __forceinline__ void operator()(const f32x4 (&acc)[2][2][4][2], const Unit& u, int wr, int wc, int fr, int fq) const {
        const int row0 = u.pm * BM + wr * 64 + fr, col0 = u.pn * HALF + wc * 32 + 8 * fq;
#pragma unroll
        for (int ai = 0; ai < 2; ++ai)
#pragma unroll
            for (int m = 0; m < 4; ++m) { const int row = row0 + ai * HALF + m * 16; const float rs = __builtin_amdgcn_rsqf((float)ss[row] * (1.0f / (16777216.0f * 2048.0f)) + kEps);
                f32x4 h0, h1;
#pragma unroll
                for (int j = 0; j < 4; ++j) { h0[j] = silu_f(acc[ai][0][m][0][j] * rs) * (acc[ai][1][m][0][j] * rs); h1[j] = silu_f(acc[ai][0][m][1][j] * rs) * (acc[ai][1][m][1][j] * rs); }
                *(u32x4*)(H + (size_t)row * ldh + col0) = pack8(h0, h1); }
    }
};
struct EpiResid {
    static constexpr bool PERM = true, AFTER_DRAIN = false;
    float* X; bf16_t* XB; unsigned long long* ssn; float coef;
    __device__ __forceinline__ void operator()(const f32x4 (&acc)[2][2][4][2], const Unit& u, int wr, int wc, int fr, int fq) const {
        const int row0 = u.pm * BM + wr * 64 + fr, col0 = u.pn * BM + wc * 32 + 8 * fq;
#pragma unroll
        for (int ai = 0; ai < 2; ++ai)
#pragma unroll
            for (int m = 0; m < 4; ++m) { const int row = row0 + ai * HALF + m * 16; float part = 0.f;
#pragma unroll
                for (int bj = 0; bj < 2; ++bj) { float* xp = X + (size_t)row * 2048 + col0 + bj * HALF;
                    f32x4 x0 = *(const f32x4*)xp, x1 = *(const f32x4*)(xp + 4);
                    x0 = x0 + acc[ai][bj][m][0] * coef; x1 = x1 + acc[ai][bj][m][1] * coef;
                    *(f32x4*)xp = x0; *(f32x4*)(xp + 4) = x1;
                    *(u32x4*)(XB + (size_t)row * 2048 + col0 + bj * HALF) = pack8(x0, x1);
                    part += (x0[0] * x0[0] + x0[1] * x0[1]) + (x0[2] * x0[2] + x0[3] * x0[3]) + (x1[0] * x1[0] + x1[1] * x1[1]) + (x1[2] * x1[2] + x1[3] * x1[3]); }
                part += __shfl_xor(part, 16); part += __shfl_xor(part, 32);
                if (ssn != nullptr && fq == 0) (void)__hip_atomic_fetch_add(ssn + row, (unsigned long long)((double)part * 16777216.0), __ATOMIC_RELAXED, __HIP_MEMORY_SCOPE_AGENT); }
    }
};
struct EpiWin {
    static constexpr bool PERM = true, AFTER_DRAIN = false;
    const unsigned long long* ss; bf16_t *QN, *PR; float *outK, *outSh; const float *qg, *kg; size_t qkv_stride, kv_out_stride;
    __device__ __forceinline__ void operator()(const f32x4 (&acc)[2][2][4][2], const Unit& u, int wr, int wc, int fr, int fq) const {
        const int row0 = u.pm * BM + wr * 64 + fr;
        if (u.pn < 6) {
            const int type = u.pn >> 1, head = 4 * (u.pn & 1) + wc;
            f32x4 gn[2][2];
#pragma unroll
            for (int bj = 0; bj < 2; ++bj)
#pragma unroll
                for (int n = 0; n < 2; ++n) { const int d = 32 * bj + 8 * fq + 4 * n;
                    const f32x4 gq = *(const f32x4*)(qg + d) * 0.125f, gk = *(const f32x4*)(kg + d);
                    gn[bj][n] = type == 0 ? gq : (type == 1 ? gk : (f32x4){1.f, 1.f, 1.f, 1.f}); }
            bf16_t* const dst = QN + (size_t)type * qkv_stride;
            float* const od = outK + (size_t)(type >> 1) * kv_out_stride;
#pragma unroll
            for (int ai = 0; ai < 2; ++ai)
#pragma unroll
                for (int m = 0; m < 4; ++m) { const int row = row0 + ai * HALF + m * 16; const float rs = __builtin_amdgcn_rsqf((float)ss[row] * (1.0f / (16777216.0f * 2048.0f)) + kEps);
                    f32x4 v[2][2]; float q = 0.f;
#pragma unroll
                    for (int bj = 0; bj < 2; ++bj)
#pragma unroll
                        for (int n = 0; n < 2; ++n) { v[bj][n] = acc[ai][bj][m][n] * rs; q += (v[bj][n][0] * v[bj][n][0] + v[bj][n][1] * v[bj][n][1]) + (v[bj][n][2] * v[bj][n][2] + v[bj][n][3] * v[bj][n][3]); }
                    q += __shfl_xor(q, 16); q += __shfl_xor(q, 32);
                    const float hn = type < 2 ? __builtin_amdgcn_rsqf(q * (1.0f / 64.0f) + kEps) : 1.0f;
#pragma unroll
                    for (int bj = 0; bj < 2; ++bj) { const f32x4 a = v[bj][0] * hn * gn[bj][0], b = v[bj][1] * hn * gn[bj][1];
                        const size_t o = (size_t)row * 512 + head * 64 + 32 * bj + 8 * fq;
                        *(u32x4*)(dst + o) = pack8(a, b);
                        if (type >= 1) { *(f32x4*)(od + o) = a; *(f32x4*)(od + o + 4) = b; } } }
        } else {
            const int colp = u.pn * BM + wc * 32 + 8 * fq - 1536;
#pragma unroll
            for (int ai = 0; ai < 2; ++ai)
#pragma unroll
                for (int m = 0; m < 4; ++m) { const int row = row0 + ai * HALF + m * 16; const float rs = __builtin_amdgcn_rsqf((float)ss[row] * (1.0f / (16777216.0f * 2048.0f)) + kEps);
#pragma unroll
                    for (int bj = 0; bj < 2; ++bj) { const f32x4 a = acc[ai][bj][m][0] * rs, b = acc[ai][bj][m][1] * rs; const int c = colp + bj * HALF;
                        *(u32x4*)(PR + (size_t)row * 4864 + c) = pack8(a, b);
                        if (u.pn < 16 && (row & 2047) == 2047) { float* o = outSh + (size_t)(row >> 11) * 2560 + c; *(f32x4*)o = a; *(f32x4*)(o + 4) = b; } } }
        }
    }
};
template <class Epi, class Sched, bool ALIGN_EPI = false, bool SP2 = false>
__device__ __forceinline__ void gemm_phase(PG8_LAS unsigned char* lds, const Gemm g, const Sched& S, const Epi& E, const int tid) {
    const int wid = __builtin_amdgcn_readfirstlane(tid >> 6), lane = tid & 63, wr = wid >> 2, wc = wid & 3, fr = lane & 15, fq = lane >> 4;
    const int K = g.K, nt = K / BK;
    unsigned voffA[2], voffB[2];
#pragma unroll
    for (int i = 0; i < 2; ++i) { int R, C; stage_rc(tid * 16 + i * 8192, R, C); const int Rb = Epi::PERM ? ((R & ~31) + perm32(R & 31)) : R;
        voffA[i] = (unsigned)(R * K + C) * 2u; voffB[i] = (unsigned)(Rb * K + C) * 2u; }
    const size_t kstep = (size_t)(BK * 2);
    const size_t hstep = (size_t)HALF * K * 2;
    const size_t tstep = 2 * hstep;
    const unsigned ldsw = (unsigned)wid * 1024u;
    const int aoff = lds_byte(wr * 64 + fr, fq * 8), boff = lds_byte(wc * 32 + fr, fq * 8);
#define PG8_SA(b, h) (((b) * 2 + (h)) * HTB)
#define PG8_SB(b, h) ((4 + (b) * 2 + (h)) * HTB)
#define PG8_STAGE(bufoff, gbase, voff) do { _Pragma("unroll") for (int _i = 0; _i < 2; ++_i) \
        __builtin_amdgcn_global_load_lds((const unsigned*)((const char*)(gbase) + (voff)[_i]), (PG8_LAS unsigned*)(lds + (bufoff) + ldsw + _i * 8192), 16, 0, 0); } while (0)
#define PG8_LDA(dst, b, h) do { _Pragma("unroll") for (int m = 0; m < 4; ++m) _Pragma("unroll") for (int k = 0; k < 2; ++k) dst[m][k] = *(const PG8_LAS bf16x8*)(lds + PG8_SA(b, h) + aoff + m * 2048 + k * 1024); } while (0)
#define PG8_LDB(dst, b, h) do { _Pragma("unroll") for (int n = 0; n < 2; ++n) _Pragma("unroll") for (int k = 0; k < 2; ++k) dst[n][k] = *(const PG8_LAS bf16x8*)(lds + PG8_SB(b, h) + boff + n * 2048 + k * 1024); } while (0)
#define PG8_MMA(ai, bj, At, Bt) do { __builtin_amdgcn_s_setprio(1); _Pragma("unroll") for (int m = 0; m < 4; ++m) _Pragma("unroll") for (int n = 0; n < 2; ++n) _Pragma("unroll") for (int k = 0; k < 2; ++k) \
        acc[ai][bj][m][n] = __builtin_amdgcn_mfma_f32_16x16x32_bf16(Bt[n][k], At[m][k], acc[ai][bj][m][n], 0, 0, 0); __builtin_amdgcn_s_setprio(0); } while (0)
#define PG8_WAIT_V(n) asm volatile("s_waitcnt vmcnt(" #n ")" ::: "memory")
#define PG8_WAIT_L(n) asm volatile("s_waitcnt lgkmcnt(" #n ")" ::: "memory")
#define PG8_BAR __builtin_amdgcn_s_barrier()
#define PG8_SCHED __builtin_amdgcn_sched_barrier(0)
    Unit cur, nxt; int ui = 0;
    if (!S.next(0, cur)) return;
    f32x4 acc[2][2][4][2];
#pragma unroll
    for (int a = 0; a < 2; ++a)
#pragma unroll
        for (int b = 0; b < 2; ++b)
#pragma unroll
            for (int m = 0; m < 4; ++m)
#pragma unroll
                for (int n = 0; n < 2; ++n) acc[a][b][m][n] = (f32x4){0.f, 0.f, 0.f, 0.f};
    bf16x8 At[4][2], B0[2][2], B1[2][2];
    const char* cA = (const char*)g.A + (size_t)cur.pm * tstep; const char* cB = (const char*)g.Bt + (size_t)cur.pn * tstep;
    S.a_ready(cur);
    if constexpr (SP2) {
        PG8_STAGE(PG8_SB(0, 0), cB, voffB); PG8_STAGE(PG8_SB(0, 1), cB + hstep, voffB); PG8_STAGE(PG8_SA(0, 0), cA, voffA); PG8_STAGE(PG8_SA(0, 1), cA + hstep, voffA);
        if (wr == 1) PG8_BAR;
        PG8_WAIT_V(2); PG8_BAR;
        PG8_STAGE(PG8_SB(1, 0), cB + kstep, voffB); PG8_STAGE(PG8_SA(1, 0), cA + kstep, voffA); PG8_STAGE(PG8_SB(1, 1), cB + hstep + kstep, voffB);
        PG8_WAIT_V(6); PG8_BAR;
    } else {
        PG8_STAGE(PG8_SB(0, 0), cB, voffB); PG8_STAGE(PG8_SA(0, 0), cA, voffA); PG8_STAGE(PG8_SB(0, 1), cB + hstep, voffB); PG8_STAGE(PG8_SA(0, 1), cA + hstep, voffA);
        if (wr == 1) PG8_BAR;
        PG8_WAIT_V(4); PG8_BAR;
        PG8_STAGE(PG8_SB(1, 0), cB + kstep, voffB); PG8_STAGE(PG8_SA(1, 0), cA + kstep, voffA); PG8_STAGE(PG8_SB(1, 1), cB + hstep + kstep, voffB);
        PG8_WAIT_V(6); PG8_BAR;
    }
    for (;;) {
        const bool has_next = S.next(ui + 1, nxt);
        const char* nA = has_next ? (const char*)g.A + (size_t)nxt.pm * tstep : cA; const char* nB = has_next ? (const char*)g.Bt + (size_t)nxt.pn * tstep : cB;
        for (int t = 0; t < nt; t += 2) {
            const bool last = (t == nt - 2);
            const char* a1 = cA + (size_t)(t + 1) * kstep;
            const char* a2 = last ? nA : cA + (size_t)(t + 2) * kstep; const char* b2 = last ? nB : cB + (size_t)(t + 2) * kstep;
            const char* a3 = a2 + kstep; const char* b3 = b2 + kstep;
            if (last && has_next) S.a_ready(nxt);
            if constexpr (SP2) {
            PG8_LDB(B0, 0, 0); PG8_LDB(B1, 0, 1); PG8_SCHED; PG8_LDA(At, 0, 0); PG8_STAGE(PG8_SA(1, 1), a1 + hstep, voffA);
            PG8_WAIT_V(8); PG8_WAIT_L(0); PG8_BAR; PG8_MMA(0, 0, At, B0); PG8_MMA(0, 1, At, B1); PG8_BAR; PG8_SCHED;
            PG8_LDA(At, 0, 1); PG8_STAGE(PG8_SB(0, 0), b2, voffB); PG8_STAGE(PG8_SB(0, 1), b2 + hstep, voffB); PG8_STAGE(PG8_SA(0, 0), a2, voffA);
            PG8_WAIT_V(8); PG8_WAIT_L(0); PG8_BAR; PG8_MMA(1, 0, At, B0); PG8_MMA(1, 1, At, B1); PG8_BAR; PG8_SCHED;
            PG8_LDB(B0, 1, 0); PG8_LDB(B1, 1, 1); PG8_SCHED; PG8_LDA(At, 1, 0); PG8_STAGE(PG8_SA(0, 1), a2 + hstep, voffA);
            PG8_WAIT_V(8); PG8_WAIT_L(0); PG8_BAR; PG8_MMA(0, 0, At, B0); PG8_MMA(0, 1, At, B1); PG8_BAR; PG8_SCHED;
            PG8_LDA(At, 1, 1); PG8_STAGE(PG8_SB(1, 0), b3, voffB); PG8_STAGE(PG8_SB(1, 1), b3 + hstep, voffB); PG8_STAGE(PG8_SA(1, 0), a3, voffA);
            PG8_WAIT_V(8); PG8_WAIT_L(0); PG8_BAR; PG8_MMA(1, 0, At, B0); PG8_MMA(1, 1, At, B1); PG8_BAR; PG8_SCHED;
            } else {
            PG8_LDB(B0, 0, 0); PG8_SCHED; PG8_LDA(At, 0, 0); PG8_STAGE(PG8_SA(1, 1), a1 + hstep, voffA);
            PG8_WAIT_L(8); PG8_BAR; PG8_WAIT_L(0); PG8_MMA(0, 0, At, B0); PG8_BAR; PG8_SCHED;
            PG8_LDB(B1, 0, 1); PG8_STAGE(PG8_SB(0, 0), b2, voffB);
            PG8_BAR; PG8_WAIT_L(0); PG8_MMA(0, 1, At, B1); PG8_BAR;
            PG8_LDA(At, 0, 1); PG8_STAGE(PG8_SA(0, 0), a2, voffA);
            PG8_BAR; PG8_WAIT_L(0); PG8_MMA(1, 0, At, B0); PG8_BAR; PG8_SCHED;
            PG8_STAGE(PG8_SB(0, 1), b2 + hstep, voffB);
            PG8_WAIT_V(6); PG8_BAR; PG8_MMA(1, 1, At, B1); PG8_BAR;
            PG8_LDB(B0, 1, 0); PG8_SCHED; PG8_LDA(At, 1, 0); PG8_STAGE(PG8_SA(0, 1), a2 + hstep, voffA);
            PG8_WAIT_L(8); PG8_BAR; PG8_WAIT_L(0); PG8_MMA(0, 0, At, B0); PG8_BAR; PG8_SCHED;
            PG8_LDB(B1, 1, 1); PG8_STAGE(PG8_SB(1, 0), b3, voffB);
            PG8_BAR; PG8_WAIT_L(0); PG8_MMA(0, 1, At, B1); PG8_BAR;
            PG8_LDA(At, 1, 1); PG8_STAGE(PG8_SA(1, 0), a3, voffA);
            PG8_BAR; PG8_WAIT_L(0); PG8_MMA(1, 0, At, B0); PG8_BAR; PG8_SCHED;
            PG8_STAGE(PG8_SB(1, 1), b3 + hstep, voffB);
            PG8_WAIT_V(6); PG8_BAR; PG8_MMA(1, 1, At, B1); PG8_BAR;
            }
        }
        if constexpr (ALIGN_EPI) { if (wr == 0) PG8_BAR; }
        if constexpr (!Epi::AFTER_DRAIN) { E(acc, cur, wr, wc, fr, fq); S.done(cur); }
        if (!has_next) break;
#pragma unroll
        for (int a = 0; a < 2; ++a)
#pragma unroll
            for (int b = 0; b < 2; ++b)
#pragma unroll
                for (int m = 0; m < 4; ++m)
#pragma unroll
                    for (int n = 0; n < 2; ++n) acc[a][b][m][n] = (f32x4){0.f, 0.f, 0.f, 0.f};
        cur = nxt; cA = nA; cB = nB; ++ui;
        if constexpr (ALIGN_EPI) { if (wr == 1) PG8_BAR; }
    }
    PG8_WAIT_V(0);
    if constexpr (!ALIGN_EPI) { if (wr == 0) PG8_BAR; }
    PG8_BAR;
    if constexpr (Epi::AFTER_DRAIN) { E.fused(acc, cur, wr, wc, fr, fq, lds, wid, lane); S.done(cur); }
#undef PG8_SA
#undef PG8_SB
#undef PG8_STAGE
#undef PG8_LDA
#undef PG8_LDB
#undef PG8_MMA
#undef PG8_WAIT_V
#undef PG8_WAIT_L
#undef PG8_BAR
#undef PG8_SCHED
}
}
namespace fk {
struct Frame {
    LAS unsigned char* lds;
    volatile LAS unsigned* MISC;
    gu32* ctl;
    int tid, lane, wave, G, bid;
    const LAS unsigned* ptab;
    float* out;
    unsigned char* ws;
};
__device__ __forceinline__ const float* inp(const Frame& F, int i) { const unsigned lo = __builtin_amdgcn_readfirstlane(F.ptab[2 * i]), hi = __builtin_amdgcn_readfirstlane(F.ptab[2 * i + 1]); return (const float*)(((unsigned long long)hi << 32) | lo); }
__device__ __forceinline__ unsigned char* wlayer(const Frame& F, int l) { return F.ws + WS_W + (size_t)l * WL_LAYER; }
__device__ __forceinline__ u64* ssarr(const Frame& F, int j) { return (u64*)(F.ws + WS_SS) + (size_t)j * MP; }
__device__ __forceinline__ u64* sacc(const Frame& F, int l, int off) { return (u64*)(F.ws + WS_SACC) + (size_t)l * SA_LAYER + off; }
__device__ __forceinline__ float* xsbuf(const Frame& F, int j) { return (float*)(F.ws + WS_XS) + (size_t)j * NS * D; }
__device__ __forceinline__ float* rstdbuf(const Frame& F, int j) { return (float*)(F.ws + WS_RSTD) + j * 8; }

#define RELAUNDER(F) do { int t_ = threadIdx.x; asm volatile("" : "+v"(t_)); (F).tid = t_; (F).lane = t_ & 63; (F).wave = __builtin_amdgcn_readfirstlane(t_ >> 6); } while (0)
template <int MAP> __device__ __forceinline__ int dest_row(int n) {
    if (MAP == 1) return (n >> 7) * 256 + (n & 127);
    if (MAP == 2) return (n >> 7) * 256 + 128 + (n & 127);
    if (MAP == 3) { if (n >= 1536) return n; const int tile = n >> 8, loc = n & 255, hh = loc >> 6, d = loc & 63; return tile * 256 + (d >> 5) * 128 + hh * 32 + (d & 31); }
    return n;
}
template <int MAP> __device__ __forceinline__ void transpose_item(const float* W, const float* gk, int K, int N, bf16* WT, LAS float* scr, int item, int lane) {
    const int nblk = N >> 6, kb = item / nblk, nb = item - kb * nblk, k0 = kb * 64, n0 = nb * 64;
    const int lr = lane >> 4, lc = (lane & 15) * 4;
#pragma unroll 4
    for (int i = 0; i < 16; ++i) { const int kk = 4 * i + lr; f32x4 v = *(const GAS f32x4*)(W + (size_t)(k0 + kk) * N + n0 + lc);
        if (gk != nullptr) v = v * gk[k0 + kk];
        LAS float* s = scr + kk * 65 + lc; s[0] = v[0]; s[1] = v[1]; s[2] = v[2]; s[3] = v[3]; }
    LDS_WAIT(); asm volatile("" ::: "memory");
    const int c = lane & 7;
#pragma unroll
    for (int jj = 0; jj < 8; ++jj) { const int n = (lane >> 3) + 8 * jj; const LAS float* s = scr + (8 * c) * 65 + n;
        v4u o; o.x = pk2(s[0], s[65]); o.y = pk2(s[2 * 65], s[3 * 65]); o.z = pk2(s[4 * 65], s[5 * 65]); o.w = pk2(s[6 * 65], s[7 * 65]);
        *(GAS v4u*)(WT + (size_t)dest_row<MAP>(n0 + n) * K + k0 + 8 * c) = o; }
    LDS_WAIT(); asm volatile("" ::: "memory");
}
__device__ __forceinline__ void p0_prologue(Frame& F) {
    LAS float* scr = (LAS float*)(F.lds + F.wave * 16640);
    const int gw = F.bid * NWAVES + F.wave, NGW = F.G * NWAVES;
    constexpr int I_GU = (D / 64) * (FF / 64), I_DN = (FF / 64) * (D / 64), I_IN = (D / 64) * (MIXP / 64), I_OUT = (D / 64) * (D / 64);
    constexpr int PER_LAYER = 6 * I_GU + I_IN + I_OUT;
    static_assert(I_GU == I_DN, "item counts");
    for (int it = gw; it < L * PER_LAYER; it += NGW) {
        const int l = it / PER_LAYER; int r = it - l * PER_LAYER;
        unsigned char* wl = wlayer(F, l);
        const size_t o1 = (size_t)l * D * FF, o2 = (size_t)l * D;
        if (r < I_GU) { transpose_item<1>(inp(F, 8) + o1, inp(F, 7) + o2, D, FF, (bf16*)(wl + WL_GU1), scr, r, F.lane); continue; } r -= I_GU;
        if (r < I_GU) { transpose_item<2>(inp(F, 9) + o1, inp(F, 7) + o2, D, FF, (bf16*)(wl + WL_GU1), scr, r, F.lane); continue; } r -= I_GU;
        if (r < I_DN) { transpose_item<0>(inp(F, 10) + o1, nullptr, FF, D, (bf16*)(wl + WL_D1), scr, r, F.lane); continue; } r -= I_DN;
        if (r < I_IN) { transpose_item<3>(inp(F, 12) + (size_t)l * D * MIXP, inp(F, 11) + o2, D, MIXP, (bf16*)(wl + WL_IN), scr, r, F.lane); continue; } r -= I_IN;
        if (r < I_OUT) { transpose_item<0>(inp(F, 28) + (size_t)l * D * D, nullptr, D, D, (bf16*)(wl + WL_OUT), scr, r, F.lane); continue; } r -= I_OUT;
        if (r < I_GU) { transpose_item<1>(inp(F, 30) + o1, inp(F, 29) + o2, D, FF, (bf16*)(wl + WL_GU2), scr, r, F.lane); continue; } r -= I_GU;
        if (r < I_GU) { transpose_item<2>(inp(F, 31) + o1, inp(F, 29) + o2, D, FF, (bf16*)(wl + WL_GU2), scr, r, F.lane); continue; } r -= I_GU;
        transpose_item<0>(inp(F, 32) + o1, nullptr, FF, D, (bf16*)(wl + WL_D2), scr, r, F.lane);
    }
    const int gt = F.bid * NTHREADS + F.tid, NGT = F.G * NTHREADS;
    for (int i = gt; i < L * RW * 256; i += NGT) { const int l = i / (RW * 256), r = i - l * RW * 256, c = r >> 8, j = r & 255;
        unsigned char* wl = wlayer(F, l);
        if (j < 64) ((bf16*)(wl + WL_W2T))[c * 64 + j] = (bf16)f2bf(inp(F, 17)[((size_t)l * 64 + j) * RW + c]);
        else if (j < 128) ((bf16*)(wl + WL_A2T))[c * 64 + (j - 64)] = (bf16)f2bf(inp(F, 19)[((size_t)l * 64 + (j - 64)) * RW + c]);
        else ((bf16*)(wl + WL_G2T))[c * 128 + (j - 128)] = (bf16)f2bf(inp(F, 20)[((size_t)l * 128 + (j - 128)) * RW + c]); }
    u64* ss0 = ssarr(F, 0); bf16* XB = (bf16*)(F.ws + WS_XB);
    for (int m = gw; m < MP; m += NGW) { const GAS f32x4* xr = (const GAS f32x4*)(inp(F, 0) + (size_t)m * D) + F.lane; GAS f32x4* xo = (GAS f32x4*)(F.out + O_Y + (size_t)m * D) + F.lane;
        GAS v2u* xb = (GAS v2u*)(XB + (size_t)m * D) + F.lane; float s = 0.f;
#pragma unroll
        for (int j = 0; j < 8; ++j) { const f32x4 v = xr[64 * j]; xo[64 * j] = v; v2u p; p.x = pk2(v[0], v[1]); p.y = pk2(v[2], v[3]); xb[64 * j] = p; s += (v[0] * v[0] + v[1] * v[1]) + (v[2] * v[2] + v[3] * v[3]); }
        s = wave_sum(s); if (F.lane == 0) ss0[m] = ss_enc(s); }
}

__device__ __forceinline__ void sample_x_prep(Frame& F, int j, const float* xprev, const u64* accprev, float c, LAS bf16* Alds, LAS float* red) {
    f32x4 v[8]; float sq[8];
#pragma unroll
    for (int i = 0; i < 8; ++i) { v[i] = *(const GAS f32x4*)(xprev + i * D + 4 * F.tid);
        if (accprev != nullptr) { const u64* ap = accprev + i * D + 4 * F.tid; v[i] = v[i] + (f32x4){fx_dec(ap[0]), fx_dec(ap[1]), fx_dec(ap[2]), fx_dec(ap[3])} * c; }
        sq[i] = wave_sum((v[i][0] * v[i][0] + v[i][1] * v[i][1]) + (v[i][2] * v[i][2] + v[i][3] * v[i][3]));
        v2u p; p.x = pk2(v[i][0], v[i][1]); p.y = pk2(v[i][2], v[i][3]); *(LAS v2u*)(Alds + i * D + 4 * F.tid) = p; }
    if (F.lane == 0) {
#pragma unroll
        for (int i = 0; i < 8; ++i) red[F.wave * 8 + i] = sq[i]; }
    __syncthreads();
    if (F.bid == 0) {
        if (j > 0) {
#pragma unroll
            for (int i = 0; i < 8; ++i) *(GAS f32x4*)(xsbuf(F, j) + i * D + 4 * F.tid) = v[i]; }
        if (F.tid < 8) { float s = 0.f;
#pragma unroll
            for (int w = 0; w < 8; ++w) s += red[w * 8 + F.tid];
            rstdbuf(F, j)[F.tid] = 1.0f / sqrtf(s * (1.0f / D) + EPS); }
    }
}
__device__ __forceinline__ void skinny_task(const bf16* Bt, int K, int cg, int k0, int nks, const LAS bf16* Alds, int lda, int a_k0, u64* accout, int N, int lane) {
    const bf16* brow = Bt + (size_t)(cg * 16 + (lane & 15)) * K + k0 + 8 * (lane >> 4);
    const LAS bf16* arow = Alds + (lane & 7) * lda + (k0 - a_k0) + 8 * (lane >> 4);
    f32x4 acc = (f32x4){0.f, 0.f, 0.f, 0.f};
#pragma unroll 4
    for (int ks = 0; ks < nks; ++ks) { const bf16x8 w = *(const GAS bf16x8*)(brow + 32 * ks); const bf16x8 x = *(const LAS bf16x8*)(arow + 32 * ks);
        acc = __builtin_amdgcn_mfma_f32_16x16x32_bf16(w, x, acc, 0, 0, 0); }
    if ((lane & 15) < 8) { u64* o = accout + (size_t)(lane & 15) * N + cg * 16 + 4 * (lane >> 4);
#pragma unroll
        for (int r = 0; r < 4; ++r) (void)__hip_atomic_fetch_add(o + r, fx_enc(acc[r]), __ATOMIC_RELAXED, __HIP_MEMORY_SCOPE_AGENT); }
}
__device__ __forceinline__ void skinny_gemm(Frame& F, const bf16* Bt, int N, int K, int KS, const LAS bf16* Alds, int lda, bool a_is_slice, u64* accout) {
    const int ks = F.bid % KS, jj = F.bid / KS, per = F.G / KS;
    const int klen = K / KS, k0 = ks * klen;
    for (int cg = jj * NWAVES + F.wave; cg < N / 16; cg += per * NWAVES) skinny_task(Bt, K, cg, k0, klen / 32, Alds, lda, a_is_slice ? k0 : 0, accout, N, F.lane);
}
__device__ __forceinline__ void sample_proj(Frame& F, int j, const float* xprev, const u64* accprev, float c, const bf16* Bt, int N, u64* accout) {
    LAS bf16* Alds = (LAS bf16*)F.lds; LAS float* red = (LAS float*)(F.lds + 65536);
    sample_x_prep(F, j, xprev, accprev, c, Alds, red);
    __syncthreads();
    skinny_gemm(F, Bt, N, D, 4, Alds, D, false, accout);
    __syncthreads();
}
__device__ __forceinline__ void sample_down(Frame& F, const u64* accgu, const float* rstd, const bf16* Bt, u64* accout) {
    LAS bf16* Alds = (LAS bf16*)F.lds; constexpr int KS = 16, KL = FF / KS;
    const int k0 = (F.bid % KS) * KL;
    for (int e = F.tid; e < 8 * KL; e += NTHREADS) { const int r = e / KL, kk = e - r * KL, k = k0 + kk; const float rs = rstd[r];
        const int rho = (k >> 7) * 256 + (k & 127); const float g = fx_dec(accgu[(size_t)r * NGU + rho]) * rs, u = fx_dec(accgu[(size_t)r * NGU + rho + 128]) * rs;
        Alds[r * KL + kk] = (bf16)f2bf(g / (1.0f + __expf(-g)) * u); }
    __syncthreads();
    skinny_gemm(F, Bt, D, FF, KS, Alds, KL, true, accout);
    __syncthreads();
}
__device__ __forceinline__ void sample_wout(Frame& F, const float* mixs, const bf16* Bt, u64* accout) {
    LAS bf16* Alds = (LAS bf16*)F.lds;
#pragma unroll
    for (int i = 0; i < 8; ++i) { const f32x4 v = *(const GAS f32x4*)(mixs + i * D + 4 * F.tid); v2u p; p.x = pk2(v[0], v[1]); p.y = pk2(v[2], v[3]); *(LAS v2u*)(Alds + i * D + 4 * F.tid) = p; }
    __syncthreads();
    skinny_gemm(F, Bt, D, D, 16, Alds, D, false, accout);
    __syncthreads();
}

constexpr int M1_TASK_LDS = 40960 + 512;
constexpr int LORS = 264;
__device__ __forceinline__ void m1_phase(Frame& F, int l) {
    RELAUNDER(F);
    const int half = F.wave >> 2, wv = F.wave & 3, tid2 = F.tid & 255, lane = F.lane, kg = lane & 7, rg = lane >> 3;
    LAS unsigned char* tb = F.lds + half * M1_TASK_LDS;
    LAS float* VW = (LAS float*)tb;
    LAS float* VA = VW + 1024;
    LAS float* VBv = VW + 2048;
    LAS float* VK = VW + 3072;
    LAS float* VR = VW + 4096;
    LAS float* VV = VW + 5120;
    LAS bf16* LOR = (LAS bf16*)(tb + 24576);
    constexpr int KR_OFF = (24576 + 16 * LORS * 2) / 4;
    LAS float* KR = VW + KR_OFF;
    LAS float* AS = KR + 1024;
    const bf16* PR = (const bf16*)(F.ws + WS_PR);
    const unsigned char* wl = wlayer(F, l);
    const bf16* w2T = (const bf16*)(wl + WL_W2T); const bf16* a2T = (const bf16*)(wl + WL_A2T); const bf16* g2T = (const bf16*)(wl + WL_G2T);
    const float* mu = inp(F, 15) + (size_t)l * RP; const float* w0 = inp(F, 16) + (size_t)l * RW; const float* a0 = inp(F, 18) + (size_t)l * RW;
    const float* k_k = inp(F, 21) + (size_t)l * RW; const float* k_a = inp(F, 22) + (size_t)l * RW; const float* r_k = inp(F, 23) + (size_t)l * RW;
    float* RT = (float*)(F.ws + WS_RT); float* YZ = (float*)(F.ws + WS_YZ); float* GG = (float*)(F.ws + WS_GG); float* BON = (float*)(F.ws + WS_BON); float* PC = (float*)(F.ws + WS_PC);
    for (int item = F.bid; item < NTASK / 2; item += F.G) {
        const int task = item * 2 + half, nh = task / NCH, c = task - nh * NCH, n = nh / RH, h = nh - n * RH;
        float S[4][8];
#pragma unroll
        for (int i = 0; i < 4; ++i)
#pragma unroll
            for (int j = 0; j < 8; ++j) S[i][j] = (wv < 2 && (32 * wv + 4 * rg + i) == (8 * kg + j)) ? 1.0f : 0.0f;
        for (int sc = 0; sc < 4; ++sc) {
            const int t0 = c * CH + sc * 16;
            for (int q = tid2; q < 16 * 56; q += 256) { const int tok = q / 56, ch = q - tok * 56;
                const int col = ch < 8 ? 64 * h + 8 * ch : (ch < 16 ? RW + 64 * h + 8 * (ch - 8) : (ch < 24 ? 2 * RW + 64 * h + 8 * (ch - 16) : 3 * RW + 8 * (ch - 24)));
                const size_t row = (size_t)n * T + t0 + tok;
                const v4u p8 = *(const GAS v4u*)(PR + row * PRW + col);
                v4u q8 = (v4u){0u, 0u, 0u, 0u}; if (t0 + tok > 0) q8 = *(const GAS v4u*)(PR + (row - 1) * PRW + col);
                const f32x4 m0 = *(const GAS f32x4*)(mu + col), m1 = *(const GAS f32x4*)(mu + col + 4);
                float xm[8];
                { const unsigned pw[4] = {p8.x, p8.y, p8.z, p8.w}, qw[4] = {q8.x, q8.y, q8.z, q8.w};
#pragma unroll
                  for (int e = 0; e < 4; ++e) { const float pl = bflo(pw[e]), ph = bfhi(pw[e]), ql = bflo(qw[e]), qh = bfhi(qw[e]);
                      const float ml = e < 2 ? m0[2 * e] : m1[2 * e - 4], mh = e < 2 ? m0[2 * e + 1] : m1[2 * e - 3];
                      xm[2 * e] = pl + (ql - pl) * ml; xm[2 * e + 1] = ph + (qh - ph) * mh; } }
                if (ch < 24) { LAS float* dst = VW + (ch < 8 ? 4096 : (ch < 16 ? KR_OFF : 5120)) + tok * 64 + 8 * (ch & 7);
                    *(LAS f32x4*)dst = (f32x4){xm[0], xm[1], xm[2], xm[3]}; *(LAS f32x4*)(dst + 4) = (f32x4){xm[4], xm[5], xm[6], xm[7]}; }
                else { const int jc = 8 * (ch - 24);
#pragma unroll
                    for (int e = 0; e < 8; ++e) { if (jc < 64) xm[e] = 1.0f - 2.0f / (1.0f + __expf(2.0f * xm[e])); else if (jc >= 128) xm[e] = sigmoidf_(xm[e]); }
                    v4u o; o.x = pk2(xm[0], xm[1]); o.y = pk2(xm[2], xm[3]); o.z = pk2(xm[4], xm[5]); o.w = pk2(xm[6], xm[7]);
                    *(LAS v4u*)(LOR + tok * LORS + jc) = o; }
            }
            __syncthreads();
            { const int ci = 16 * wv + (lane & 15), c768 = 64 * h + ci, kq = 8 * (lane >> 4);
              f32x4 aw = (f32x4){0.f, 0.f, 0.f, 0.f}, aa = aw, ag = aw;
              const LAS bf16* arow = LOR + (lane & 15) * LORS + kq;
#pragma unroll
              for (int ks = 0; ks < 2; ++ks) { const bf16x8 a = *(const LAS bf16x8*)(arow + 32 * ks); const bf16x8 b = *(const GAS bf16x8*)(w2T + (size_t)c768 * 64 + 32 * ks + kq);
                  aw = __builtin_amdgcn_mfma_f32_16x16x32_bf16(a, b, aw, 0, 0, 0); }
#pragma unroll
              for (int ks = 0; ks < 2; ++ks) { const bf16x8 a = *(const LAS bf16x8*)(arow + 64 + 32 * ks); const bf16x8 b = *(const GAS bf16x8*)(a2T + (size_t)c768 * 64 + 32 * ks + kq);
                  aa = __builtin_amdgcn_mfma_f32_16x16x32_bf16(a, b, aa, 0, 0, 0); }
#pragma unroll
              for (int ks = 0; ks < 4; ++ks) { const bf16x8 a = *(const LAS bf16x8*)(arow + 128 + 32 * ks); const bf16x8 b = *(const GAS bf16x8*)(g2T + (size_t)c768 * 128 + 32 * ks + kq);
                  ag = __builtin_amdgcn_mfma_f32_16x16x32_bf16(a, b, ag, 0, 0, 0); }
              const float w0c = w0[c768], a0c = a0[c768];
#pragma unroll
              for (int r = 0; r < 4; ++r) { const int tok = 4 * (lane >> 4) + r;
                  VW[tok * 64 + ci] = __expf(-0.60653065971f * sigmoidf_(w0c + aw[r]));
                  AS[tok * 64 + ci] = sigmoidf_(a0c + aa[r]);
                  GG[((size_t)nh * T + t0 + tok) * 64 + ci] = ag[r]; } }
            __syncthreads();
            { const int tok = tid2 >> 4, i4 = 4 * (tid2 & 15), cc = 64 * h + i4;
              const f32x4 kr = *(const LAS f32x4*)(KR + tok * 64 + i4), as = *(const LAS f32x4*)(AS + tok * 64 + i4), rr = *(const LAS f32x4*)(VR + tok * 64 + i4), vv = *(const LAS f32x4*)(VV + tok * 64 + i4);
              const f32x4 kkw = *(const GAS f32x4*)(k_k + cc), kaw = *(const GAS f32x4*)(k_a + cc), rkw = *(const GAS f32x4*)(r_k + cc);
              f32x4 kk = kr * kkw; float sq = (kk[0] * kk[0] + kk[1] * kk[1]) + (kk[2] * kk[2] + kk[3] * kk[3]); sq = sum16(sq);
              kk = kk * (1.0f / fmaxf(sqrtf(sq), 1e-12f));
              const f32x4 km = kr * ((as - 1.0f) * kaw + 1.0f);
              float bs = (rr[0] * km[0] * rkw[0] + rr[1] * km[1] * rkw[1]) + (rr[2] * km[2] * rkw[2] + rr[3] * km[3] * rkw[3]); bs = sum16(bs);
              *(LAS f32x4*)(VA + tok * 64 + i4) = -kk; *(LAS f32x4*)(VBv + tok * 64 + i4) = kk * as; *(LAS f32x4*)(VK + tok * 64 + i4) = km;
              *(GAS f32x4*)(BON + ((size_t)nh * T + t0 + tok) * 64 + i4) = vv * bs; }
            __syncthreads();
            { float* yout = RT + (size_t)(wv >> 1) * ((WS_YZ - WS_RT) / 4) + ((size_t)nh * T + t0) * 64 + 32 * (wv & 1) + 4 * rg;
              const int vofs = 32 * (wv & 1) + 4 * rg;
              for (int st = 0; st < 16; ++st) {
                  const f32x4 a0v = *(const LAS f32x4*)(VA + st * 64 + 8 * kg), a1v = *(const LAS f32x4*)(VA + st * 64 + 8 * kg + 4);
                  float sa[4];
#pragma unroll
                  for (int i = 0; i < 4; ++i) { float s = S[i][0] * a0v[0]; s += S[i][1] * a0v[1]; s += S[i][2] * a0v[2]; s += S[i][3] * a0v[3]; s += S[i][4] * a1v[0]; s += S[i][5] * a1v[1]; s += S[i][6] * a1v[2]; s += S[i][7] * a1v[3]; sa[i] = sum8(s); }
                  const f32x4 w0v = *(const LAS f32x4*)(VW + st * 64 + 8 * kg), w1v = *(const LAS f32x4*)(VW + st * 64 + 8 * kg + 4);
                  const f32x4 b0v = *(const LAS f32x4*)(VBv + st * 64 + 8 * kg), b1v = *(const LAS f32x4*)(VBv + st * 64 + 8 * kg + 4);
                  const f32x4 k0v = *(const LAS f32x4*)(VK + st * 64 + 8 * kg), k1v = *(const LAS f32x4*)(VK + st * 64 + 8 * kg + 4);
                  f32x4 vv = (f32x4){0.f, 0.f, 0.f, 0.f}; if (wv >= 2) vv = *(const LAS f32x4*)(VV + st * 64 + vofs);
                  const f32x4 r0v = *(const LAS f32x4*)(VR + st * 64 + 8 * kg), r1v = *(const LAS f32x4*)(VR + st * 64 + 8 * kg + 4);
                  f32x4 y;
#pragma unroll
                  for (int i = 0; i < 4; ++i) { float yy = 0.f;
#pragma unroll
                      for (int j = 0; j < 8; ++j) { const float wj = j < 4 ? w0v[j] : w1v[j - 4], bj = j < 4 ? b0v[j] : b1v[j - 4], kj = j < 4 ? k0v[j] : k1v[j - 4], rj = j < 4 ? r0v[j] : r1v[j - 4];
                          const float sn = S[i][j] * wj + sa[i] * bj + vv[i] * kj; S[i][j] = sn; yy += sn * rj; }
                      y[i] = sum8(yy); }
                  if (kg == 0) *(GAS f32x4*)(yout + st * 64) = y;
              } }
            __syncthreads();
        }
        { float* pc = PC + ((size_t)task * 2 + (wv >> 1)) * 4096 + (size_t)(32 * (wv & 1) + 4 * rg) * 64 + 8 * kg;
#pragma unroll
          for (int i = 0; i < 4; ++i) { *(GAS f32x4*)(pc + i * 64) = (f32x4){S[i][0], S[i][1], S[i][2], S[i][3]}; *(GAS f32x4*)(pc + i * 64 + 4) = (f32x4){S[i][4], S[i][5], S[i][6], S[i][7]}; } }
    }
}

__device__ __forceinline__ void m2_carry(Frame& F, int l) {
    RELAUNDER(F);
    const int nh = F.bid >> 2, qv = F.bid & 3, i = F.tid >> 5, x = F.tid & 31;
    LAS float* Sl = (LAS float*)F.lds;
    LAS float* Pl = (LAS float*)(F.lds + 8192);
    const float* PC = (const float*)(F.ws + WS_PC); float* SC = (float*)(F.ws + WS_SC);
    float zz = 0.f; asm volatile("" : "+v"(zz));
    f32x2 s = (f32x2){zz, zz};
    *(LAS f32x2*)(Sl + i * 64 + 2 * x) = s;
    int cur = 0;
    f32x4 p0, p1; f32x2 z;
    { const float* pc = PC + (size_t)(nh * NCH) * 2 * 4096; p0 = *(const GAS f32x4*)(pc + 8 * F.tid); p1 = *(const GAS f32x4*)(pc + 8 * F.tid + 4); z = *(const GAS f32x2*)(pc + 4096 + (16 * qv + i) * 64 + 2 * x); }
    for (int c = 0; c < NCH; ++c) {
        const int task = nh * NCH + c;
        *(GAS f32x2*)(SC + (size_t)task * 4096 + (16 * qv + i) * 64 + 2 * x) = s;
        *(LAS f32x4*)(Pl + 8 * F.tid) = p0; *(LAS f32x4*)(Pl + 8 * F.tid + 4) = p1;
        __syncthreads();
        f32x2 o = z;
        if (c + 1 < NCH) { const float* pc = PC + (size_t)(task + 1) * 2 * 4096; p0 = *(const GAS f32x4*)(pc + 8 * F.tid); p1 = *(const GAS f32x4*)(pc + 8 * F.tid + 4); z = *(const GAS f32x2*)(pc + 4096 + (16 * qv + i) * 64 + 2 * x); }
        const LAS float* sr = Sl + cur * 1024 + i * 64;
#pragma unroll 8
        for (int k = 0; k < 64; ++k) { const float sv = sr[k]; const f32x2 pp = *(const LAS f32x2*)(Pl + k * 64 + 2 * x); o[0] += sv * pp[0]; o[1] += sv * pp[1]; }
        s = o; cur ^= 1;
        *(LAS f32x2*)(Sl + cur * 1024 + i * 64 + 2 * x) = s;
        __syncthreads();
    }
    const int n = nh / RH, h = nh - n * RH;
    *(GAS f32x2*)(F.out + O_PWKV + ((((size_t)l * NB + n) * RH + h) * 64 + 16 * qv + i) * 64 + 2 * x) = s;
}
__device__ __forceinline__ int crow(int r, int hi) { return (r & 3) + 8 * (r >> 2) + 4 * hi; }
typedef __bf16 bf16x2_t __attribute__((ext_vector_type(2)));
__device__ __forceinline__ unsigned cvtpk_s(float lo, float hi) { f32x2 v = {lo, hi}; bf16x2_t b = __builtin_convertvector(v, bf16x2_t); return __builtin_bit_cast(unsigned, b); }
typedef short v4i16_t __attribute__((ext_vector_type(4)));
__device__ __forceinline__ s16x4 vtr(const LAS unsigned char* p) { return __builtin_bit_cast(s16x4, __builtin_amdgcn_ds_read_tr16_b64_v4i16((LAS v4i16_t*)p)); }
__device__ __forceinline__ void m2_attn_item(Frame& F, int it) {
    const int half = F.wave >> 2, wv = F.wave & 3, tid2 = F.tid & 255, lane = F.lane, l31 = lane & 31, hi = lane >> 5;
    const int unit = it * 2 + half, g = unit >> 9, rem = unit & 511, nh = rem >> 4, idx = rem & 15, n = nh >> 3, h = nh & 7;
    const int dil = g == 0 ? 1 : (g == 1 ? 4 : 16), r = g == 0 ? 0 : (g == 1 ? (idx >> 2) : idx), b = g == 0 ? idx : (g == 1 ? (idx & 3) : 0);
    LAS unsigned char* Vl = F.lds + half * 32768;
    const bf16* QN = (const bf16*)(F.ws + WS_QN); const bf16* KN = (const bf16*)(F.ws + WS_KN); const bf16* VB = (const bf16*)(F.ws + WS_VB);
    const size_t rowbase = (size_t)n * T + r;
    for (int q = tid2; q < 2048; q += 256) { const int key = q >> 3, ch = q & 7, sp = 128 * (b - 1) + key; v4u v = (v4u){0u, 0u, 0u, 0u};
        if (sp >= 0) v = *(const GAS v4u*)(VB + (rowbase + (size_t)dil * sp) * AW + h * 64 + 8 * ch);
        *(LAS v4u*)(Vl + key * 128 + ch * 16) = v; }
    const int sq = 128 * b + 32 * wv + l31;
    bf16x8 qf[4];
    { const bf16* qp = QN + (rowbase + (size_t)dil * sq) * AW + h * 64 + 8 * hi;
#pragma unroll
      for (int ks = 0; ks < 4; ++ks) qf[ks] = *(const GAS bf16x8*)(qp + 16 * ks); }
    const float slope = exp2f(-(float)(h + 1)) * (float)dil;
    f32x16 sc[5];
#pragma unroll
    for (int kt = 0; kt < 5; ++kt) {
        const int kl0 = 32 * wv + 32 * kt;
        int sp = 128 * (b - 1) + kl0 + l31; sp = sp < 0 ? 0 : sp;
        const bf16* kp = KN + (rowbase + (size_t)dil * sp) * AW + h * 64 + 8 * hi;
        f32x16 a;
#pragma unroll
        for (int e = 0; e < 16; ++e) a[e] = 0.f;
#pragma unroll
        for (int ks = 0; ks < 4; ++ks) { const bf16x8 kf = *(const GAS bf16x8*)(kp + 16 * ks); a = __builtin_amdgcn_mfma_f32_32x32x16_bf16(kf, qf[ks], a, 0, 0, 0); }
#pragma unroll
        for (int e = 0; e < 16; ++e) { const int kl = kl0 + crow(e, hi), delta = 128 + 32 * wv + l31 - kl; const bool ok = delta >= 0 && delta <= 128 && (128 * (b - 1) + kl) >= 0;
            a[e] = ok ? a[e] - slope * (float)delta : -INFINITY; }
        sc[kt] = a;
    }
    float m = -INFINITY;
#pragma unroll
    for (int kt = 0; kt < 5; ++kt)
#pragma unroll
        for (int e = 0; e < 16; ++e) m = fmaxf(m, sc[kt][e]);
    m = fmaxf(m, __shfl_xor(m, 32));
    float lsum = 0.f;
#pragma unroll
    for (int kt = 0; kt < 5; ++kt)
#pragma unroll
        for (int e = 0; e < 16; ++e) { const float p = __expf(sc[kt][e] - m); sc[kt][e] = p; lsum += p; }
    lsum += __shfl_xor(lsum, 32);
    __syncthreads();
    f32x16 o[2];
#pragma unroll
    for (int e = 0; e < 16; ++e) { o[0][e] = 0.f; o[1][e] = 0.f; }
    const int i16 = lane & 15, qq = i16 >> 2, pp = i16 & 3, blk = (lane >> 4) & 1;
#pragma unroll
    for (int kt = 0; kt < 5; ++kt) {
        const int kl0 = 32 * wv + 32 * kt;
#pragma unroll
        for (int s2 = 0; s2 < 2; ++s2) {
            v4u pw; pw.x = cvtpk_s(sc[kt][8 * s2], sc[kt][8 * s2 + 1]); pw.y = cvtpk_s(sc[kt][8 * s2 + 2], sc[kt][8 * s2 + 3]); pw.z = cvtpk_s(sc[kt][8 * s2 + 4], sc[kt][8 * s2 + 5]); pw.w = cvtpk_s(sc[kt][8 * s2 + 6], sc[kt][8 * s2 + 7]);
            const bf16x8 pf = __builtin_bit_cast(bf16x8, pw);
#pragma unroll
            for (int dt = 0; dt < 2; ++dt) {
                const LAS unsigned char* base = Vl + (kl0 + 16 * s2 + 4 * hi + qq) * 128 + (32 * dt + 16 * blk + 4 * pp) * 2;
                const s16x4 lo = vtr(base), hh = vtr(base + 8 * 128);
                const bf16x8 vf = (bf16x8){lo[0], lo[1], lo[2], lo[3], hh[0], hh[1], hh[2], hh[3]};
                o[dt] = __builtin_amdgcn_mfma_f32_32x32x16_bf16(vf, pf, o[dt], 0, 0, 0);
            }
        }
    }
    const float inv = 1.0f / lsum;
    float* og = (float*)(F.ws + WS_OG) + ((size_t)g * MP + rowbase + (size_t)dil * sq) * AW + h * 64;
#pragma unroll
    for (int dt = 0; dt < 2; ++dt)
#pragma unroll
        for (int rq = 0; rq < 4; ++rq) *(GAS f32x4*)(og + 32 * dt + 8 * rq + 4 * hi) = (f32x4){o[dt][4 * rq] * inv, o[dt][4 * rq + 1] * inv, o[dt][4 * rq + 2] * inv, o[dt][4 * rq + 3] * inv};
    if (hi == 0) ((float*)(F.ws + WS_LSE))[((size_t)g * MP + rowbase + (size_t)dil * sq) * AH + h] = m + __logf(lsum);
    __syncthreads();
}
__device__ __forceinline__ void ld8f(const bf16* p, float (&o)[8]) { const v4u v = *(const GAS v4u*)p; o[0] = bflo(v.x); o[1] = bfhi(v.x); o[2] = bflo(v.y); o[3] = bfhi(v.y); o[4] = bflo(v.z); o[5] = bfhi(v.z); o[6] = bflo(v.w); o[7] = bfhi(v.w); }
__device__ __forceinline__ void m2_conv_item(Frame& F, int l, int it) {
    if (F.tid >= 384) return;
    const int c8 = F.tid % 96, rs = F.tid / 96, c = 8 * c8;
    const bf16* PR = (const bf16*)(F.ws + WS_PR) + RP; bf16* MIX = (bf16*)(F.ws + WS_MIX);
    const float* cw = inp(F, 26) + (size_t)l * 3 * CW; const float* cb = inp(F, 27) + (size_t)l * CW;
    float w0[8], w1[8], w2[8], bb[8];
#pragma unroll
    for (int e = 0; e < 8; ++e) { w0[e] = cw[c + e]; w1[e] = cw[CW + c + e]; w2[e] = cw[2 * CW + c + e]; bb[e] = cb[c + e]; }
    const int row0 = it * 64 + rs * 16, t00 = row0 & (T - 1);
    float z1[8], z2[8];
#pragma unroll
    for (int e = 0; e < 8; ++e) { z1[e] = 0.f; z2[e] = 0.f; }
    if (t00 >= 1) { float u[8], gc[8]; ld8f(PR + (size_t)(row0 - 1) * PRW + (c), u); ld8f(PR + (size_t)(row0 - 1) * PRW + (2 * CW + c), gc);
#pragma unroll
        for (int e = 0; e < 8; ++e) z1[e] = gc[e] * u[e]; }
    if (t00 >= 2) { float u[8], gc[8]; ld8f(PR + (size_t)(row0 - 2) * PRW + (c), u); ld8f(PR + (size_t)(row0 - 2) * PRW + (2 * CW + c), gc);
#pragma unroll
        for (int e = 0; e < 8; ++e) z2[e] = gc[e] * u[e]; }
    for (int rr = 0; rr < 16; ++rr) { const size_t row = (size_t)row0 + rr; float u[8], gb[8], gc[8], y[8]; ld8f(PR + (size_t)(row) * PRW + (c), u); ld8f(PR + (size_t)(row) * PRW + (CW + c), gb); ld8f(PR + (size_t)(row) * PRW + (2 * CW + c), gc);
#pragma unroll
        for (int e = 0; e < 8; ++e) { const float z0 = gc[e] * u[e]; y[e] = gb[e] * (bb[e] + w0[e] * z2[e] + w1[e] * z1[e] + w2[e] * z0); z2[e] = z1[e]; z1[e] = z0; }
        v4u o; o.x = pk2(y[0], y[1]); o.y = pk2(y[2], y[3]); o.z = pk2(y[4], y[5]); o.w = pk2(y[6], y[7]);
        *(GAS v4u*)(MIX + row * D + AW + RW + c) = o;
        if ((row & (T - 1)) == T - 1) { float* oc = F.out + O_PCV + ((size_t)l * NB + (row >> 11)) * 2 * CW + c;
#pragma unroll
            for (int e = 0; e < 8; ++e) { oc[e] = z2[e]; oc[CW + e] = z1[e]; } }
    }
}
__device__ __forceinline__ void m2_sample_item(Frame& F, int l, int n) {
    LAS float* P = (LAS float*)F.lds;
    LAS float* XM = P + 6400;
    LAS float* SCO = XM + 2560;
    LAS float* VEC = SCO + 8 * 3 * 132;
    LAS float* RED = VEC + 12 * 6 * 64;
    const u64* accp = sacc(F, l, SA_P) + (size_t)n * MIXP; const float rs = rstdbuf(F, 3 * l + 1)[n];
    for (int c = F.tid; c < MIXP; c += NTHREADS) P[c] = fx_dec(accp[dest_row<3>(c)]) * rs;
    __syncthreads();
    float* out = F.out; float* mixs = (float*)(F.ws + WS_MIXS) + ((size_t)l * NS + n) * D;
    { const int h = F.wave, lane = F.lane;
      float q = P[h * 64 + lane], k = P[AW + h * 64 + lane], v = P[2 * AW + h * 64 + lane];
      q = q * (1.0f / sqrtf(wave_sum(q * q) * (1.0f / 64.f) + EPS)) * inp(F, 13)[l * 64 + lane];
      k = k * (1.0f / sqrtf(wave_sum(k * k) * (1.0f / 64.f) + EPS)) * inp(F, 14)[l * 64 + lane];
      out[O_SK + ((size_t)l * NS + n) * AW + h * 64 + lane] = k; out[O_SV + ((size_t)l * NS + n) * AW + h * 64 + lane] = v;
      LAS float* qs = VEC + h * 192; qs[lane] = q; qs[64 + lane] = k; qs[128 + lane] = v;
      LDS_WAIT(); asm volatile("" ::: "memory");
      const float slope = exp2f(-(float)(h + 1));
      const float* ck = inp(F, 2) + ((size_t)(l * NS + n) * 2048) * AW + h * 64; const float* cv = inp(F, 3) + ((size_t)(l * NS + n) * 2048) * AW + h * 64;
      LAS float* sc = SCO + h * 396;
      float mx = -INFINITY;
      for (int g = 0; g < 3; ++g) { const int dil = g == 0 ? 1 : (g == 1 ? 4 : 16);
          for (int j = lane; j <= 128; j += 64) { float s = 0.f;
              if (j == 0) { for (int d = 0; d < 64; ++d) s += qs[d] * qs[64 + d]; }
              else { const float* kp = ck + (size_t)(2048 - dil * j) * AW; for (int d = 0; d < 64; d += 4) { const f32x4 kk4 = *(const GAS f32x4*)(kp + d); s += qs[d] * kk4[0] + qs[d + 1] * kk4[1] + qs[d + 2] * kk4[2] + qs[d + 3] * kk4[3]; } }
              s = s * 0.125f - slope * (float)(dil * j); sc[g * 132 + j] = s; mx = fmaxf(mx, s); } }
#pragma unroll
      for (int o = 1; o < 64; o <<= 1) mx = fmaxf(mx, __shfl_xor(mx, o));
      float ls = 0.f;
      for (int g = 0; g < 3; ++g) for (int j = lane; j <= 128; j += 64) { const float p = __expf(sc[g * 132 + j] - mx); sc[g * 132 + j] = p; ls += p; }
      ls = wave_sum(ls);
      LDS_WAIT(); asm volatile("" ::: "memory");
      float acc = 0.f;
      for (int g = 0; g < 3; ++g) { const int dil = g == 0 ? 1 : (g == 1 ? 4 : 16);
          acc += sc[g * 132] * qs[128 + lane];
          for (int j = 1; j <= 128; ++j) acc += sc[g * 132 + j] * cv[(size_t)(2048 - dil * j) * AW + lane]; }
      mixs[h * 64 + lane] = acc / ls; }
    __syncthreads();
    RELAUNDER(F);
    { const float* sh = inp(F, 5) + ((size_t)l * NS + n) * RP; const float* mu = inp(F, 15) + (size_t)l * RP;
      for (int c = F.tid; c < RP; c += NTHREADS) { const float p = P[3 * AW + c]; XM[c] = p + (sh[c] - p) * mu[c]; out[O_SSH + ((size_t)l * NS + n) * RP + c] = p; } }
    __syncthreads();
#pragma unroll 1
    for (int h = F.wave; h < RH; h += NWAVES) { RELAUNDER(F); const int lane = F.lane, c = h * 64 + lane;
        float sw = inp(F, 16)[(size_t)l * RW + c], sa = inp(F, 18)[(size_t)l * RW + c], sg = 0.f;
        const float* w2 = inp(F, 17) + (size_t)l * 64 * RW; const float* a2 = inp(F, 19) + (size_t)l * 64 * RW; const float* g2 = inp(F, 20) + (size_t)l * 128 * RW;
        for (int j = 0; j < 64; ++j) { const float tw = 1.0f - 2.0f / (1.0f + __expf(2.0f * XM[2304 + j])); sw += tw * w2[(size_t)j * RW + c]; sa += XM[2368 + j] * a2[(size_t)j * RW + c]; }
        for (int j = 0; j < 128; ++j) sg += sigmoidf_(XM[2432 + j]) * g2[(size_t)j * RW + c];
        const float dec = __expf(-0.60653065971f * sigmoidf_(sw)), a = sigmoidf_(sa);
        const float rr = XM[c], kr = XM[RW + c], vr = XM[2 * RW + c];
        float kk = kr * inp(F, 21)[(size_t)l * RW + c]; kk = kk / fmaxf(sqrtf(wave_sum(kk * kk)), 1e-12f);
        const float km = kr * (1.0f + (a - 1.0f) * inp(F, 22)[(size_t)l * RW + c]);
        const float bon = wave_sum(rr * km * inp(F, 23)[(size_t)l * RW + c]);
        LAS float* ve = VEC + h * 384; ve[lane] = -kk; ve[64 + lane] = kk * a; ve[128 + lane] = km; ve[192 + lane] = rr; ve[256 + lane] = dec;
        LDS_WAIT(); asm volatile("" ::: "memory");
        const float* s0 = inp(F, 4) + ((((size_t)l * NS + n) * RH + h) * 64 + lane) * 64; float* so = out + O_SWKV + ((((size_t)l * NS + n) * RH + h) * 64 + lane) * 64;
        float sdot = 0.f;
        for (int k = 0; k < 64; k += 4) { const f32x4 s4 = *(const GAS f32x4*)(s0 + k); sdot += s4[0] * ve[k] + s4[1] * ve[k + 1] + s4[2] * ve[k + 2] + s4[3] * ve[k + 3]; }
        float y = 0.f;
        for (int k = 0; k < 64; k += 4) { const f32x4 s4 = *(const GAS f32x4*)(s0 + k); f32x4 sn;
#pragma unroll
            for (int e = 0; e < 4; ++e) { sn[e] = s4[e] * ve[256 + k + e] + sdot * ve[64 + k + e] + vr * ve[128 + k + e]; y += sn[e] * ve[192 + k + e]; }
            *(GAS f32x4*)(so + k) = sn; }
        const float mean = wave_sum(y) * (1.0f / 64.f), dl = y - mean, var = wave_sum(dl * dl) * (1.0f / 64.f);
        const float yn = dl * (1.0f / sqrtf(var + GN_EPS)) * inp(F, 24)[(size_t)l * RW + c] + inp(F, 25)[(size_t)l * RW + c];
        mixs[AW + c] = (yn + bon * vr) * sg;
    }
    RELAUNDER(F);
    { const float* scv = inp(F, 6) + ((size_t)l * NS + n) * 2 * CW; const float* cw = inp(F, 26) + (size_t)l * 3 * CW; const float* cb = inp(F, 27) + (size_t)l * CW;
      for (int c = F.tid; c < CW; c += NTHREADS) { const float u = P[4096 + c], gb = P[4096 + CW + c], gc = P[4096 + 2 * CW + c], z0 = gc * u, z2 = scv[c], z1 = scv[CW + c];
          mixs[AW + RW + c] = gb * (cb[c] + cw[c] * z2 + cw[CW + c] * z1 + cw[2 * CW + c] * z0);
          float* oc = out + O_SCV + ((size_t)l * NS + n) * 2 * CW; oc[c] = z1; oc[CW + c] = z0; } }
    __syncthreads();
}
__device__ __forceinline__ void m2_phase(Frame& F, int l) {
    if (F.bid < 192) m2_carry(F, l);
    constexpr int N_ATT = 768, N_CONV = MP / 64, N_ITEMS = N_ATT + N_CONV + NS;
    for (;;) {
        __syncthreads();
        if (F.tid == 0) F.MISC[16] = __hip_atomic_fetch_add((unsigned*)(F.ctl + CW_QUEUE + 64 * l), 1u, RLX_AGENT);
        __syncthreads();
        const int it = (int)F.MISC[16];
        if (it >= N_ITEMS) break;
        RELAUNDER(F);
        if (it < N_ATT) m2_attn_item(F, it);
        else if (it < N_ATT + N_CONV) m2_conv_item(F, l, it - N_ATT);
        else m2_sample_item(F, l, it - N_ATT - N_CONV);
    }
}

__device__ __forceinline__ void m3_phase(Frame& F, int l) {
    const int lane = F.lane;
    bf16* MIX = (bf16*)(F.ws + WS_MIX);
    LAS float* RTl = (LAS float*)(F.lds + F.wave * 16384);
    const float* RT = (const float*)(F.ws + WS_RT); const float* YZ = (const float*)(F.ws + WS_YZ); const float* GG = (const float*)(F.ws + WS_GG); const float* BON = (const float*)(F.ws + WS_BON); const float* SC = (const float*)(F.ws + WS_SC);
    for (int task = F.bid * NWAVES + F.wave; task < NTASK; task += F.G * NWAVES) {
        RELAUNDER(F);
        const int nh = task / NCH, c = task - nh * NCH, n = nh / RH, h = nh - n * RH;
        const size_t tb = ((size_t)nh * T + c * CH) * 64;
        float sr[64];
        if (c > 0) {
#pragma unroll
            for (int k = 0; k < 64; k += 4) { const f32x4 s4 = *(const GAS f32x4*)(SC + (size_t)task * 4096 + lane * 64 + k); sr[k] = s4[0]; sr[k + 1] = s4[1]; sr[k + 2] = s4[2]; sr[k + 3] = s4[3]; }
#pragma unroll
            for (int i = 0; i < 16; ++i) *(LAS f32x4*)(RTl + (i * 64 + lane) * 4) = *(const GAS f32x4*)(RT + tb + (size_t)(i * 64 + lane) * 4);
            LDS_WAIT(); asm volatile("" ::: "memory");
        } else {
#pragma unroll
            for (int k = 0; k < 64; ++k) sr[k] = 0.f;
        }
        const float lw = inp(F, 24)[(size_t)l * RW + h * 64 + lane], lb = inp(F, 25)[(size_t)l * RW + h * 64 + lane];
        for (int t = 0; t < CH; ++t) {
            float y = YZ[tb + t * 64 + lane];
            if (c > 0) {
#pragma unroll
                for (int k = 0; k < 64; k += 4) { const f32x4 r4 = *(const LAS f32x4*)(RTl + t * 64 + k); y += sr[k] * r4[0] + sr[k + 1] * r4[1] + sr[k + 2] * r4[2] + sr[k + 3] * r4[3]; } }
            const float mean = wave_sum(y) * (1.0f / 64.f), dl = y - mean, var = wave_sum(dl * dl) * (1.0f / 64.f);
            const float yn = dl * __builtin_amdgcn_rsqf(var + GN_EPS) * lw + lb;
            const float o = (yn + BON[tb + t * 64 + lane]) * GG[tb + t * 64 + lane];
            MIX[((size_t)n * T + c * CH + t) * D + AW + h * 64 + lane] = (bf16)f2bf(o);
        }
        LDS_WAIT(); asm volatile("" ::: "memory");
    }
    const float* OG = (const float*)(F.ws + WS_OG); const float* LSE = (const float*)(F.ws + WS_LSE);
    for (int q = F.bid * NTHREADS + F.tid; q < MP * 64; q += F.G * NTHREADS) { const int row = q >> 6, c8 = (q & 63) * 8, h = c8 >> 6;
        const float l0 = LSE[(size_t)row * AH + h], l1 = LSE[((size_t)MP + row) * AH + h], l2 = LSE[((size_t)2 * MP + row) * AH + h];
        const float mx = fmaxf(l0, fmaxf(l1, l2)), e0 = __expf(l0 - mx), e1 = __expf(l1 - mx), e2 = __expf(l2 - mx), inv = 1.0f / (e0 + e1 + e2);
        f32x4 a = (f32x4){0.f, 0.f, 0.f, 0.f}, b = a;
        { const float* p = OG + (size_t)row * AW + c8; a = a + *(const GAS f32x4*)p * (e0 * inv); b = b + *(const GAS f32x4*)(p + 4) * (e0 * inv); }
        { const float* p = OG + ((size_t)MP + row) * AW + c8; a = a + *(const GAS f32x4*)p * (e1 * inv); b = b + *(const GAS f32x4*)(p + 4) * (e1 * inv); }
        { const float* p = OG + ((size_t)2 * MP + row) * AW + c8; a = a + *(const GAS f32x4*)p * (e2 * inv); b = b + *(const GAS f32x4*)(p + 4) * (e2 * inv); }
        v4u o; o.x = pk2(a[0], a[1]); o.y = pk2(a[2], a[3]); o.z = pk2(b[0], b[1]); o.w = pk2(b[2], b[3]);
        *(GAS v4u*)(MIX + (size_t)row * D + c8) = o; }
}
__device__ __forceinline__ void final_phase(Frame& F) {
    const float* xp = xsbuf(F, 3 * (L - 1) + 2); const u64* ac = sacc(F, L - 1, SA_D2);
    for (int i = F.bid * NTHREADS + F.tid; i < NS * D; i += F.G * NTHREADS) F.out[O_YS + i] = xp[i] + 0.5f * fx_dec(ac[i]);
}
}
namespace fk {
struct Args { const float* in[33]; float* out; unsigned char* ws; int ph_lo, ph_hi; };
constexpr int N_PHASES = 1 + 8 * 2 + L * 5 + 1;
__global__ void __launch_bounds__(NTHREADS, 2) mega(Args args) {
    extern __shared__ __attribute__((aligned(16))) unsigned char lds[];
    Frame F;
    F.lds = (LAS unsigned char*)lds;
    F.MISC = (volatile LAS unsigned*)(F.lds + MISC_OFF);
    F.tid = threadIdx.x; F.lane = F.tid & 63; F.wave = __builtin_amdgcn_readfirstlane(F.tid >> 6);
    F.G = gridDim.x; F.bid = blockIdx.x;
    F.ws = args.ws; F.out = args.out; F.ctl = (gu32*)(args.ws + WS_CTL);
    F.ptab = (const LAS unsigned*)(F.lds + PTAB_OFF);
    if (F.tid < 64) F.MISC[F.tid] = 0u;
    if (F.tid < 33) { const unsigned long long pv = (unsigned long long)args.in[F.tid]; ((LAS unsigned*)(F.lds + PTAB_OFF))[2 * F.tid] = (unsigned)pv; ((LAS unsigned*)(F.lds + PTAB_OFF))[2 * F.tid + 1] = (unsigned)(pv >> 32); }
    __syncthreads();
    const int lo = args.ph_lo, hi = args.ph_hi;
    const bool one_launch = (hi - lo) > 1;
    XcdBarrier bar; bar.bar = (unsigned*)(F.ctl + CW_BAR); bar.x = 0; bar.st = nullptr;
    if (one_launch) bar = xcd_barrier_post((unsigned*)(F.ctl + CW_BAR), F.MISC + 8);
    int ph = 0;
#define PHASE_BEGIN if (ph >= lo && ph < hi) { { int t_ = threadIdx.x; asm volatile("" : "+v"(t_)); F.tid = t_; F.lane = t_ & 63; F.wave = __builtin_amdgcn_readfirstlane(t_ >> 6); int b_ = blockIdx.x; asm volatile("" : "+s"(b_)); F.bid = b_; }
#define PHASE_END   if (ph + 1 < hi) xcd_barrier(bar); } ++ph;
    bf16* XB = (bf16*)(F.ws + WS_XB); bf16* HB = (bf16*)(F.ws + WS_H); bf16* MIX = (bf16*)(F.ws + WS_MIX);
    float* X = F.out + O_Y;

    PHASE_BEGIN p0_prologue(F); PHASE_END

    for (int s = 0; s < 2 * L; ++s) {
        const int l = s >> 1, second = s & 1;
        unsigned char* wl = wlayer(F, l);
        PHASE_BEGIN
            const int j = 3 * l + (second ? 2 : 0);
            const float* xprev = j == 0 ? inp(F, 1) : (j == 1 ? inp(F, 1) : xsbuf(F, j - 1));
            const u64* accprev = j == 0 ? nullptr : (second ? sacc(F, l, SA_O) : sacc(F, l - 1, SA_D2));
            sample_proj(F, j, xprev, accprev, second ? 1.0f : 0.5f, (const bf16*)(wl + (second ? WL_GU2 : WL_GU1)), NGU, sacc(F, l, second ? SA_GU2 : SA_GU1));
            pg8::Gemm g{XB, (const bf16*)(wl + (second ? WL_GU2 : WL_GU1)), MP, NGU, D}; pg8::StaticOrder S; S.init(MP, NGU, F.G, F.bid);
            pg8::EpiSwiglu E{HB, ssarr(F, j), FF};
            pg8::gemm_phase<pg8::EpiSwiglu, pg8::StaticOrder, true, true>(F.lds, g, S, E, F.tid);
        PHASE_END
        PHASE_BEGIN
            const int j = 3 * l + (second ? 2 : 0);
            sample_down(F, sacc(F, l, second ? SA_GU2 : SA_GU1), rstdbuf(F, j), (const bf16*)(wl + (second ? WL_D2 : WL_D1)), sacc(F, l, second ? SA_D2 : SA_D1));
            pg8::Gemm g{HB, (const bf16*)(wl + (second ? WL_D2 : WL_D1)), MP, D, FF}; pg8::StaticOrder S; S.init(MP, D, F.G, F.bid);
            u64* ssn = second ? (l + 1 < L ? ssarr(F, 3 * (l + 1)) : nullptr) : ssarr(F, 3 * l + 1);
            pg8::EpiResid E{X, XB, ssn, 0.5f};
            pg8::gemm_phase<pg8::EpiResid, pg8::StaticOrder, true, true>(F.lds, g, S, E, F.tid);
        PHASE_END
        if (!second) {
            PHASE_BEGIN
                const int j = 3 * l + 1;
                sample_proj(F, j, l == 0 ? inp(F, 1) : xsbuf(F, j - 1), sacc(F, l, SA_D1), 0.5f, (const bf16*)(wl + WL_IN), MIXP, sacc(F, l, SA_P));
                pg8::Gemm g{XB, (const bf16*)(wl + WL_IN), MP, MIXP, D}; pg8::StaticOrder S; S.init(MP, MIXP, F.G, F.bid);
                static_assert(WS_KN - WS_QN == WS_VB - WS_KN, "QN | KN | VB equally spaced");
                pg8::EpiWin E{ssarr(F, j), (bf16*)(F.ws + WS_QN), (bf16*)(F.ws + WS_PR), F.out + O_PK + (size_t)l * MP * AW, F.out + O_PSH + (size_t)l * NB * RP,
                              inp(F, 13) + l * 64, inp(F, 14) + l * 64, (WS_KN - WS_QN) / 2, O_PV - O_PK};
                pg8::gemm_phase<pg8::EpiWin, pg8::StaticOrder, true, true>(F.lds, g, S, E, F.tid);
            PHASE_END
            PHASE_BEGIN m1_phase(F, l); PHASE_END
            PHASE_BEGIN m2_phase(F, l); PHASE_END
            PHASE_BEGIN m3_phase(F, l); PHASE_END
            PHASE_BEGIN
                sample_wout(F, (const float*)(F.ws + WS_MIXS) + (size_t)l * NS * D, (const bf16*)(wl + WL_OUT), sacc(F, l, SA_O));
                pg8::Gemm g{MIX, (const bf16*)(wl + WL_OUT), MP, D, D}; pg8::StaticOrder S; S.init(MP, D, F.G, F.bid);
                pg8::EpiResid E{X, XB, ssarr(F, 3 * l + 2), 1.0f};
                pg8::gemm_phase<pg8::EpiResid, pg8::StaticOrder, true, true>(F.lds, g, S, E, F.tid);
            PHASE_END
        }
    }
    PHASE_BEGIN final_phase(F); PHASE_END
#undef PHASE_BEGIN
#undef PHASE_END
}

static int g_grid = 0;
static bool fast_setup() {
    if (g_grid != 0) return g_grid > 0;
    int dev = 0, cus = 0, per_cu = 0;
    if (hipGetDevice(&dev) != hipSuccess || hipDeviceGetAttribute(&cus, hipDeviceAttributeMultiprocessorCount, dev) != hipSuccess) { fprintf(stderr, "fast_setup: device query failed\n"); g_grid = -1; return false; }
    if (hipFuncSetAttribute((const void*)mega, hipFuncAttributeMaxDynamicSharedMemorySize, LDS_BYTES) != hipSuccess) { fprintf(stderr, "fast_setup: hipFuncSetAttribute failed\n"); g_grid = -1; return false; }
    if (hipOccupancyMaxActiveBlocksPerMultiprocessor(&per_cu, (const void*)mega, NTHREADS, LDS_BYTES) != hipSuccess || per_cu < 1) fprintf(stderr, "fast_setup: occupancy query reports %d blocks per CU\n", per_cu);
    (void)hipGetLastError();
    g_grid = cus;
    fprintf(stderr, "fast_setup: grid %d, occupancy %d\n", g_grid, per_cu);
    return true;
}
static void launch_range(void* const* d_in, float* out, void* d_ws, int lo, int hi, hipStream_t stream) {
    Args a; memset(&a, 0, sizeof(a));
    for (int i = 0; i < 33; ++i) a.in[i] = (const float*)d_in[i];
    a.out = out; a.ws = (unsigned char*)d_ws; a.ph_lo = lo; a.ph_hi = hi;
    hipLaunchKernelGGL(mega, dim3(g_grid), dim3(NTHREADS), LDS_BYTES, stream, a);
    const hipError_t le = hipPeekAtLastError();
    if (le != hipSuccess) fprintf(stderr, "launch_range [%d,%d) failed: %s\n", lo, hi, hipGetErrorName(le));
}
}
#ifndef KMODE
#define KMODE 1
#endif
#ifndef PROBE_ONE_LAUNCH
#define PROBE_ONE_LAUNCH 0
#endif
extern "C" void kernel_launch(void* const* d_in, const int* in_sizes, int n_in, void* d_out, int out_size, void* d_ws, size_t ws_size, hipStream_t stream) {
    constexpr size_t MiB = 1u << 20;
    if (n_in != 33 || out_size != (int)fk::O_END || ws_size < fk::WS_FAST_END) { fprintf(stderr, "kernel_launch: unexpected sizes n_in %d out %d ws %zu\n", n_in, out_size, ws_size); return; }
    if (!fk::fast_setup()) return;
#if KMODE == 2
    constexpr size_t OFF_OUT2 = 1137 * MiB, OFF_SNAP = 1340 * MiB, OFF_FMIX = 1405 * MiB, OFF_END = 1440 * MiB;
    static_assert(OFF_OUT2 >= fk::WS_FAST_END && OFF_OUT2 + fk::O_END * 4 <= OFF_SNAP && OFF_SNAP + (size_t)nv::R * 2048 * 4 <= OFF_FMIX && OFF_FMIX + (size_t)8192 * 2048 * 2 <= OFF_END, "probe map");
    if (ws_size < OFF_END) { fprintf(stderr, "kernel_launch: PROBE needs %zu bytes of workspace, got %zu\n", (size_t)OFF_END, ws_size); return; }
    float* out2 = (float*)((char*)d_ws + OFF_OUT2); float* snap = (float*)((char*)d_ws + OFF_SNAP); unsigned short* fmix = (unsigned short*)((char*)d_ws + OFF_FMIX);
    nv::forward(d_in, (float*)d_out, (float*)d_ws, stream, snap);
    float* fout = out2;
#else
    float* fout = (float*)d_out;
#endif
    hipMemsetAsync((char*)d_ws + fk::WS_CTL, 0, fk::CTL_ZERO_BYTES, stream);
#if KMODE == 0 || (KMODE == 2 && PROBE_ONE_LAUNCH)
    fk::launch_range(d_in, fout, d_ws, 0, fk::N_PHASES, stream);
#if KMODE == 2
#endif
#else
    for (int p = 0; p < fk::N_PHASES; ++p) {
        fk::launch_range(d_in, fout, d_ws, p, p + 1, stream);
#if KMODE == 2
        if (p == 1 + 2 + 4 - 1) hipMemcpyAsync(fmix, (char*)d_ws + fk::WS_MIX, (size_t)8192 * 2048 * 2, hipMemcpyDeviceToDevice, stream);
#endif
    }
#endif
#if KMODE == 2
    {   float* slots = (float*)((char*)d_ws + fk::WS_CTL) + 12288;
        const float* o = (const float*)d_out; int s = 0;
        auto cmpo = [&](size_t off, size_t n) { pb::cmp(false, out2 + off, n, o + off, n, 1, (int)n, slots, s++, stream); };
        for (int l = 0; l < 4; ++l) {
            cmpo(fk::O_PK + (size_t)l * 8192 * 512, (size_t)8192 * 512); cmpo(fk::O_PV + (size_t)l * 8192 * 512, (size_t)8192 * 512);
            cmpo(fk::O_SK + (size_t)l * 8 * 512, 8 * 512); cmpo(fk::O_SV + (size_t)l * 8 * 512, 8 * 512);
            cmpo(fk::O_PSH + (size_t)l * 4 * 2560, 4 * 2560); cmpo(fk::O_SSH + (size_t)l * 8 * 2560, 8 * 2560);
            cmpo(fk::O_PCV + (size_t)l * 4 * 1536, 4 * 1536); cmpo(fk::O_SCV + (size_t)l * 8 * 1536, 8 * 1536);
            cmpo(fk::O_PWKV + (size_t)l * 4 * 12 * 4096, (size_t)4 * 12 * 4096); cmpo(fk::O_SWKV + (size_t)l * 8 * 12 * 4096, (size_t)8 * 12 * 4096);
            if (l == 0) {
#if !PROBE_ONE_LAUNCH
                pb::cmp(true, fmix, 2048, snap, 2048, 8192, 512, slots, s++, stream);
                pb::cmp(true, fmix + 512, 2048, snap + 512, 2048, 8192, 768, slots, s++, stream);
                pb::cmp(true, fmix + 1280, 2048, snap + 1280, 2048, 8192, 768, slots, s++, stream);
#else
                s += 3;
#endif
                pb::cmp(false, (const float*)((char*)d_ws + fk::WS_MIXS), 2048, snap + (size_t)8192 * 2048, 2048, 8, 2048, slots, s++, stream);
            }
        }
        cmpo(fk::O_Y, (size_t)8192 * 2048); cmpo(fk::O_YS, 8 * 2048);
        pb::k_encode<<<1, 256, 0, stream>>>(slots, s, (float*)d_out + fk::O_YS, 8 * 2048, 1e-3f);
    }
#endif
}
```

```cpp
#include <hip/hip_runtime.h>
#include <hip/hip_bf16.h>
#include <cstdio>
#include <cstdint>
#include <cmath>
#include <cstring>
#define KMODE 0
#define PROBE_ONE_LAUNCH 0
#define REP_CLASS 0
#define REP_COUNT 1
namespace fk {
#define GAS __attribute__((address_space(1)))
#define LAS __attribute__((address_space(3)))
typedef unsigned short bf16;
typedef unsigned v4u __attribute__((ext_vector_type(4)));
typedef unsigned v2u __attribute__((ext_vector_type(2)));
typedef float f32x4 __attribute__((ext_vector_type(4)));
typedef float f32x2 __attribute__((ext_vector_type(2)));
typedef float f32x16 __attribute__((ext_vector_type(16)));
typedef short bf16x8 __attribute__((ext_vector_type(8)));
typedef short s16x4 __attribute__((ext_vector_type(4)));
typedef GAS unsigned gu32;

constexpr int D = 2048, NB = 4, T = 2048, MP = NB * T, NS = 8, L = 4;
constexpr int AW = 512, AH = 8, RW = 768, RH = 12, CW = 768, RP = 2560, MIXP = 6400, FF = 5632, PRW = RP + 3 * CW  ;
constexpr int NGU = 2 * FF;
constexpr float EPS = 1e-6f, GN_EPS = 64e-5f;
constexpr int NWAVES = 8, NTHREADS = 512;
constexpr int NCH = 32, CH = 64;
constexpr int NTASK = NB * RH * NCH;

constexpr size_t O_Y = 0, O_YS = 16777216, O_PK = 16793600, O_PV = 33570816, O_PWKV = 50348032, O_PSH = 51134464, O_PCV = 51175424,
                 O_SK = 51200000, O_SV = 51216384, O_SWKV = 51232768, O_SSH = 52805632, O_SCV = 52887552, O_END = 52936704;

constexpr size_t alignup(size_t x) { return (x + 4095) & ~(size_t)4095; }
constexpr int CW_TMO = 0;
constexpr int CW_BAR = 4096;
constexpr int CW_QUEUE = 8192;
constexpr size_t CTL_U32 = 16384;
constexpr size_t WS_CTL = 0;
constexpr size_t WS_SS = WS_CTL + CTL_U32 * 4;
constexpr size_t WS_SACC = WS_SS + (size_t)12 * MP * 8;
constexpr int SA_GU1 = 0, SA_D1 = 8 * NGU, SA_P = SA_D1 + 8 * D, SA_O = SA_P + 8 * MIXP, SA_GU2 = SA_O + 8 * D, SA_D2 = SA_GU2 + 8 * NGU, SA_LAYER = SA_D2 + 8 * D;
constexpr size_t CTL_ZERO_BYTES = alignup(WS_SACC + (size_t)L * SA_LAYER * 8);
constexpr size_t WS_XS = CTL_ZERO_BYTES;
constexpr size_t WS_RSTD = WS_XS + (size_t)13 * NS * D * 4;
constexpr size_t WS_MIXS = alignup(WS_RSTD + 13 * 8 * 4);
constexpr size_t WB_GU = (size_t)NGU * D * 2, WB_D = (size_t)D * FF * 2, WB_IN = (size_t)MIXP * D * 2, WB_OUT = (size_t)D * D * 2;
constexpr size_t WL_GU1 = 0, WL_D1 = WL_GU1 + WB_GU, WL_IN = WL_D1 + WB_D, WL_OUT = WL_IN + WB_IN, WL_GU2 = WL_OUT + WB_OUT, WL_D2 = WL_GU2 + WB_GU, WL_W2T = WL_D2 + WB_D,
                 WL_A2T = WL_W2T + (size_t)RW * 64 * 2, WL_G2T = WL_A2T + (size_t)RW * 64 * 2, WL_LAYER = alignup(WL_G2T + (size_t)RW * 128 * 2);
constexpr size_t WS_W = alignup(WS_MIXS + (size_t)L * NS * D * 4);
constexpr size_t WS_XB = WS_W + (size_t)L * WL_LAYER;
constexpr size_t WS_H = WS_XB + (size_t)MP * D * 2;
constexpr size_t WS_QN = WS_H + (size_t)MP * FF * 2;
constexpr size_t WS_KN = WS_QN + (size_t)MP * AW * 2;
constexpr size_t WS_VB = WS_KN + (size_t)MP * AW * 2;
constexpr size_t WS_PR = WS_VB + (size_t)MP * AW * 2;
constexpr size_t WS_MIX = WS_PR + (size_t)MP * PRW * 2;
constexpr size_t WS_OG = WS_MIX + (size_t)MP * D * 2;
constexpr size_t WS_LSE = WS_OG + (size_t)3 * MP * AW * 4;
constexpr size_t WS_PC = WS_LSE + (size_t)3 * MP * AH * 4;
constexpr size_t WS_RT = WS_PC + (size_t)NTASK * 2 * 4096 * 4;
constexpr size_t WS_YZ = WS_RT + (size_t)48 * T * 64 * 4;
constexpr size_t WS_GG = WS_YZ + (size_t)48 * T * 64 * 4;
constexpr size_t WS_BON = WS_GG + (size_t)48 * T * 64 * 4;
constexpr size_t WS_SC = WS_BON + (size_t)48 * T * 64 * 4;
constexpr size_t WS_FAST_END = WS_SC + (size_t)NTASK * 4096 * 4;

constexpr int LDS_BYTES = 147456;
constexpr int RING_BYTES = 131072;
constexpr int MISC_OFF = LDS_BYTES - 256;
constexpr int PTAB_OFF = LDS_BYTES - 1024;

#define RLX_AGENT __ATOMIC_RELAXED, __HIP_MEMORY_SCOPE_AGENT
#define LDS_WAIT() asm volatile("s_waitcnt lgkmcnt(0)" ::: "memory")
#define VM_WAIT() asm volatile("s_waitcnt vmcnt(0)" ::: "memory")
__device__ __forceinline__ unsigned f2bf(float f) { unsigned u = __builtin_bit_cast(unsigned, f); return (u + 0x7fffu + ((u >> 16) & 1u)) >> 16; }
__device__ __forceinline__ unsigned pk2(float lo, float hi) { return f2bf(lo) | (f2bf(hi) << 16); }
__device__ __forceinline__ float bf2f(unsigned short b) { return __builtin_bit_cast(float, (unsigned)b << 16); }
__device__ __forceinline__ float bflo(unsigned w) { return __builtin_bit_cast(float, w << 16); }
__device__ __forceinline__ float bfhi(unsigned w) { return __builtin_bit_cast(float, w & 0xffff0000u); }
typedef unsigned long long u64;
constexpr float SS_SCALE = 16777216.0f, SS_INV = 1.0f / 16777216.0f;
__device__ __forceinline__ u64 ss_enc(float s) { return (u64)((double)s * 16777216.0); }
__device__ __forceinline__ float ss_dec(u64 v) { return (float)v * SS_INV; }
__device__ __forceinline__ u64 fx_enc(float a) { return (u64)(long long)__double2ll_rn((double)a * 4294967296.0); }
__device__ __forceinline__ float fx_dec(u64 v) { return (float)((double)(long long)v * 2.3283064365386963e-10); }
__device__ __forceinline__ float sigmoidf_(float x) { return 1.0f / (1.0f + __expf(-x)); }
__device__ __forceinline__ float wave_sum(float v) {
#pragma unroll
    for (int o = 1; o < 64; o <<= 1) v += __shfl_xor(v, o);
    return v;
}
__device__ __forceinline__ float dpp_x1(float x) { return __builtin_bit_cast(float, __builtin_amdgcn_update_dpp(0, __builtin_bit_cast(int, x), 0xB1, 0xF, 0xF, true)); }
__device__ __forceinline__ float dpp_x2(float x) { return __builtin_bit_cast(float, __builtin_amdgcn_update_dpp(0, __builtin_bit_cast(int, x), 0x4E, 0xF, 0xF, true)); }
__device__ __forceinline__ float dpp_hm(float x) { return __builtin_bit_cast(float, __builtin_amdgcn_update_dpp(0, __builtin_bit_cast(int, x), 0x141, 0xF, 0xF, true)); }
__device__ __forceinline__ float dpp_rm(float x) { return __builtin_bit_cast(float, __builtin_amdgcn_update_dpp(0, __builtin_bit_cast(int, x), 0x140, 0xF, 0xF, true)); }
__device__ __forceinline__ float sum8(float x) { x += dpp_x1(x); x += dpp_x2(x); x += dpp_hm(x); return x; }
__device__ __forceinline__ float sum16(float x) { x = sum8(x); x += dpp_rm(x); return x; }

#define XB_TMO      128
#define XB_XCNT(j)  (256  + 64 * (j))
#define XB_XSUB(j)  (1280 + 64 * (j))
#define XB_XGEN(j)  (2304 + 64 * (j))
#define XB_TOP      3328
#define XB_TOPGEN   3392
#define XCD_BAR_WORDS 3456
#define XB_SPIN_CAP (1u << 20)
__device__ __forceinline__ unsigned xb_ld(unsigned* p)              { return __hip_atomic_load(p, __ATOMIC_RELAXED, __HIP_MEMORY_SCOPE_AGENT); }
__device__ __forceinline__ unsigned xb_add(unsigned* p, unsigned v) { return __hip_atomic_fetch_add(p, v, __ATOMIC_RELAXED, __HIP_MEMORY_SCOPE_AGENT); }
__device__ __forceinline__ unsigned xb_xcc_id() { return (unsigned)__builtin_amdgcn_s_getreg((3 << 11) | 20) & 0xFu; }
#define XB_SPIN(cond, bar) do { unsigned _sp = 0; while (cond) { __builtin_amdgcn_s_sleep(1); \
    if ((++_sp & 255u) == 0u) { if (xb_ld(&(bar)[XB_TMO])) break; if (_sp > XB_SPIN_CAP) { atomicAdd(&(bar)[XB_TMO], 1u); break; } } } } while (0)
struct XcdBarrier { unsigned* bar; unsigned x; volatile LAS unsigned* st; };
__device__ __forceinline__ XcdBarrier xcd_barrier_post(unsigned* bar, volatile LAS unsigned* st) {
    XcdBarrier b; b.bar = bar; b.x = xb_xcc_id(); b.st = st;
    if (threadIdx.x == 0) (void)xb_add(&bar[XB_XCNT(b.x)], 1u);
    return b;
}
__device__ __forceinline__ void xcd_barrier_complete(unsigned* bar, unsigned x, unsigned& nloc, unsigned& nx) {
    const unsigned G = gridDim.x * gridDim.y * gridDim.z;
    unsigned sum, cnt, mine, sp = 0u;
    for (;;) {
        sum = 0u; cnt = 0u; mine = 0u;
#pragma unroll
        for (unsigned j = 0; j < 16; ++j) { const unsigned c = xb_ld(&bar[XB_XCNT(j)]); sum += c; cnt += (c > 0u) ? 1u : 0u; mine = (j == x) ? c : mine; }
        if (sum == G) break;
        __builtin_amdgcn_s_sleep(1);
        if ((++sp & 255u) == 0u) { if (xb_ld(&bar[XB_TMO])) break; if (sp > XB_SPIN_CAP) { atomicAdd(&bar[XB_TMO], 1u); break; } }
    }
    nloc = mine > 0u ? mine : 1u; nx = cnt > 0u ? cnt : 1u;
}
__device__ __forceinline__ void xcd_barrier(const XcdBarrier& b) {
    asm volatile("s_waitcnt vmcnt(0)" ::: "memory");
    __syncthreads();
    if (threadIdx.x == 0) {
        unsigned* bar = b.bar;
        __builtin_amdgcn_s_waitcnt(0);
        unsigned nloc = b.st[0], nx = b.st[1];
        if (nloc == 0u) { xcd_barrier_complete(bar, b.x, nloc, nx); b.st[0] = nloc; b.st[1] = nx; }
        const unsigned old = xb_add(&bar[XB_XSUB(b.x)], 1u);
        const unsigned gen = old / nloc;
        if (old + 1u == (gen + 1u) * nloc) {
            __builtin_amdgcn_fence(__ATOMIC_RELEASE, "agent");
            asm volatile("s_waitcnt vmcnt(0)" ::: "memory");
            const unsigned og = xb_add(&bar[XB_TOP], 1u);
            const unsigned tg = og / nx;
            if (og + 1u == (tg + 1u) * nx) xb_add(&bar[XB_TOPGEN], 1u);
            else XB_SPIN(xb_ld(&bar[XB_TOPGEN]) == tg, bar);
            __builtin_amdgcn_fence(__ATOMIC_ACQUIRE, "agent");
            xb_add(&bar[XB_XGEN(b.x)], 1u);
            asm volatile("s_waitcnt vmcnt(0)" ::: "memory");
        } else {
            XB_SPIN(xb_ld(&bar[XB_XGEN(b.x)]) == gen, bar);
            __builtin_amdgcn_fence(__ATOMIC_ACQUIRE, "agent");
            asm volatile("s_waitcnt vmcnt(0)" ::: "memory");
        }
    }
    __syncthreads();
}
}
namespace pg8 {
#define PG8_LAS __attribute__((address_space(3)))
typedef unsigned short bf16_t;
typedef short bf16x8 __attribute__((ext_vector_type(8)));
typedef float f32x4 __attribute__((ext_vector_type(4)));
typedef unsigned u32x4 __attribute__((ext_vector_type(4)));
constexpr int BM = 256, BK = 64, HALF = 128, HTB = HALF * BK * 2  , STAGE_BYTES = 8 * HTB, NXCD = 8, WGM = 8;

__host__ __device__ __forceinline__ int lds_byte(int r, int c) { const int st = (r >> 4) * 2 + (c >> 5), rr = r & 15, cc = c & 31, ob = rr * 64 + cc * 2; return st * 1024 + (ob ^ (((ob >> 9) & 1) << 5)); }
__host__ __device__ __forceinline__ void stage_rc(int b, int& R, int& C) { const int st = b / 1024, sb = b % 1024, swz = sb ^ (((sb >> 9) & 1) << 5); R = (st >> 1) * 16 + swz / 64; C = (st & 1) * 32 + (swz % 64) / 2; }
__host__ __device__ __forceinline__ int perm32(int rho) { const int n = rho >> 4, i = rho & 15; return 8 * (i >> 2) + 4 * n + (i & 3); }

struct Unit { int pm, pn; };
struct Gemm { const bf16_t* A; const bf16_t* Bt; int M, N, K; };

struct StaticOrder {
    int nM, nN, nwg, G, c;
    __host__ __device__ void init(int M, int N, int G_, int c_) { nM = M / BM; nN = N / BM; nwg = nM * nN; G = G_; c = c_; }
    __host__ __device__ bool next(int i, Unit& u) const {
        const long L = (long)i * G + c; if (L >= nwg) return false;
        int wgid = (int)L; { const int q = nwg / NXCD, r = nwg % NXCD, xcd = wgid % NXCD, off = wgid / NXCD; wgid = (xcd < r ? xcd * (q + 1) : r * (q + 1) + (xcd - r) * q) + off; }
        const int nig = WGM * nN, gid = wgid / nig, fm = gid * WGM, gsz = (nM - fm) < WGM ? (nM - fm) : WGM;
        u.pm = fm + ((wgid % nig) % gsz); u.pn = (wgid % nig) / gsz; return true;
    }
    __device__ __forceinline__ void a_ready(const Unit&) const {}
    __device__ __forceinline__ void done(const Unit&) const {}
};

__device__ __forceinline__ unsigned cvt_pk_bf16(float lo, float hi) { unsigned r; asm volatile("v_cvt_pk_bf16_f32 %0, %1, %2" : "=v"(r) : "v"(lo), "v"(hi)); return r; }
__device__ __forceinline__ u32x4 pack8(const f32x4& a, const f32x4& b) { u32x4 w; w.x = cvt_pk_bf16(a[0], a[1]); w.y = cvt_pk_bf16(a[2], a[3]); w.z = cvt_pk_bf16(b[0], b[1]); w.w = cvt_pk_bf16(b[2], b[3]); return w; }
__device__ __forceinline__ float silu_f(float g) { return g * __builtin_amdgcn_rcpf(1.0f + __expf(-g)); }
constexpr float kEps = 1e-6f;

struct EpiSwiglu {
    static constexpr bool PERM = true, AFTER_DRAIN = false;
    bf16_t* H; const unsigned long long* ss; int ldh;
    __device__ __forceinline__ void operator()(const f32x4 (&acc)[2][2][4][2], const Unit& u, int wr, int wc, int fr, int fq) const {
        const int row0 = u.pm * BM + wr * 64 + fr, col0 = u.pn * HALF + wc * 32 + 8 * fq;
#pragma unroll
        for (int ai = 0; ai < 2; ++ai)
#pragma unroll
            for (int m = 0; m < 4; ++m) { const int row = row0 + ai * HALF + m * 16; const float rs = __builtin_amdgcn_rsqf((float)ss[row] * (1.0f / (16777216.0f * 2048.0f)) + kEps);
                f32x4 h0, h1;
#pragma unroll
                for (int j = 0; j < 4; ++j) { h0[j] = silu_f(acc[ai][0][m][0][j] * rs) * (acc[ai][1][m][0][j] * rs); h1[j] = silu_f(acc[ai][0][m][1][j] * rs) * (acc[ai][1][m][1][j] * rs); }
                *(u32x4*)(H + (size_t)row * ldh + col0) = pack8(h0, h1); }
    }
};
struct EpiResid {
    static constexpr bool PERM = true, AFTER_DRAIN = false;
    float* X; bf16_t* XB; unsigned long long* ssn; float coef;
    __device__ __forceinline__ void operator()(const f32x4 (&acc)[2][2][4][2], const Unit& u, int wr, int wc, int fr, int fq) const {
        const int row0 = u.pm * BM + wr * 64 + fr, col0 = u.pn * BM + wc * 32 + 8 * fq;
#pragma unroll
        for (int ai = 0; ai < 2; ++ai)
#pragma unroll
            for (int m = 0; m < 4; ++m) { const int row = row0 + ai * HALF + m * 16; float part = 0.f;
#pragma unroll
                for (int bj = 0; bj < 2; ++bj) { float* xp = X + (size_t)row * 2048 + col0 + bj * HALF;
                    f32x4 x0 = *(const f32x4*)xp, x1 = *(const f32x4*)(xp + 4);
                    x0 = x0 + acc[ai][bj][m][0] * coef; x1 = x1 + acc[ai][bj][m][1] * coef;
                    *(f32x4*)xp = x0; *(f32x4*)(xp + 4) = x1;
                    *(u32x4*)(XB + (size_t)row * 2048 + col0 + bj * HALF) = pack8(x0, x1);
                    part += (x0[0] * x0[0] + x0[1] * x0[1]) + (x0[2] * x0[2] + x0[3] * x0[3]) + (x1[0] * x1[0] + x1[1] * x1[1]) + (x1[2] * x1[2] + x1[3] * x1[3]); }
                part += __shfl_xor(part, 16); part += __shfl_xor(part, 32);
                if (ssn != nullptr && fq == 0) (void)__hip_atomic_fetch_add(ssn + row, (unsigned long long)((double)part * 16777216.0), __ATOMIC_RELAXED, __HIP_MEMORY_SCOPE_AGENT); }
    }
};
struct EpiWin {
    static constexpr bool PERM = true, AFTER_DRAIN = false;
    const unsigned long long* ss; bf16_t *QN, *PR; float *outK, *outSh; const float *qg, *kg; size_t qkv_stride, kv_out_stride;
    __device__ __forceinline__ void operator()(const f32x4 (&acc)[2][2][4][2], const Unit& u, int wr, int wc, int fr, int fq) const {
        const int row0 = u.pm * BM + wr * 64 + fr;
        if (u.pn < 6) {
            const int type = u.pn >> 1, head = 4 * (u.pn & 1) + wc;
            f32x4 gn[2][2];
#pragma unroll
            for (int bj = 0; bj < 2; ++bj)
#pragma unroll
                for (int n = 0; n < 2; ++n) { const int d = 32 * bj + 8 * fq + 4 * n;
                    const f32x4 gq = *(const f32x4*)(qg + d) * 0.125f, gk = *(const f32x4*)(kg + d);
                    gn[bj][n] = type == 0 ? gq : (type == 1 ? gk : (f32x4){1.f, 1.f, 1.f, 1.f}); }
            bf16_t* const dst = QN + (size_t)type * qkv_stride;
            float* const od = outK + (size_t)(type >> 1) * kv_out_stride;
#pragma unroll
            for (int ai = 0; ai < 2; ++ai)
#pragma unroll
                for (int m = 0; m < 4; ++m) { const int row = row0 + ai * HALF + m * 16; const float rs = __builtin_amdgcn_rsqf((float)ss[row] * (1.0f / (16777216.0f * 2048.0f)) + kEps);
                    f32x4 v[2][2]; float q = 0.f;
#pragma unroll
                    for (int bj = 0; bj < 2; ++bj)
#pragma unroll
                        for (int n = 0; n < 2; ++n) { v[bj][n] = acc[ai][bj][m][n] * rs; q += (v[bj][n][0] * v[bj][n][0] + v[bj][n][1] * v[bj][n][1]) + (v[bj][n][2] * v[bj][n][2] + v[bj][n][3] * v[bj][n][3]); }
                    q += __shfl_xor(q, 16); q += __shfl_xor(q, 32);
                    const float hn = type < 2 ? __builtin_amdgcn_rsqf(q * (1.0f / 64.0f) + kEps) : 1.0f;
#pragma unroll
                    for (int bj = 0; bj < 2; ++bj) { const f32x4 a = v[bj][0] * hn * gn[bj][0], b = v[bj][1] * hn * gn[bj][1];
                        const size_t o = (size_t)row * 512 + head * 64 + 32 * bj + 8 * fq;
                        *(u32x4*)(dst + o) = pack8(a, b);
                        if (type >= 1) { *(f32x4*)(od + o) = a; *(f32x4*)(od + o + 4) = b; } } }
        } else {
            const int colp = u.pn * BM + wc * 32 + 8 * fq - 1536;
#pragma unroll
            for (int ai = 0; ai < 2; ++ai)
#pragma unroll
                for (int m = 0; m < 4; ++m) { const int row = row0 + ai * HALF + m * 16; const float rs = __builtin_amdgcn_rsqf((float)ss[row] * (1.0f / (16777216.0f * 2048.0f)) + kEps);
#pragma unroll
                    for (int bj = 0; bj < 2; ++bj) { const f32x4 a = acc[ai][bj][m][0] * rs, b = acc[ai][bj][m][1] * rs; const int c = colp + bj * HALF;
                        *(u32x4*)(PR + (size_t)row * 4864 + c) = pack8(a, b);
                        if (u.pn < 16 && (row & 2047) == 2047) { float* o = outSh + (size_t)(row >> 11) * 2560 + c; *(f32x4*)o = a; *(f32x4*)(o + 4) = b; } } }
        }
    }
};
template <class Epi, class Sched, bool ALIGN_EPI = false, bool SP2 = false>
__device__ __forceinline__ void gemm_phase(PG8_LAS unsigned char* lds, const Gemm g, const Sched& S, const Epi& E, const int tid) {
    const int wid = __builtin_amdgcn_readfirstlane(tid >> 6), lane = tid & 63, wr = wid >> 2, wc = wid & 3, fr = lane & 15, fq = lane >> 4;
    const int K = g.K, nt = K / BK;
    unsigned voffA[2], voffB[2];
#pragma unroll
    for (int i = 0; i < 2; ++i) { int R, C; stage_rc(tid * 16 + i * 8192, R, C); const int Rb = Epi::PERM ? ((R & ~31) + perm32(R & 31)) : R;
        voffA[i] = (unsigned)(R * K + C) * 2u; voffB[i] = (unsigned)(Rb * K + C) * 2u; }
    const size_t kstep = (size_t)(BK * 2);
    const size_t hstep = (size_t)HALF * K * 2;
    const size_t tstep = 2 * hstep;
    const unsigned ldsw = (unsigned)wid * 1024u;
    const int aoff = lds_byte(wr * 64 + fr, fq * 8), boff = lds_byte(wc * 32 + fr, fq * 8);
#define PG8_SA(b, h) (((b) * 2 + (h)) * HTB)
#define PG8_SB(b, h) ((4 + (b) * 2 + (h)) * HTB)
#define PG8_STAGE(bufoff, gbase, voff) do { _Pragma("unroll") for (int _i = 0; _i < 2; ++_i) \
        __builtin_amdgcn_global_load_lds((const unsigned*)((const char*)(gbase) + (voff)[_i]), (PG8_LAS unsigned*)(lds + (bufoff) + ldsw + _i * 8192), 16, 0, 0); } while (0)
#define PG8_LDA(dst, b, h) do { _Pragma("unroll") for (int m = 0; m < 4; ++m) _Pragma("unroll") for (int k = 0; k < 2; ++k) dst[m][k] = *(const PG8_LAS bf16x8*)(lds + PG8_SA(b, h) + aoff + m * 2048 + k * 1024); } while (0)
#define PG8_LDB(dst, b, h) do { _Pragma("unroll") for (int n = 0; n < 2; ++n) _Pragma("unroll") for (int k = 0; k < 2; ++k) dst[n][k] = *(const PG8_LAS bf16x8*)(lds + PG8_SB(b, h) + boff + n * 2048 + k * 1024); } while (0)
#define PG8_MMA(ai, bj, At, Bt) do { __builtin_amdgcn_s_setprio(1); _Pragma("unroll") for (int m = 0; m < 4; ++m) _Pragma("unroll") for (int n = 0; n < 2; ++n) _Pragma("unroll") for (int k = 0; k < 2; ++k) \
        acc[ai][bj][m][n] = __builtin_amdgcn_mfma_f32_16x16x32_bf16(Bt[n][k], At[m][k], acc[ai][bj][m][n], 0, 0, 0); __builtin_amdgcn_s_setprio(0); } while (0)
#define PG8_WAIT_V(n) asm volatile("s_waitcnt vmcnt(" #n ")" ::: "memory")
#define PG8_WAIT_L(n) asm volatile("s_waitcnt lgkmcnt(" #n ")" ::: "memory")
#define PG8_BAR __builtin_amdgcn_s_barrier()
#define PG8_SCHED __builtin_amdgcn_sched_barrier(0)
    Unit cur, nxt; int ui = 0;
    if (!S.next(0, cur)) return;
    f32x4 acc[2][2][4][2];
#pragma unroll
    for (int a = 0; a < 2; ++a)
#pragma unroll
        for (int b = 0; b < 2; ++b)
#pragma unroll
            for (int m = 0; m < 4; ++m)
#pragma unroll
                for (int n = 0; n < 2; ++n) acc[a][b][m][n] = (f32x4){0.f, 0.f, 0.f, 0.f};
    bf16x8 At[4][2], B0[2][2], B1[2][2];
    const char* cA = (const char*)g.A + (size_t)cur.pm * tstep; const char* cB = (const char*)g.Bt + (size_t)cur.pn * tstep;
    S.a_ready(cur);
    if constexpr (SP2) {
        PG8_STAGE(PG8_SB(0, 0), cB, voffB); PG8_STAGE(PG8_SB(0, 1), cB + hstep, voffB); PG8_STAGE(PG8_SA(0, 0), cA, voffA); PG8_STAGE(PG8_SA(0, 1), cA + hstep, voffA);
        if (wr == 1) PG8_BAR;
        PG8_WAIT_V(2); PG8_BAR;
        PG8_STAGE(PG8_SB(1, 0), cB + kstep, voffB); PG8_STAGE(PG8_SA(1, 0), cA + kstep, voffA); PG8_STAGE(PG8_SB(1, 1), cB + hstep + kstep, voffB);
        PG8_WAIT_V(6); PG8_BAR;
    } else {
        PG8_STAGE(PG8_SB(0, 0), cB, voffB); PG8_STAGE(PG8_SA(0, 0), cA, voffA); PG8_STAGE(PG8_SB(0, 1), cB + hstep, voffB); PG8_STAGE(PG8_SA(0, 1), cA + hstep, voffA);
        if (wr == 1) PG8_BAR;
        PG8_WAIT_V(4); PG8_BAR;
        PG8_STAGE(PG8_SB(1, 0), cB + kstep, voffB); PG8_STAGE(PG8_SA(1, 0), cA + kstep, voffA); PG8_STAGE(PG8_SB(1, 1), cB + hstep + kstep, voffB);
        PG8_WAIT_V(6); PG8_BAR;
    }
    for (;;) {
        const bool has_next = S.next(ui + 1, nxt);
        const char* nA = has_next ? (const char*)g.A + (size_t)nxt.pm * tstep : cA; const char* nB = has_next ? (const char*)g.Bt + (size_t)nxt.pn * tstep : cB;
        for (int t = 0; t < nt; t += 2) {
            const bool last = (t == nt - 2);
            const char* a1 = cA + (size_t)(t + 1) * kstep;
            const char* a2 = last ? nA : cA + (size_t)(t + 2) * kstep; const char* b2 = last ? nB : cB + (size_t)(t + 2) * kstep;
            const char* a3 = a2 + kstep; const char* b3 = b2 + kstep;
            if (last && has_next) S.a_ready(nxt);
            if constexpr (SP2) {
            PG8_LDB(B0, 0, 0); PG8_LDB(B1, 0, 1); PG8_SCHED; PG8_LDA(At, 0, 0); PG8_STAGE(PG8_SA(1, 1), a1 + hstep, voffA);
            PG8_WAIT_V(8); PG8_WAIT_L(0); PG8_BAR; PG8_MMA(0, 0, At, B0); PG8_MMA(0, 1, At, B1); PG8_BAR; PG8_SCHED;
            PG8_LDA(At, 0, 1); PG8_STAGE(PG8_SB(0, 0), b2, voffB); PG8_STAGE(PG8_SB(0, 1), b2 + hstep, voffB); PG8_STAGE(PG8_SA(0, 0), a2, voffA);
            PG8_WAIT_V(8); PG8_WAIT_L(0); PG8_BAR; PG8_MMA(1, 0, At, B0); PG8_MMA(1, 1, At, B1); PG8_BAR; PG8_SCHED;
            PG8_LDB(B0, 1, 0); PG8_LDB(B1, 1, 1); PG8_SCHED; PG8_LDA(At, 1, 0); PG8_STAGE(PG8_SA(0, 1), a2 + hstep, voffA);
            PG8_WAIT_V(8); PG8_WAIT_L(0); PG8_BAR; PG8_MMA(0, 0, At, B0); PG8_MMA(0, 1, At, B1); PG8_BAR; PG8_SCHED;
            PG8_LDA(At, 1, 1); PG8_STAGE(PG8_SB(1, 0), b3, voffB); PG8_STAGE(PG8_SB(1, 1), b3 + hstep, voffB); PG8_STAGE(PG8_SA(1, 0), a3, voffA);
            PG8_WAIT_V(8); PG8_WAIT_L(0); PG8_BAR; PG8_MMA(1, 0, At, B0); PG8_MMA(1, 1, At, B1); PG8_BAR; PG8_SCHED;
            } else {
            PG8_LDB(B0, 0, 0); PG8_SCHED; PG8_LDA(At, 0, 0); PG8_STAGE(PG8_SA(1, 1), a1 + hstep, voffA);
            PG8_WAIT_L(8); PG8_BAR; PG8_WAIT_L(0); PG8_MMA(0, 0, At, B0); PG8_BAR; PG8_SCHED;
            PG8_LDB(B1, 0, 1); PG8_STAGE(PG8_SB(0, 0), b2, voffB);
            PG8_BAR; PG8_WAIT_L(0); PG8_MMA(0, 1, At, B1); PG8_BAR;
            PG8_LDA(At, 0, 1); PG8_STAGE(PG8_SA(0, 0), a2, voffA);
            PG8_BAR; PG8_WAIT_L(0); PG8_MMA(1, 0, At, B0); PG8_BAR; PG8_SCHED;
            PG8_STAGE(PG8_SB(0, 1), b2 + hstep, voffB);
            PG8_WAIT_V(6); PG8_BAR; PG8_MMA(1, 1, At, B1); PG8_BAR;
            PG8_LDB(B0, 1, 0); PG8_SCHED; PG8_LDA(At, 1, 0); PG8_STAGE(PG8_SA(0, 1), a2 + hstep, voffA);
            PG8_WAIT_L(8); PG8_BAR; PG8_WAIT_L(0); PG8_MMA(0, 0, At, B0); PG8_BAR; PG8_SCHED;
            PG8_LDB(B1, 1, 1); PG8_STAGE(PG8_SB(1, 0), b3, voffB);
            PG8_BAR; PG8_WAIT_L(0); PG8_MMA(0, 1, At, B1); PG8_BAR;
            PG8_LDA(At, 1, 1); PG8_STAGE(PG8_SA(1, 0), a3, voffA);
            PG8_BAR; PG8_WAIT_L(0); PG8_MMA(1, 0, At, B0); PG8_BAR; PG8_SCHED;
            PG8_STAGE(PG8_SB(1, 1), b3 + hstep, voffB);
            PG8_WAIT_V(6); PG8_BAR; PG8_MMA(1, 1, At, B1); PG8_BAR;
            }
        }
        if constexpr (ALIGN_EPI) { if (wr == 0) PG8_BAR; }
        if constexpr (!Epi::AFTER_DRAIN) { E(acc, cur, wr, wc, fr, fq); S.done(cur); }
        if (!has_next) break;
#pragma unroll
        for (int a = 0; a < 2; ++a)
#pragma unroll
            for (int b = 0; b < 2; ++b)
#pragma unroll
                for (int m = 0; m < 4; ++m)
#pragma unroll
                    for (int n = 0; n < 2; ++n) acc[a][b][m][n] = (f32x4){0.f, 0.f, 0.f, 0.f};
        cur = nxt; cA = nA; cB = nB; ++ui;
        if constexpr (ALIGN_EPI) { if (wr == 1) PG8_BAR; }
    }
    PG8_WAIT_V(0);
    if constexpr (!ALIGN_EPI) { if (wr == 0) PG8_BAR; }
    PG8_BAR;
    if constexpr (Epi::AFTER_DRAIN) { E.fused(acc, cur, wr, wc, fr, fq, lds, wid, lane); S.done(cur); }
#undef PG8_SA
#undef PG8_SB
#undef PG8_STAGE
#undef PG8_LDA
#undef PG8_LDB
#undef PG8_MMA
#undef PG8_WAIT_V
#undef PG8_WAIT_L
#undef PG8_BAR
#undef PG8_SCHED
}
}
namespace fk {
struct Frame {
    LAS unsigned char* lds;
    volatile LAS unsigned* MISC;
    gu32* ctl;
    int tid, lane, wave, G, bid;
    const LAS unsigned* ptab;
    float* out;
    unsigned char* ws;
};
__device__ __forceinline__ const float* inp(const Frame& F, int i) { const unsigned lo = __builtin_amdgcn_readfirstlane(F.ptab[2 * i]), hi = __builtin_amdgcn_readfirstlane(F.ptab[2 * i + 1]); return (const float*)(((unsigned long long)hi << 32) | lo); }
__device__ __forceinline__ unsigned char* wlayer(const Frame& F, int l) { return F.ws + WS_W + (size_t)l * WL_LAYER; }
__device__ __forceinline__ u64* ssarr(const Frame& F, int j) { return (u64*)(F.ws + WS_SS) + (size_t)j * MP; }
__device__ __forceinline__ u64* sacc(const Frame& F, int l, int off) { return (u64*)(F.ws + WS_SACC) + (size_t)l * SA_LAYER + off; }
__device__ __forceinline__ float* xsbuf(const Frame& F, int j) { return (float*)(F.ws + WS_XS) + (size_t)j * NS * D; }
__device__ __forceinline__ float* rstdbuf(const Frame& F, int j) { return (float*)(F.ws + WS_RSTD) + j * 8; }

#define RELAUNDER(F) do { int t_ = threadIdx.x; asm volatile("" : "+v"(t_)); (F).tid = t_; (F).lane = t_ & 63; (F).wave = __builtin_amdgcn_readfirstlane(t_ >> 6); } while (0)
template <int MAP> __device__ __forceinline__ int dest_row(int n) {
    if (MAP == 1) return (n >> 7) * 256 + (n & 127);
    if (MAP == 2) return (n >> 7) * 256 + 128 + (n & 127);
    if (MAP == 3) { if (n >= 1536) return n; const int tile = n >> 8, loc = n & 255, hh = loc >> 6, d = loc & 63; return tile * 256 + (d >> 5) * 128 + hh * 32 + (d & 31); }
    return n;
}
template <int MAP> __device__ __forceinline__ void transpose_item(const float* W, const float* gk, int K, int N, bf16* WT, LAS float* scr, int item, int lane) {
    const int nblk = N >> 6, kb = item / nblk, nb = item - kb * nblk, k0 = kb * 64, n0 = nb * 64;
    const int lr = lane >> 4, lc = (lane & 15) * 4;
    f32x4 vv[16];
#pragma unroll
    for (int i = 0; i < 16; ++i) vv[i] = *(const GAS f32x4*)(W + (size_t)(k0 + 4 * i + lr) * N + n0 + lc);
#pragma unroll
    for (int i = 0; i < 16; ++i) { const int kk = 4 * i + lr; f32x4 v = vv[i];
        if (gk != nullptr) v = v * gk[k0 + kk];
        LAS float* s = scr + kk * 65 + lc; s[0] = v[0]; s[1] = v[1]; s[2] = v[2]; s[3] = v[3]; }
    LDS_WAIT(); asm volatile("" ::: "memory");
    const int c = lane & 7;
#pragma unroll
    for (int jj = 0; jj < 8; ++jj) { const int n = (lane >> 3) + 8 * jj; const LAS float* s = scr + (8 * c) * 65 + n;
        v4u o; o.x = pk2(s[0], s[65]); o.y = pk2(s[2 * 65], s[3 * 65]); o.z = pk2(s[4 * 65], s[5 * 65]); o.w = pk2(s[6 * 65], s[7 * 65]);
        *(GAS v4u*)(WT + (size_t)dest_row<MAP>(n0 + n) * K + k0 + 8 * c) = o; }
    LDS_WAIT(); asm volatile("" ::: "memory");
}
__device__ __forceinline__ void p0_prologue(Frame& F) {
    LAS float* scr = (LAS float*)(F.lds + F.wave * 16640);
    const int gw = F.bid * NWAVES + F.wave, NGW = F.G * NWAVES;
    constexpr int I_GU = (D / 64) * (FF / 64), I_DN = (FF / 64) * (D / 64), I_IN = (D / 64) * (MIXP / 64), I_OUT = (D / 64) * (D / 64);
    constexpr int PER_LAYER = 6 * I_GU + I_IN + I_OUT;
    static_assert(I_GU == I_DN, "item counts");
    for (int it = gw; it < L * PER_LAYER; it += NGW) {
        const int l = it / PER_LAYER; int r = it - l * PER_LAYER;
        unsigned char* wl = wlayer(F, l);
        const size_t o1 = (size_t)l * D * FF, o2 = (size_t)l * D;
        if (r < I_GU) { transpose_item<1>(inp(F, 8) + o1, inp(F, 7) + o2, D, FF, (bf16*)(wl + WL_GU1), scr, r, F.lane); continue; } r -= I_GU;
        if (r < I_GU) { transpose_item<2>(inp(F, 9) + o1, inp(F, 7) + o2, D, FF, (bf16*)(wl + WL_GU1), scr, r, F.lane); continue; } r -= I_GU;
        if (r < I_DN) { transpose_item<0>(inp(F, 10) + o1, nullptr, FF, D, (bf16*)(wl + WL_D1), scr, r, F.lane); continue; } r -= I_DN;
        if (r < I_IN) { transpose_item<3>(inp(F, 12) + (size_t)l * D * MIXP, inp(F, 11) + o2, D, MIXP, (bf16*)(wl + WL_IN), scr, r, F.lane); continue; } r -= I_IN;
        if (r < I_OUT) { transpose_item<0>(inp(F, 28) + (size_t)l * D * D, nullptr, D, D, (bf16*)(wl + WL_OUT), scr, r, F.lane); continue; } r -= I_OUT;
        if (r < I_GU) { transpose_item<1>(inp(F, 30) + o1, inp(F, 29) + o2, D, FF, (bf16*)(wl + WL_GU2), scr, r, F.lane); continue; } r -= I_GU;
        if (r < I_GU) { transpose_item<2>(inp(F, 31) + o1, inp(F, 29) + o2, D, FF, (bf16*)(wl + WL_GU2), scr, r, F.lane); continue; } r -= I_GU;
        transpose_item<0>(inp(F, 32) + o1, nullptr, FF, D, (bf16*)(wl + WL_D2), scr, r, F.lane);
    }
    const int gt = F.bid * NTHREADS + F.tid, NGT = F.G * NTHREADS;
    for (int i = gt; i < L * RW * 256; i += NGT) { const int l = i / (RW * 256), r = i - l * RW * 256, c = r >> 8, j = r & 255;
        unsigned char* wl = wlayer(F, l);
        if (j < 64) ((bf16*)(wl + WL_W2T))[c * 64 + j] = (bf16)f2bf(inp(F, 17)[((size_t)l * 64 + j) * RW + c]);
        else if (j < 128) ((bf16*)(wl + WL_A2T))[c * 64 + (j - 64)] = (bf16)f2bf(inp(F, 19)[((size_t)l * 64 + (j - 64)) * RW + c]);
        else ((bf16*)(wl + WL_G2T))[c * 128 + (j - 128)] = (bf16)f2bf(inp(F, 20)[((size_t)l * 128 + (j - 128)) * RW + c]); }
    u64* ss0 = ssarr(F, 0); bf16* XB = (bf16*)(F.ws + WS_XB);
    for (int m = gw; m < MP; m += NGW) { const GAS f32x4* xr = (const GAS f32x4*)(inp(F, 0) + (size_t)m * D) + F.lane; GAS f32x4* xo = (GAS f32x4*)(F.out + O_Y + (size_t)m * D) + F.lane;
        GAS v2u* xb = (GAS v2u*)(XB + (size_t)m * D) + F.lane; float s = 0.f;
#pragma unroll
        for (int j = 0; j < 8; ++j) { const f32x4 v = xr[64 * j]; xo[64 * j] = v; v2u p; p.x = pk2(v[0], v[1]); p.y = pk2(v[2], v[3]); xb[64 * j] = p; s += (v[0] * v[0] + v[1] * v[1]) + (v[2] * v[2] + v[3] * v[3]); }
        s = wave_sum(s); if (F.lane == 0) ss0[m] = ss_enc(s); }
}

__device__ __forceinline__ void sample_x_prep(Frame& F, int j, const float* xprev, const u64* accprev, float c, LAS bf16* Alds, LAS float* red) {
    f32x4 v[8]; float sq[8];
#pragma unroll
    for (int i = 0; i < 8; ++i) { v[i] = *(const GAS f32x4*)(xprev + i * D + 4 * F.tid);
        if (accprev != nullptr) { const u64* ap = accprev + i * D + 4 * F.tid; v[i] = v[i] + (f32x4){fx_dec(ap[0]), fx_dec(ap[1]), fx_dec(ap[2]), fx_dec(ap[3])} * c; }
        sq[i] = wave_sum((v[i][0] * v[i][0] + v[i][1] * v[i][1]) + (v[i][2] * v[i][2] + v[i][3] * v[i][3]));
        v2u p; p.x = pk2(v[i][0], v[i][1]); p.y = pk2(v[i][2], v[i][3]); *(LAS v2u*)(Alds + i * D + 4 * F.tid) = p; }
    if (F.lane == 0) {
#pragma unroll
        for (int i = 0; i < 8; ++i) red[F.wave * 8 + i] = sq[i]; }
    __syncthreads();
    if (F.bid == 0) {
        if (j > 0) {
#pragma unroll
            for (int i = 0; i < 8; ++i) *(GAS f32x4*)(xsbuf(F, j) + i * D + 4 * F.tid) = v[i]; }
        if (F.tid < 8) { float s = 0.f;
#pragma unroll
            for (int w = 0; w < 8; ++w) s += red[w * 8 + F.tid];
            rstdbuf(F, j)[F.tid] = 1.0f / sqrtf(s * (1.0f / D) + EPS); }
    }
}
template <int NKS> __device__ __forceinline__ void skinny_task(const bf16* Bt, int K, int cg, int k0, const LAS bf16* Alds, int lda, int a_k0, u64* accout, int N, int lane) {
    const bf16* brow = Bt + (size_t)(cg * 16 + (lane & 15)) * K + k0 + 8 * (lane >> 4);
    const LAS bf16* arow = Alds + (lane & 7) * lda + (k0 - a_k0) + 8 * (lane >> 4);
    bf16x8 w[NKS];
#pragma unroll
    for (int ks = 0; ks < NKS; ++ks) w[ks] = *(const GAS bf16x8*)(brow + 32 * ks);
    f32x4 acc = (f32x4){0.f, 0.f, 0.f, 0.f};
#pragma unroll
    for (int ks = 0; ks < NKS; ++ks) { const bf16x8 x = *(const LAS bf16x8*)(arow + 32 * ks); acc = __builtin_amdgcn_mfma_f32_16x16x32_bf16(w[ks], x, acc, 0, 0, 0); }
    if ((lane & 15) < 8) { u64* o = accout + (size_t)(lane & 15) * N + cg * 16 + 4 * (lane >> 4);
#pragma unroll
        for (int r = 0; r < 4; ++r) (void)__hip_atomic_fetch_add(o + r, fx_enc(acc[r]), __ATOMIC_RELAXED, __HIP_MEMORY_SCOPE_AGENT); }
}
template <int KS, int NKS> __device__ __forceinline__ void skinny_gemm(Frame& F, const bf16* Bt, int N, int K, const LAS bf16* Alds, int lda, bool a_is_slice, u64* accout) {
    const int ks = F.bid % KS, jj = F.bid / KS, per = F.G / KS;
    const int k0 = ks * 32 * NKS;
    for (int cg = jj * NWAVES + F.wave; cg < N / 16; cg += per * NWAVES) skinny_task<NKS>(Bt, K, cg, k0, Alds, lda, a_is_slice ? k0 : 0, accout, N, F.lane);
}
__device__ __forceinline__ void sample_proj(Frame& F, int j, const float* xprev, const u64* accprev, float c, const bf16* Bt, int N, u64* accout) {
    LAS bf16* Alds = (LAS bf16*)F.lds; LAS float* red = (LAS float*)(F.lds + 65536);
    sample_x_prep(F, j, xprev, accprev, c, Alds, red);
    __syncthreads();
    skinny_gemm<4, 16>(F, Bt, N, D, Alds, D, false, accout);
    __syncthreads();
}
__device__ __forceinline__ void sample_down(Frame& F, const u64* accgu, const float* rstd, const bf16* Bt, u64* accout) {
    LAS bf16* Alds = (LAS bf16*)F.lds; constexpr int KS = 16, KL = FF / KS;
    const int k0 = (F.bid % KS) * KL;
    for (int e = F.tid; e < 8 * KL; e += NTHREADS) { const int r = e / KL, kk = e - r * KL, k = k0 + kk; const float rs = rstd[r];
        const int rho = (k >> 7) * 256 + (k & 127); const float g = fx_dec(accgu[(size_t)r * NGU + rho]) * rs, u = fx_dec(accgu[(size_t)r * NGU + rho + 128]) * rs;
        Alds[r * KL + kk] = (bf16)f2bf(g / (1.0f + __expf(-g)) * u); }
    __syncthreads();
    skinny_gemm<16, 11>(F, Bt, D, FF, Alds, KL, true, accout);
    __syncthreads();
}
__device__ __forceinline__ void sample_wout(Frame& F, const float* mixs, const bf16* Bt, u64* accout) {
    LAS bf16* Alds = (LAS bf16*)F.lds;
#pragma unroll
    for (int i = 0; i < 8; ++i) { const f32x4 v = *(const GAS f32x4*)(mixs + i * D + 4 * F.tid); v2u p; p.x = pk2(v[0], v[1]); p.y = pk2(v[2], v[3]); *(LAS v2u*)(Alds + i * D + 4 * F.tid) = p; }
    __syncthreads();
    skinny_gemm<16, 4>(F, Bt, D, D, Alds, D, false, accout);
    __syncthreads();
}

constexpr int M1_TASK_LDS = 44544;
constexpr int LORS = 264;
__device__ __forceinline__ int m1_col(int ch, int h) { return ch < 8 ? 64 * h + 8 * ch : (ch < 16 ? RW + 64 * h + 8 * (ch - 8) : (ch < 24 ? 2 * RW + 64 * h + 8 * (ch - 16) : 3 * RW + 8 * (ch - 24))); }
__device__ __forceinline__ void m1_phase(Frame& F, int l) {
    RELAUNDER(F);
    const int half = F.wave >> 2, wv = F.wave & 3, tid2 = F.tid & 255, lane = F.lane, kg = lane & 7, rg = lane >> 3;
    LAS unsigned char* tb = F.lds + half * M1_TASK_LDS;
    LAS float* VW = (LAS float*)tb;
    LAS float* VA = VW + 1024;
    LAS float* VBv = VW + 2048;
    LAS float* VK = VW + 3072;
    LAS float* VR = VW + 4096;
    LAS float* VV = VW + 5120;
    LAS bf16* LOR = (LAS bf16*)(tb + 24576);
    constexpr int KR_OFF = (24576 + 16 * LORS * 2) / 4;
    LAS float* KR = VW + KR_OFF;
    LAS float* AS = KR + 1024;
    LAS float* MUl = AS + 1024;
    LAS float* CST = MUl + 448;
    const bf16* PR = (const bf16*)(F.ws + WS_PR);
    const unsigned char* wl = wlayer(F, l);
    const bf16* w2T = (const bf16*)(wl + WL_W2T); const bf16* a2T = (const bf16*)(wl + WL_A2T); const bf16* g2T = (const bf16*)(wl + WL_G2T);
    const float* mu = inp(F, 15) + (size_t)l * RP; const float* w0 = inp(F, 16) + (size_t)l * RW; const float* a0 = inp(F, 18) + (size_t)l * RW;
    const float* k_k = inp(F, 21) + (size_t)l * RW; const float* k_a = inp(F, 22) + (size_t)l * RW; const float* r_k = inp(F, 23) + (size_t)l * RW;
    float* RT = (float*)(F.ws + WS_RT); float* GG = (float*)(F.ws + WS_GG); float* BON = (float*)(F.ws + WS_BON); float* PC = (float*)(F.ws + WS_PC);
    for (int item = F.bid; item < NTASK / 2; item += F.G) {
        const int task = item * 2 + half, nh = task / NCH, c = task - nh * NCH, n = nh / RH, h = nh - n * RH;
        for (int i = tid2; i < 448; i += 256) MUl[i] = mu[m1_col(i >> 3, h) + (i & 7)];
        for (int i = tid2; i < 320; i += 256) { const int which = i >> 6, cc = 64 * h + (i & 63);
            float v; if (which == 0) v = k_k[cc]; else if (which == 1) v = k_a[cc]; else if (which == 2) v = r_k[cc]; else if (which == 3) v = w0[cc]; else v = a0[cc];
            CST[i] = v; }
        const int ci = 16 * wv + (lane & 15), c768 = 64 * h + ci, kq = 8 * (lane >> 4);
        bf16x8 bw[2], ba[2], bg[4];
#pragma unroll
        for (int ks = 0; ks < 2; ++ks) { bw[ks] = *(const GAS bf16x8*)(w2T + (size_t)c768 * 64 + 32 * ks + kq); ba[ks] = *(const GAS bf16x8*)(a2T + (size_t)c768 * 64 + 32 * ks + kq); }
#pragma unroll
        for (int ks = 0; ks < 4; ++ks) bg[ks] = *(const GAS bf16x8*)(g2T + (size_t)c768 * 128 + 32 * ks + kq);
        v4u pre[4], prq[4];
#define M1_PREFETCH(t0_) do { _Pragma("unroll") for (int it = 0; it < 4; ++it) { const int q = tid2 + 256 * it; if (q < 16 * 56) { const int tok = q / 56, ch = q - tok * 56; const int col = m1_col(ch, h); \
            const size_t row = (size_t)n * T + (t0_) + tok; pre[it] = *(const GAS v4u*)(PR + row * PRW + col); prq[it] = (v4u){0u, 0u, 0u, 0u}; if ((t0_) + tok > 0) prq[it] = *(const GAS v4u*)(PR + (row - 1) * PRW + col); } } } while (0)
        M1_PREFETCH(c * CH);
        float S[4][8];
#pragma unroll
        for (int i = 0; i < 4; ++i)
#pragma unroll
            for (int j = 0; j < 8; ++j) S[i][j] = (wv < 2 && (32 * wv + 4 * rg + i) == (8 * kg + j)) ? 1.0f : 0.0f;
        __syncthreads();
        for (int sc = 0; sc < 4; ++sc) {
            const int t0 = c * CH + sc * 16;
#pragma unroll
            for (int it = 0; it < 4; ++it) { const int q = tid2 + 256 * it; if (q < 16 * 56) { const int tok = q / 56, ch = q - tok * 56;
                const v4u p8 = pre[it], q8 = prq[it];
                const f32x4 m0 = *(const LAS f32x4*)(MUl + ch * 8), m1 = *(const LAS f32x4*)(MUl + ch * 8 + 4);
                float xm[8];
                { const unsigned pw[4] = {p8.x, p8.y, p8.z, p8.w}, qw[4] = {q8.x, q8.y, q8.z, q8.w};
#pragma unroll
                  for (int e = 0; e < 4; ++e) { const float pl = bflo(pw[e]), ph = bfhi(pw[e]), ql = bflo(qw[e]), qh = bfhi(qw[e]);
                      const float ml = e < 2 ? m0[2 * e] : m1[2 * e - 4], mh = e < 2 ? m0[2 * e + 1] : m1[2 * e - 3];
                      xm[2 * e] = pl + (ql - pl) * ml; xm[2 * e + 1] = ph + (qh - ph) * mh; } }
                if (ch < 24) { LAS float* dst = VW + (ch < 8 ? 4096 : (ch < 16 ? KR_OFF : 5120)) + tok * 64 + 8 * (ch & 7);
                    *(LAS f32x4*)dst = (f32x4){xm[0], xm[1], xm[2], xm[3]}; *(LAS f32x4*)(dst + 4) = (f32x4){xm[4], xm[5], xm[6], xm[7]}; }
                else { const int jc = 8 * (ch - 24);
#pragma unroll
                    for (int e = 0; e < 8; ++e) { if (jc < 64) xm[e] = 1.0f - 2.0f / (1.0f + __expf(2.0f * xm[e])); else if (jc >= 128) xm[e] = sigmoidf_(xm[e]); }
                    v4u o; o.x = pk2(xm[0], xm[1]); o.y = pk2(xm[2], xm[3]); o.z = pk2(xm[4], xm[5]); o.w = pk2(xm[6], xm[7]);
                    *(LAS v4u*)(LOR + tok * LORS + jc) = o; }
            } }
            if (sc < 3) M1_PREFETCH(t0 + 16);
            __syncthreads();
            { f32x4 aw = (f32x4){0.f, 0.f, 0.f, 0.f}, aa = aw, ag = aw;
              const LAS bf16* arow = LOR + (lane & 15) * LORS + kq;
#pragma unroll
              for (int ks = 0; ks < 2; ++ks) { const bf16x8 a = *(const LAS bf16x8*)(arow + 32 * ks); aw = __builtin_amdgcn_mfma_f32_16x16x32_bf16(a, bw[ks], aw, 0, 0, 0); }
#pragma unroll
              for (int ks = 0; ks < 2; ++ks) { const bf16x8 a = *(const LAS bf16x8*)(arow + 64 + 32 * ks); aa = __builtin_amdgcn_mfma_f32_16x16x32_bf16(a, ba[ks], aa, 0, 0, 0); }
#pragma unroll
              for (int ks = 0; ks < 4; ++ks) { const bf16x8 a = *(const LAS bf16x8*)(arow + 128 + 32 * ks); ag = __builtin_amdgcn_mfma_f32_16x16x32_bf16(a, bg[ks], ag, 0, 0, 0); }
              const float w0c = CST[192 + ci], a0c = CST[256 + ci];
#pragma unroll
              for (int r = 0; r < 4; ++r) { const int tok = 4 * (lane >> 4) + r;
                  VW[tok * 64 + ci] = __expf(-0.60653065971f * sigmoidf_(w0c + aw[r]));
                  AS[tok * 64 + ci] = sigmoidf_(a0c + aa[r]);
                  GG[((size_t)nh * T + t0 + tok) * 64 + ci] = ag[r]; } }
            __syncthreads();
            { const int tok = tid2 >> 4, i4 = 4 * (tid2 & 15);
              const f32x4 kr = *(const LAS f32x4*)(KR + tok * 64 + i4), as = *(const LAS f32x4*)(AS + tok * 64 + i4), rr = *(const LAS f32x4*)(VR + tok * 64 + i4), vv = *(const LAS f32x4*)(VV + tok * 64 + i4);
              const f32x4 kkw = *(const LAS f32x4*)(CST + i4), kaw = *(const LAS f32x4*)(CST + 64 + i4), rkw = *(const LAS f32x4*)(CST + 128 + i4);
              f32x4 kk = kr * kkw; float sq = (kk[0] * kk[0] + kk[1] * kk[1]) + (kk[2] * kk[2] + kk[3] * kk[3]); sq = sum16(sq);
              kk = kk * (1.0f / fmaxf(sqrtf(sq), 1e-12f));
              const f32x4 km = kr * ((as - 1.0f) * kaw + 1.0f);
              float bs = (rr[0] * km[0] * rkw[0] + rr[1] * km[1] * rkw[1]) + (rr[2] * km[2] * rkw[2] + rr[3] * km[3] * rkw[3]); bs = sum16(bs);
              *(LAS f32x4*)(VA + tok * 64 + i4) = -kk; *(LAS f32x4*)(VBv + tok * 64 + i4) = kk * as; *(LAS f32x4*)(VK + tok * 64 + i4) = km;
              *(GAS f32x4*)(BON + ((size_t)nh * T + t0 + tok) * 64 + i4) = vv * bs; }
            __syncthreads();
            { float* yout = RT + (size_t)(wv >> 1) * ((WS_YZ - WS_RT) / 4) + ((size_t)nh * T + t0) * 64 + 32 * (wv & 1) + 4 * rg;
              const int vofs = 32 * (wv & 1) + 4 * rg;
              for (int st = 0; st < 16; ++st) {
                  const f32x4 a0v = *(const LAS f32x4*)(VA + st * 64 + 8 * kg), a1v = *(const LAS f32x4*)(VA + st * 64 + 8 * kg + 4);
                  float sa[4];
#pragma unroll
                  for (int i = 0; i < 4; ++i) { float s = S[i][0] * a0v[0]; s += S[i][1] * a0v[1]; s += S[i][2] * a0v[2]; s += S[i][3] * a0v[3]; s += S[i][4] * a1v[0]; s += S[i][5] * a1v[1]; s += S[i][6] * a1v[2]; s += S[i][7] * a1v[3]; sa[i] = sum8(s); }
                  const f32x4 w0v = *(const LAS f32x4*)(VW + st * 64 + 8 * kg), w1v = *(const LAS f32x4*)(VW + st * 64 + 8 * kg + 4);
                  const f32x4 b0v = *(const LAS f32x4*)(VBv + st * 64 + 8 * kg), b1v = *(const LAS f32x4*)(VBv + st * 64 + 8 * kg + 4);
                  const f32x4 k0v = *(const LAS f32x4*)(VK + st * 64 + 8 * kg), k1v = *(const LAS f32x4*)(VK + st * 64 + 8 * kg + 4);
                  f32x4 vv = (f32x4){0.f, 0.f, 0.f, 0.f}; if (wv >= 2) vv = *(const LAS f32x4*)(VV + st * 64 + vofs);
                  const f32x4 r0v = *(const LAS f32x4*)(VR + st * 64 + 8 * kg), r1v = *(const LAS f32x4*)(VR + st * 64 + 8 * kg + 4);
                  f32x4 y;
#pragma unroll
                  for (int i = 0; i < 4; ++i) { float yy = 0.f;
#pragma unroll
                      for (int j = 0; j < 8; ++j) { const float wj = j < 4 ? w0v[j] : w1v[j - 4], bj = j < 4 ? b0v[j] : b1v[j - 4], kj = j < 4 ? k0v[j] : k1v[j - 4], rj = j < 4 ? r0v[j] : r1v[j - 4];
                          const float sn = S[i][j] * wj + sa[i] * bj + vv[i] * kj; S[i][j] = sn; yy += sn * rj; }
                      y[i] = sum8(yy); }
                  if (kg == 0) *(GAS f32x4*)(yout + st * 64) = y;
              } }
            __syncthreads();
        }
#undef M1_PREFETCH
        { float* pc = PC + ((size_t)task * 2 + (wv >> 1)) * 4096 + (size_t)(32 * (wv & 1) + 4 * rg) * 64 + 8 * kg;
#pragma unroll
          for (int i = 0; i < 4; ++i) { *(GAS f32x4*)(pc + i * 64) = (f32x4){S[i][0], S[i][1], S[i][2], S[i][3]}; *(GAS f32x4*)(pc + i * 64 + 4) = (f32x4){S[i][4], S[i][5], S[i][6], S[i][7]}; } }
    }
}

__device__ __forceinline__ void m2_carry(Frame& F, int l) {
    RELAUNDER(F);
    const int nh = F.bid >> 2, qv = F.bid & 3, i = F.tid >> 5, x = F.tid & 31;
    LAS float* Sl = (LAS float*)F.lds;
    LAS float* Pl = (LAS float*)(F.lds + 8192);
    const float* PC = (const float*)(F.ws + WS_PC); float* SC = (float*)(F.ws + WS_SC);
    float zz = 0.f; asm volatile("" : "+v"(zz));
    f32x2 s = (f32x2){zz, zz};
    *(LAS f32x2*)(Sl + i * 64 + 2 * x) = s;
    int cur = 0;
    f32x4 p0, p1; f32x2 z;
    { const float* pc = PC + (size_t)(nh * NCH) * 2 * 4096; p0 = *(const GAS f32x4*)(pc + 8 * F.tid); p1 = *(const GAS f32x4*)(pc + 8 * F.tid + 4); z = *(const GAS f32x2*)(pc + 4096 + (16 * qv + i) * 64 + 2 * x); }
    for (int c = 0; c < NCH; ++c) {
        const int task = nh * NCH + c;
        *(GAS f32x2*)(SC + (size_t)task * 4096 + (16 * qv + i) * 64 + 2 * x) = s;
        *(LAS f32x4*)(Pl + 8 * F.tid) = p0; *(LAS f32x4*)(Pl + 8 * F.tid + 4) = p1;
        __syncthreads();
        f32x2 o = z;
        if (c + 1 < NCH) { const float* pc = PC + (size_t)(task + 1) * 2 * 4096; p0 = *(const GAS f32x4*)(pc + 8 * F.tid); p1 = *(const GAS f32x4*)(pc + 8 * F.tid + 4); z = *(const GAS f32x2*)(pc + 4096 + (16 * qv + i) * 64 + 2 * x); }
        const LAS float* sr = Sl + cur * 1024 + i * 64;
#pragma unroll 8
        for (int k = 0; k < 64; ++k) { const float sv = sr[k]; const f32x2 pp = *(const LAS f32x2*)(Pl + k * 64 + 2 * x); o[0] += sv * pp[0]; o[1] += sv * pp[1]; }
        s = o; cur ^= 1;
        *(LAS f32x2*)(Sl + cur * 1024 + i * 64 + 2 * x) = s;
        __syncthreads();
    }
    const int n = nh / RH, h = nh - n * RH;
    *(GAS f32x2*)(F.out + O_PWKV + ((((size_t)l * NB + n) * RH + h) * 64 + 16 * qv + i) * 64 + 2 * x) = s;
}
__device__ __forceinline__ int crow(int r, int hi) { return (r & 3) + 8 * (r >> 2) + 4 * hi; }
typedef __bf16 bf16x2_t __attribute__((ext_vector_type(2)));
__device__ __forceinline__ unsigned cvtpk_s(float lo, float hi) { f32x2 v = {lo, hi}; bf16x2_t b = __builtin_convertvector(v, bf16x2_t); return __builtin_bit_cast(unsigned, b); }
typedef short v4i16_t __attribute__((ext_vector_type(4)));
__device__ __forceinline__ s16x4 vtr(const LAS unsigned char* p) { return __builtin_bit_cast(s16x4, __builtin_amdgcn_ds_read_tr16_b64_v4i16((LAS v4i16_t*)p)); }
__device__ __forceinline__ void m2_attn_item(Frame& F, int it) {
    const int half = F.wave >> 2, wv = F.wave & 3, tid2 = F.tid & 255, lane = F.lane, l31 = lane & 31, hi = lane >> 5;
    const int unit = it * 2 + half, g = unit >> 9, rem = unit & 511, nh = rem >> 4, idx = rem & 15, n = nh >> 3, h = nh & 7;
    const int dil = g == 0 ? 1 : (g == 1 ? 4 : 16), r = g == 0 ? 0 : (g == 1 ? (idx >> 2) : idx), b = g == 0 ? idx : (g == 1 ? (idx & 3) : 0);
    LAS unsigned char* Vl = F.lds + half * 32768;
    const bf16* QN = (const bf16*)(F.ws + WS_QN); const bf16* KN = (const bf16*)(F.ws + WS_KN); const bf16* VB = (const bf16*)(F.ws + WS_VB);
    const size_t rowbase = (size_t)n * T + r;
    for (int q = tid2; q < 2048; q += 256) { const int key = q >> 3, ch = q & 7, sp = 128 * (b - 1) + key; v4u v = (v4u){0u, 0u, 0u, 0u};
        if (sp >= 0) v = *(const GAS v4u*)(VB + (rowbase + (size_t)dil * sp) * AW + h * 64 + 8 * ch);
        *(LAS v4u*)(Vl + key * 128 + ch * 16) = v; }
    const int sq = 128 * b + 32 * wv + l31;
    bf16x8 qf[4];
    { const bf16* qp = QN + (rowbase + (size_t)dil * sq) * AW + h * 64 + 8 * hi;
#pragma unroll
      for (int ks = 0; ks < 4; ++ks) qf[ks] = *(const GAS bf16x8*)(qp + 16 * ks); }
    const float slope = exp2f(-(float)(h + 1)) * (float)dil;
    f32x16 sc[5];
#pragma unroll
    for (int kt = 0; kt < 5; ++kt) {
        const int kl0 = 32 * wv + 32 * kt;
        int sp = 128 * (b - 1) + kl0 + l31; sp = sp < 0 ? 0 : sp;
        const bf16* kp = KN + (rowbase + (size_t)dil * sp) * AW + h * 64 + 8 * hi;
        f32x16 a;
#pragma unroll
        for (int e = 0; e < 16; ++e) a[e] = 0.f;
#pragma unroll
        for (int ks = 0; ks < 4; ++ks) { const bf16x8 kf = *(const GAS bf16x8*)(kp + 16 * ks); a = __builtin_amdgcn_mfma_f32_32x32x16_bf16(kf, qf[ks], a, 0, 0, 0); }
#pragma unroll
        for (int e = 0; e < 16; ++e) { const int kl = kl0 + crow(e, hi), delta = 128 + 32 * wv + l31 - kl; const bool ok = delta >= 0 && delta <= 128 && (128 * (b - 1) + kl) >= 0;
            a[e] = ok ? a[e] - slope * (float)delta : -INFINITY; }
        sc[kt] = a;
    }
    float m = -INFINITY;
#pragma unroll
    for (int kt = 0; kt < 5; ++kt)
#pragma unroll
        for (int e = 0; e < 16; ++e) m = fmaxf(m, sc[kt][e]);
    m = fmaxf(m, __shfl_xor(m, 32));
    float lsum = 0.f;
#pragma unroll
    for (int kt = 0; kt < 5; ++kt)
#pragma unroll
        for (int e = 0; e < 16; ++e) { const float p = __expf(sc[kt][e] - m); sc[kt][e] = p; lsum += p; }
    lsum += __shfl_xor(lsum, 32);
    __syncthreads();
    f32x16 o[2];
#pragma unroll
    for (int e = 0; e < 16; ++e) { o[0][e] = 0.f; o[1][e] = 0.f; }
    const int i16 = lane & 15, qq = i16 >> 2, pp = i16 & 3, blk = (lane >> 4) & 1;
#pragma unroll
    for (int kt = 0; kt < 5; ++kt) {
        const int kl0 = 32 * wv + 32 * kt;
#pragma unroll
        for (int s2 = 0; s2 < 2; ++s2) {
            v4u pw; pw.x = cvtpk_s(sc[kt][8 * s2], sc[kt][8 * s2 + 1]); pw.y = cvtpk_s(sc[kt][8 * s2 + 2], sc[kt][8 * s2 + 3]); pw.z = cvtpk_s(sc[kt][8 * s2 + 4], sc[kt][8 * s2 + 5]); pw.w = cvtpk_s(sc[kt][8 * s2 + 6], sc[kt][8 * s2 + 7]);
            const bf16x8 pf = __builtin_bit_cast(bf16x8, pw);
#pragma unroll
            for (int dt = 0; dt < 2; ++dt) {
                const LAS unsigned char* base = Vl + (kl0 + 16 * s2 + 4 * hi + qq) * 128 + (32 * dt + 16 * blk + 4 * pp) * 2;
                const s16x4 lo = vtr(base), hh = vtr(base + 8 * 128);
                const bf16x8 vf = (bf16x8){lo[0], lo[1], lo[2], lo[3], hh[0], hh[1], hh[2], hh[3]};
                o[dt] = __builtin_amdgcn_mfma_f32_32x32x16_bf16(vf, pf, o[dt], 0, 0, 0);
            }
        }
    }
    const float inv = 1.0f / lsum;
    float* og = (float*)(F.ws + WS_OG) + ((size_t)g * MP + rowbase + (size_t)dil * sq) * AW + h * 64;
#pragma unroll
    for (int dt = 0; dt < 2; ++dt)
#pragma unroll
        for (int rq = 0; rq < 4; ++rq) *(GAS f32x4*)(og + 32 * dt + 8 * rq + 4 * hi) = (f32x4){o[dt][4 * rq] * inv, o[dt][4 * rq + 1] * inv, o[dt][4 * rq + 2] * inv, o[dt][4 * rq + 3] * inv};
    if (hi == 0) ((float*)(F.ws + WS_LSE))[((size_t)g * MP + rowbase + (size_t)dil * sq) * AH + h] = m + __logf(lsum);
    __syncthreads();
}
__device__ __forceinline__ void ld8f(const bf16* p, float (&o)[8]) { const v4u v = *(const GAS v4u*)p; o[0] = bflo(v.x); o[1] = bfhi(v.x); o[2] = bflo(v.y); o[3] = bfhi(v.y); o[4] = bflo(v.z); o[5] = bfhi(v.z); o[6] = bflo(v.w); o[7] = bfhi(v.w); }
__device__ __forceinline__ void m2_conv_item(Frame& F, int l, int it) {
    if (F.tid >= 384) return;
    const int c8 = F.tid % 96, rs = F.tid / 96, c = 8 * c8;
    const bf16* PR = (const bf16*)(F.ws + WS_PR) + RP; bf16* MIX = (bf16*)(F.ws + WS_MIX);
    const float* cw = inp(F, 26) + (size_t)l * 3 * CW; const float* cb = inp(F, 27) + (size_t)l * CW;
    float w0[8], w1[8], w2[8], bb[8];
#pragma unroll
    for (int e = 0; e < 8; ++e) { w0[e] = cw[c + e]; w1[e] = cw[CW + c + e]; w2[e] = cw[2 * CW + c + e]; bb[e] = cb[c + e]; }
    const int row0 = it * 64 + rs * 16, t00 = row0 & (T - 1);
    float z1[8], z2[8];
#pragma unroll
    for (int e = 0; e < 8; ++e) { z1[e] = 0.f; z2[e] = 0.f; }
    if (t00 >= 1) { float u[8], gc[8]; ld8f(PR + (size_t)(row0 - 1) * PRW + (c), u); ld8f(PR + (size_t)(row0 - 1) * PRW + (2 * CW + c), gc);
#pragma unroll
        for (int e = 0; e < 8; ++e) z1[e] = gc[e] * u[e]; }
    if (t00 >= 2) { float u[8], gc[8]; ld8f(PR + (size_t)(row0 - 2) * PRW + (c), u); ld8f(PR + (size_t)(row0 - 2) * PRW + (2 * CW + c), gc);
#pragma unroll
        for (int e = 0; e < 8; ++e) z2[e] = gc[e] * u[e]; }
    for (int rr = 0; rr < 16; ++rr) { const size_t row = (size_t)row0 + rr; float u[8], gb[8], gc[8], y[8]; ld8f(PR + (size_t)(row) * PRW + (c), u); ld8f(PR + (size_t)(row) * PRW + (CW + c), gb); ld8f(PR + (size_t)(row) * PRW + (2 * CW + c), gc);
#pragma unroll
        for (int e = 0; e < 8; ++e) { const float z0 = gc[e] * u[e]; y[e] = gb[e] * (bb[e] + w0[e] * z2[e] + w1[e] * z1[e] + w2[e] * z0); z2[e] = z1[e]; z1[e] = z0; }
        v4u o; o.x = pk2(y[0], y[1]); o.y = pk2(y[2], y[3]); o.z = pk2(y[4], y[5]); o.w = pk2(y[6], y[7]);
        *(GAS v4u*)(MIX + row * D + AW + RW + c) = o;
        if ((row & (T - 1)) == T - 1) { float* oc = F.out + O_PCV + ((size_t)l * NB + (row >> 11)) * 2 * CW + c;
#pragma unroll
            for (int e = 0; e < 8; ++e) { oc[e] = z2[e]; oc[CW + e] = z1[e]; } }
    }
}
__device__ __forceinline__ void m2_sample_attn(Frame& F, int l, int n) {
    LAS float* P = (LAS float*)F.lds;
    LAS float* QS = P + 1536;
    LAS float* SCO = QS + 8 * 192;
    const u64* accp = sacc(F, l, SA_P) + (size_t)n * MIXP; const float rs = rstdbuf(F, 3 * l + 1)[n];
    for (int c = F.tid; c < 3 * AW; c += NTHREADS) P[c] = fx_dec(accp[dest_row<3>(c)]) * rs;
    __syncthreads();
    float* out = F.out; float* mixs = (float*)(F.ws + WS_MIXS) + ((size_t)l * NS + n) * D;
    const int h = F.wave, lane = F.lane;
    float q = P[h * 64 + lane], k = P[AW + h * 64 + lane], v = P[2 * AW + h * 64 + lane];
    q = q * (1.0f / sqrtf(wave_sum(q * q) * (1.0f / 64.f) + EPS)) * inp(F, 13)[l * 64 + lane];
    k = k * (1.0f / sqrtf(wave_sum(k * k) * (1.0f / 64.f) + EPS)) * inp(F, 14)[l * 64 + lane];
    out[O_SK + ((size_t)l * NS + n) * AW + h * 64 + lane] = k; out[O_SV + ((size_t)l * NS + n) * AW + h * 64 + lane] = v;
    LAS float* qs = QS + h * 192; qs[lane] = q; qs[64 + lane] = k; qs[128 + lane] = v;
    LDS_WAIT(); asm volatile("" ::: "memory");
    const float slope = exp2f(-(float)(h + 1));
    const float* ck = inp(F, 2) + ((size_t)(l * NS + n) * 2048) * AW + h * 64; const float* cv = inp(F, 3) + ((size_t)(l * NS + n) * 2048) * AW + h * 64;
    LAS float* sc = SCO + h * 396;
    float mx = -INFINITY;
#pragma unroll 1
    for (int g = 0; g < 3; ++g) { const int dil = g == 0 ? 1 : (g == 1 ? 4 : 16);
        const int j0 = lane == 0 ? 64 : lane, j1 = lane == 0 ? 128 : lane + 64;
        const float* k0p = ck + (size_t)(2048 - dil * j0) * AW; const float* k1p = ck + (size_t)(2048 - dil * j1) * AW;
        float s0 = 0.f, s1 = 0.f;
#pragma unroll
        for (int d = 0; d < 64; d += 4) { const f32x4 a = *(const GAS f32x4*)(k0p + d), b = *(const GAS f32x4*)(k1p + d); const f32x4 qq = *(const LAS f32x4*)(qs + d);
            s0 += qq[0] * a[0] + qq[1] * a[1] + qq[2] * a[2] + qq[3] * a[3]; s1 += qq[0] * b[0] + qq[1] * b[1] + qq[2] * b[2] + qq[3] * b[3]; }
        s0 = s0 * 0.125f - slope * (float)(dil * j0); s1 = s1 * 0.125f - slope * (float)(dil * j1);
        sc[g * 132 + j0] = s0; sc[g * 132 + j1] = s1; mx = fmaxf(mx, fmaxf(s0, s1));
        if (lane == 0) { float s = 0.f;
#pragma unroll
            for (int d = 0; d < 64; ++d) s += qs[d] * qs[64 + d];
            s *= 0.125f; sc[g * 132] = s; mx = fmaxf(mx, s); }
    }
#pragma unroll
    for (int o = 1; o < 64; o <<= 1) mx = fmaxf(mx, __shfl_xor(mx, o));
    float ls = 0.f;
    for (int g = 0; g < 3; ++g) for (int j = lane; j <= 128; j += 64) { const float pe = __expf(sc[g * 132 + j] - mx); sc[g * 132 + j] = pe; ls += pe; }
    ls = wave_sum(ls);
    LDS_WAIT(); asm volatile("" ::: "memory");
    const int kq = lane >> 4, d4 = 4 * (lane & 15);
    f32x4 acc = (f32x4){0.f, 0.f, 0.f, 0.f};
#pragma unroll 1
    for (int g = 0; g < 3; ++g) { const int dil = g == 0 ? 1 : (g == 1 ? 4 : 16);
        if (kq == 0) acc = acc + *(const LAS f32x4*)(qs + 128 + d4) * sc[g * 132];
#pragma unroll 8
        for (int j = 4 - kq; j <= 128; j += 4) acc = acc + *(const GAS f32x4*)(cv + (size_t)(2048 - dil * j) * AW + d4) * sc[g * 132 + j];
    }
#pragma unroll
    for (int e = 0; e < 4; ++e) { acc[e] += __shfl_xor(acc[e], 16); acc[e] += __shfl_xor(acc[e], 32); }
    if (lane < 16) *(GAS f32x4*)(mixs + h * 64 + d4) = acc * (1.0f / ls);
    __syncthreads();
}
__device__ __forceinline__ void m2_sample_rwkv(Frame& F, int l, int n) {
    LAS float* P = (LAS float*)F.lds;
    LAS float* XM = P + PRW;
    LAS float* LIN = XM + RP;
    LAS float* VEC = LIN + 256;
    const u64* accp = sacc(F, l, SA_P) + (size_t)n * MIXP; const float rs = rstdbuf(F, 3 * l + 1)[n];
    for (int c = F.tid; c < PRW; c += NTHREADS) P[c] = fx_dec(accp[3 * AW + c]) * rs;
    __syncthreads();
    float* out = F.out; float* mixs = (float*)(F.ws + WS_MIXS) + ((size_t)l * NS + n) * D;
    { const float* sh = inp(F, 5) + ((size_t)l * NS + n) * RP; const float* mu = inp(F, 15) + (size_t)l * RP;
      for (int c = F.tid; c < RP; c += NTHREADS) { const float pv = P[c]; const float x = pv + (sh[c] - pv) * mu[c]; XM[c] = x; out[O_SSH + ((size_t)l * NS + n) * RP + c] = pv;
          if (c >= 3 * RW) { const int j = c - 3 * RW; LIN[j] = j < 64 ? 1.0f - 2.0f / (1.0f + __expf(2.0f * x)) : (j < 128 ? x : sigmoidf_(x)); } } }
    __syncthreads();
    const unsigned char* wl = wlayer(F, l);
    const bf16* w2T = (const bf16*)(wl + WL_W2T); const bf16* a2T = (const bf16*)(wl + WL_A2T); const bf16* g2T = (const bf16*)(wl + WL_G2T);
#pragma unroll 1
    for (int h = F.wave; h < RH; h += NWAVES) { RELAUNDER(F); const int lane = F.lane, c = h * 64 + lane;
        v4u ww[8], wa[8], wg[16];
#pragma unroll
        for (int i = 0; i < 8; ++i) { ww[i] = *(const GAS v4u*)(w2T + (size_t)c * 64 + 8 * i); wa[i] = *(const GAS v4u*)(a2T + (size_t)c * 64 + 8 * i); }
#pragma unroll
        for (int i = 0; i < 16; ++i) wg[i] = *(const GAS v4u*)(g2T + (size_t)c * 128 + 8 * i);
        const float* s0 = inp(F, 4) + ((((size_t)l * NS + n) * RH + h) * 64 + lane) * 64;
        f32x4 st[16];
#pragma unroll
        for (int i = 0; i < 16; ++i) st[i] = *(const GAS f32x4*)(s0 + 4 * i);
        float sw = inp(F, 16)[(size_t)l * RW + c], sa = inp(F, 18)[(size_t)l * RW + c], sg = 0.f;
#pragma unroll
        for (int i = 0; i < 8; ++i) { const unsigned w4[4] = {ww[i].x, ww[i].y, ww[i].z, ww[i].w}, a4[4] = {wa[i].x, wa[i].y, wa[i].z, wa[i].w};
#pragma unroll
            for (int e = 0; e < 4; ++e) { sw += LIN[8 * i + 2 * e] * bflo(w4[e]) + LIN[8 * i + 2 * e + 1] * bfhi(w4[e]); sa += LIN[64 + 8 * i + 2 * e] * bflo(a4[e]) + LIN[64 + 8 * i + 2 * e + 1] * bfhi(a4[e]); } }
#pragma unroll
        for (int i = 0; i < 16; ++i) { const unsigned g4[4] = {wg[i].x, wg[i].y, wg[i].z, wg[i].w};
#pragma unroll
            for (int e = 0; e < 4; ++e) sg += LIN[128 + 8 * i + 2 * e] * bflo(g4[e]) + LIN[128 + 8 * i + 2 * e + 1] * bfhi(g4[e]); }
        const float dec = __expf(-0.60653065971f * sigmoidf_(sw)), a = sigmoidf_(sa);
        const float rr = XM[c], kr = XM[RW + c], vr = XM[2 * RW + c];
        float kk = kr * inp(F, 21)[(size_t)l * RW + c]; kk = kk / fmaxf(sqrtf(wave_sum(kk * kk)), 1e-12f);
        const float km = kr * (1.0f + (a - 1.0f) * inp(F, 22)[(size_t)l * RW + c]);
        const float bon = wave_sum(rr * km * inp(F, 23)[(size_t)l * RW + c]);
        LAS float* ve = VEC + h * 320; ve[lane] = -kk; ve[64 + lane] = kk * a; ve[128 + lane] = km; ve[192 + lane] = rr; ve[256 + lane] = dec;
        LDS_WAIT(); asm volatile("" ::: "memory");
        float* so = out + O_SWKV + ((((size_t)l * NS + n) * RH + h) * 64 + lane) * 64;
        float sdot = 0.f;
#pragma unroll
        for (int i = 0; i < 16; ++i) { const f32x4 a4 = *(const LAS f32x4*)(ve + 4 * i); sdot += st[i][0] * a4[0] + st[i][1] * a4[1] + st[i][2] * a4[2] + st[i][3] * a4[3]; }
        float y = 0.f;
#pragma unroll
        for (int i = 0; i < 16; ++i) { const f32x4 b4 = *(const LAS f32x4*)(ve + 64 + 4 * i), k4 = *(const LAS f32x4*)(ve + 128 + 4 * i), r4 = *(const LAS f32x4*)(ve + 192 + 4 * i), w4 = *(const LAS f32x4*)(ve + 256 + 4 * i);
            const f32x4 sn = st[i] * w4 + b4 * sdot + k4 * vr; y += sn[0] * r4[0] + sn[1] * r4[1] + sn[2] * r4[2] + sn[3] * r4[3];
            *(GAS f32x4*)(so + 4 * i) = sn; }
        const float mean = wave_sum(y) * (1.0f / 64.f), dl = y - mean, var = wave_sum(dl * dl) * (1.0f / 64.f);
        const float yn = dl * (1.0f / sqrtf(var + GN_EPS)) * inp(F, 24)[(size_t)l * RW + c] + inp(F, 25)[(size_t)l * RW + c];
        mixs[AW + c] = (yn + bon * vr) * sg;
    }
    RELAUNDER(F);
    { const float* scv = inp(F, 6) + ((size_t)l * NS + n) * 2 * CW; const float* cw = inp(F, 26) + (size_t)l * 3 * CW; const float* cb = inp(F, 27) + (size_t)l * CW;
      for (int c = F.tid; c < CW; c += NTHREADS) { const float u = P[RP + c], gb = P[RP + CW + c], gc = P[RP + 2 * CW + c], z0 = gc * u, z2 = scv[c], z1 = scv[CW + c];
          mixs[AW + RW + c] = gb * (cb[c] + cw[c] * z2 + cw[CW + c] * z1 + cw[2 * CW + c] * z0);
          float* oc = out + O_SCV + ((size_t)l * NS + n) * 2 * CW; oc[c] = z1; oc[CW + c] = z0; } }
    __syncthreads();
}
__device__ __forceinline__ void m2_phase(Frame& F, int l) {
    if (F.bid < 192) m2_carry(F, l);
    constexpr int N_SMP = 2 * NS, N_ATT = 768, N_CONV = MP / 64, N_ITEMS = N_SMP + N_ATT + N_CONV;
    for (;;) {
        __syncthreads();
        if (F.tid == 0) F.MISC[16] = __hip_atomic_fetch_add((unsigned*)(F.ctl + CW_QUEUE + 64 * l), 1u, RLX_AGENT);
        __syncthreads();
        const int it = (int)F.MISC[16];
        if (it >= N_ITEMS) break;
        RELAUNDER(F);
        if (it < N_SMP) { if (it & 1) m2_sample_rwkv(F, l, it >> 1); else m2_sample_attn(F, l, it >> 1); }
        else if (it < N_SMP + N_ATT) m2_attn_item(F, it - N_SMP);
        else m2_conv_item(F, l, it - N_SMP - N_ATT);
    }
}

__device__ __forceinline__ void m3_phase(Frame& F, int l) {
    const int lane = F.lane;
    bf16* MIX = (bf16*)(F.ws + WS_MIX);
    LAS float* RTl = (LAS float*)(F.lds + F.wave * 16384);
    const float* RT = (const float*)(F.ws + WS_RT); const float* YZ = (const float*)(F.ws + WS_YZ); const float* GG = (const float*)(F.ws + WS_GG); const float* BON = (const float*)(F.ws + WS_BON); const float* SC = (const float*)(F.ws + WS_SC);
    for (int task = F.bid * NWAVES + F.wave; task < NTASK; task += F.G * NWAVES) {
        RELAUNDER(F);
        const int nh = task / NCH, c = task - nh * NCH, n = nh / RH, h = nh - n * RH;
        const size_t tb = ((size_t)nh * T + c * CH) * 64;
        float sr[64];
        if (c > 0) {
#pragma unroll
            for (int k = 0; k < 64; k += 4) { const f32x4 s4 = *(const GAS f32x4*)(SC + (size_t)task * 4096 + lane * 64 + k); sr[k] = s4[0]; sr[k + 1] = s4[1]; sr[k + 2] = s4[2]; sr[k + 3] = s4[3]; }
#pragma unroll
            for (int i = 0; i < 16; ++i) *(LAS f32x4*)(RTl + (i * 64 + lane) * 4) = *(const GAS f32x4*)(RT + tb + (size_t)(i * 64 + lane) * 4);
            LDS_WAIT(); asm volatile("" ::: "memory");
        } else {
#pragma unroll
            for (int k = 0; k < 64; ++k) sr[k] = 0.f;
        }
        const float lw = inp(F, 24)[(size_t)l * RW + h * 64 + lane], lb = inp(F, 25)[(size_t)l * RW + h * 64 + lane];
        for (int t8 = 0; t8 < CH; t8 += 8) {
            float yv[8], bv[8], gv[8];
#pragma unroll
            for (int u = 0; u < 8; ++u) { yv[u] = YZ[tb + (t8 + u) * 64 + lane]; bv[u] = BON[tb + (t8 + u) * 64 + lane]; gv[u] = GG[tb + (t8 + u) * 64 + lane]; }
#pragma unroll
            for (int u = 0; u < 8; ++u) { const int t = t8 + u; float y = yv[u];
                if (c > 0) {
#pragma unroll
                    for (int k = 0; k < 64; k += 4) { const f32x4 r4 = *(const LAS f32x4*)(RTl + t * 64 + k); y += sr[k] * r4[0] + sr[k + 1] * r4[1] + sr[k + 2] * r4[2] + sr[k + 3] * r4[3]; } }
                const float mean = wave_sum(y) * (1.0f / 64.f), dl = y - mean, var = wave_sum(dl * dl) * (1.0f / 64.f);
                const float yn = dl * __builtin_amdgcn_rsqf(var + GN_EPS) * lw + lb;
                const float o = (yn + bv[u]) * gv[u];
                MIX[((size_t)n * T + c * CH + t) * D + AW + h * 64 + lane] = (bf16)f2bf(o); }
        }
        LDS_WAIT(); asm volatile("" ::: "memory");
    }
    const float* OG = (const float*)(F.ws + WS_OG); const float* LSE = (const float*)(F.ws + WS_LSE);
    for (int q = F.bid * NTHREADS + F.tid; q < MP * 64; q += F.G * NTHREADS) { const int row = q >> 6, c8 = (q & 63) * 8, h = c8 >> 6;
        const float l0 = LSE[(size_t)row * AH + h], l1 = LSE[((size_t)MP + row) * AH + h], l2 = LSE[((size_t)2 * MP + row) * AH + h];
        const float mx = fmaxf(l0, fmaxf(l1, l2)), e0 = __expf(l0 - mx), e1 = __expf(l1 - mx), e2 = __expf(l2 - mx), inv = 1.0f / (e0 + e1 + e2);
        f32x4 a = (f32x4){0.f, 0.f, 0.f, 0.f}, b = a;
        { const float* p = OG + (size_t)row * AW + c8; a = a + *(const GAS f32x4*)p * (e0 * inv); b = b + *(const GAS f32x4*)(p + 4) * (e0 * inv); }
        { const float* p = OG + ((size_t)MP + row) * AW + c8; a = a + *(const GAS f32x4*)p * (e1 * inv); b = b + *(const GAS f32x4*)(p + 4) * (e1 * inv); }
        { const float* p = OG + ((size_t)2 * MP + row) * AW + c8; a = a + *(const GAS f32x4*)p * (e2 * inv); b = b + *(const GAS f32x4*)(p + 4) * (e2 * inv); }
        v4u o; o.x = pk2(a[0], a[1]); o.y = pk2(a[2], a[3]); o.z = pk2(b[0], b[1]); o.w = pk2(b[2], b[3]);
        *(GAS v4u*)(MIX + (size_t)row * D + c8) = o; }
}
__device__ __forceinline__ void final_phase(Frame& F) {
    const float* xp = xsbuf(F, 3 * (L - 1) + 2); const u64* ac = sacc(F, L - 1, SA_D2);
    for (int i = F.bid * NTHREADS + F.tid; i < NS * D; i += F.G * NTHREADS) F.out[O_YS + i] = xp[i] + 0.5f * fx_dec(ac[i]);
}
}
namespace fk {
struct Args { const float* in[33]; float* out; unsigned char* ws; int ph_lo, ph_hi, flags, pad; };
constexpr int N_PHASES = 1 + 8 * 2 + L * 5 + 1;
__global__ void __launch_bounds__(NTHREADS, 2) mega(Args args) {
    extern __shared__ __attribute__((aligned(16))) unsigned char lds[];
    Frame F;
    F.lds = (LAS unsigned char*)lds;
    F.MISC = (volatile LAS unsigned*)(F.lds + MISC_OFF);
    F.tid = threadIdx.x; F.lane = F.tid & 63; F.wave = __builtin_amdgcn_readfirstlane(F.tid >> 6);
    F.G = gridDim.x; F.bid = blockIdx.x;
    F.ws = args.ws; F.out = args.out; F.ctl = (gu32*)(args.ws + WS_CTL);
    F.ptab = (const LAS unsigned*)(F.lds + PTAB_OFF);
    if (F.tid < 64) F.MISC[F.tid] = 0u;
    if (F.tid < 33) { const unsigned long long pv = (unsigned long long)args.in[F.tid]; ((LAS unsigned*)(F.lds + PTAB_OFF))[2 * F.tid] = (unsigned)pv; ((LAS unsigned*)(F.lds + PTAB_OFF))[2 * F.tid + 1] = (unsigned)(pv >> 32); }
    __syncthreads();
    const int lo = args.ph_lo, hi = args.ph_hi; const bool rerun = (args.flags & 1) != 0;
    const bool one_launch = (hi - lo) > 1;
    XcdBarrier bar; bar.bar = (unsigned*)(F.ctl + CW_BAR); bar.x = 0; bar.st = nullptr;
    if (one_launch) bar = xcd_barrier_post((unsigned*)(F.ctl + CW_BAR), F.MISC + 8);
    int ph = 0;
#define PHASE_BEGIN if (ph >= lo && ph < hi) { { int t_ = threadIdx.x; asm volatile("" : "+v"(t_)); F.tid = t_; F.lane = t_ & 63; F.wave = __builtin_amdgcn_readfirstlane(t_ >> 6); int b_ = blockIdx.x; asm volatile("" : "+s"(b_)); F.bid = b_; }
#define PHASE_END   if (ph + 1 < hi) xcd_barrier(bar); } ++ph;
    bf16* XB = (bf16*)(F.ws + WS_XB); bf16* HB = (bf16*)(F.ws + WS_H); bf16* MIX = (bf16*)(F.ws + WS_MIX);
    float* X = F.out + O_Y;

    PHASE_BEGIN p0_prologue(F); PHASE_END

    for (int s = 0; s < 2 * L; ++s) {
        const int l = s >> 1, second = s & 1;
        unsigned char* wl = wlayer(F, l);
        PHASE_BEGIN
            const int j = 3 * l + (second ? 2 : 0);
            const float* xprev = j == 0 ? inp(F, 1) : (j == 1 ? inp(F, 1) : xsbuf(F, j - 1));
            const u64* accprev = j == 0 ? nullptr : (second ? sacc(F, l, SA_O) : sacc(F, l - 1, SA_D2));
            if (!rerun) sample_proj(F, j, xprev, accprev, second ? 1.0f : 0.5f, (const bf16*)(wl + (second ? WL_GU2 : WL_GU1)), NGU, sacc(F, l, second ? SA_GU2 : SA_GU1));
            pg8::Gemm g{XB, (const bf16*)(wl + (second ? WL_GU2 : WL_GU1)), MP, NGU, D}; pg8::StaticOrder S; S.init(MP, NGU, F.G, F.bid);
            pg8::EpiSwiglu E{HB, ssarr(F, j), FF};
            pg8::gemm_phase<pg8::EpiSwiglu, pg8::StaticOrder, true, true>(F.lds, g, S, E, F.tid);
        PHASE_END
        PHASE_BEGIN
            const int j = 3 * l + (second ? 2 : 0);
            if (!rerun) sample_down(F, sacc(F, l, second ? SA_GU2 : SA_GU1), rstdbuf(F, j), (const bf16*)(wl + (second ? WL_D2 : WL_D1)), sacc(F, l, second ? SA_D2 : SA_D1));
            pg8::Gemm g{HB, (const bf16*)(wl + (second ? WL_D2 : WL_D1)), MP, D, FF}; pg8::StaticOrder S; S.init(MP, D, F.G, F.bid);
            u64* ssn = second ? (l + 1 < L ? ssarr(F, 3 * (l + 1)) : nullptr) : ssarr(F, 3 * l + 1);
            pg8::EpiResid E{X, XB, rerun ? nullptr : ssn, rerun ? 0.0f : 0.5f};
            pg8::gemm_phase<pg8::EpiResid, pg8::StaticOrder, true, true>(F.lds, g, S, E, F.tid);
        PHASE_END
        if (!second) {
            PHASE_BEGIN
                const int j = 3 * l + 1;
                if (!rerun) sample_proj(F, j, l == 0 ? inp(F, 1) : xsbuf(F, j - 1), sacc(F, l, SA_D1), 0.5f, (const bf16*)(wl + WL_IN), MIXP, sacc(F, l, SA_P));
                pg8::Gemm g{XB, (const bf16*)(wl + WL_IN), MP, MIXP, D}; pg8::StaticOrder S; S.init(MP, MIXP, F.G, F.bid);
                static_assert(WS_KN - WS_QN == WS_VB - WS_KN, "QN | KN | VB equally spaced");
                pg8::EpiWin E{ssarr(F, j), (bf16*)(F.ws + WS_QN), (bf16*)(F.ws + WS_PR), F.out + O_PK + (size_t)l * MP * AW, F.out + O_PSH + (size_t)l * NB * RP,
                              inp(F, 13) + l * 64, inp(F, 14) + l * 64, (WS_KN - WS_QN) / 2, O_PV - O_PK};
                pg8::gemm_phase<pg8::EpiWin, pg8::StaticOrder, true, true>(F.lds, g, S, E, F.tid);
            PHASE_END
            PHASE_BEGIN m1_phase(F, l); PHASE_END
            PHASE_BEGIN m2_phase(F, l); PHASE_END
            PHASE_BEGIN m3_phase(F, l); PHASE_END
            PHASE_BEGIN
                if (!rerun) sample_wout(F, (const float*)(F.ws + WS_MIXS) + (size_t)l * NS * D, (const bf16*)(wl + WL_OUT), sacc(F, l, SA_O));
                pg8::Gemm g{MIX, (const bf16*)(wl + WL_OUT), MP, D, D}; pg8::StaticOrder S; S.init(MP, D, F.G, F.bid);
                pg8::EpiResid E{X, XB, rerun ? nullptr : ssarr(F, 3 * l + 2), rerun ? 0.0f : 1.0f};
                pg8::gemm_phase<pg8::EpiResid, pg8::StaticOrder, true, true>(F.lds, g, S, E, F.tid);
            PHASE_END
        }
    }
    PHASE_BEGIN final_phase(F); PHASE_END
#undef PHASE_BEGIN
#undef PHASE_END
}

static int g_grid = 0;
static bool fast_setup() {
    if (g_grid != 0) return g_grid > 0;
    int dev = 0, cus = 0, per_cu = 0;
    if (hipGetDevice(&dev) != hipSuccess || hipDeviceGetAttribute(&cus, hipDeviceAttributeMultiprocessorCount, dev) != hipSuccess) { fprintf(stderr, "fast_setup: device query failed\n"); g_grid = -1; return false; }
    if (hipFuncSetAttribute((const void*)mega, hipFuncAttributeMaxDynamicSharedMemorySize, LDS_BYTES) != hipSuccess) { fprintf(stderr, "fast_setup: hipFuncSetAttribute failed\n"); g_grid = -1; return false; }
    if (hipOccupancyMaxActiveBlocksPerMultiprocessor(&per_cu, (const void*)mega, NTHREADS, LDS_BYTES) != hipSuccess || per_cu < 1) fprintf(stderr, "fast_setup: occupancy query reports %d blocks per CU\n", per_cu);
    (void)hipGetLastError();
    g_grid = cus;
    fprintf(stderr, "fast_setup: grid %d, occupancy %d\n", g_grid, per_cu);
    return true;
}
static void launch_range(void* const* d_in, float* out, void* d_ws, int lo, int hi, hipStream_t stream, int flags = 0) {
    Args a; memset(&a, 0, sizeof(a));
    for (int i = 0; i < 33; ++i) a.in[i] = (const float*)d_in[i];
    a.out = out; a.ws = (unsigned char*)d_ws; a.ph_lo = lo; a.ph_hi = hi; a.flags = flags;
    hipLaunchKernelGGL(mega, dim3(g_grid), dim3(NTHREADS), LDS_BYTES, stream, a);
    const hipError_t le = hipPeekAtLastError();
    if (le != hipSuccess) fprintf(stderr, "launch_range [%d,%d) failed: %s\n", lo, hi, hipGetErrorName(le));
}
}
#ifndef KMODE
#define KMODE 1
#endif
#ifndef PROBE_ONE_LAUNCH
#define PROBE_ONE_LAUNCH 0
#endif
extern "C" void kernel_launch(void* const* d_in, const int* in_sizes, int n_in, void* d_out, int out_size, void* d_ws, size_t ws_size, hipStream_t stream) {
    constexpr size_t MiB = 1u << 20;
    if (n_in != 33 || out_size != (int)fk::O_END || ws_size < fk::WS_FAST_END) { fprintf(stderr, "kernel_launch: unexpected sizes n_in %d out %d ws %zu\n", n_in, out_size, ws_size); return; }
    if (!fk::fast_setup()) return;
#if KMODE == 2
    constexpr size_t OFF_OUT2 = 1137 * MiB, OFF_SNAP = 1340 * MiB, OFF_FMIX = 1405 * MiB, OFF_END = 1440 * MiB;
    static_assert(OFF_OUT2 >= fk::WS_FAST_END && OFF_OUT2 + fk::O_END * 4 <= OFF_SNAP && OFF_SNAP + (size_t)nv::R * 2048 * 4 <= OFF_FMIX && OFF_FMIX + (size_t)8192 * 2048 * 2 <= OFF_END, "probe map");
    if (ws_size < OFF_END) { fprintf(stderr, "kernel_launch: PROBE needs %zu bytes of workspace, got %zu\n", (size_t)OFF_END, ws_size); return; }
    float* out2 = (float*)((char*)d_ws + OFF_OUT2); float* snap = (float*)((char*)d_ws + OFF_SNAP); unsigned short* fmix = (unsigned short*)((char*)d_ws + OFF_FMIX);
    nv::forward(d_in, (float*)d_out, (float*)d_ws, stream, snap);
    float* fout = out2;
#else
    float* fout = (float*)d_out;
#endif
    hipMemsetAsync((char*)d_ws + fk::WS_CTL, 0, fk::CTL_ZERO_BYTES, stream);
#ifndef REP_CLASS
#define REP_CLASS 0
#endif
#ifndef REP_COUNT
#define REP_COUNT 1
#endif
#if KMODE == 0 || (KMODE == 2 && PROBE_ONE_LAUNCH)
    fk::launch_range(d_in, fout, d_ws, 0, fk::N_PHASES, stream);
#if KMODE == 2
#endif
#else
    for (int p = 0; p < fk::N_PHASES; ++p) {
        fk::launch_range(d_in, fout, d_ws, p, p + 1, stream);
#if KMODE == 3
        {
            int cls = -1, layer = 0;
            if (p == 0) cls = 0; else if (p < fk::N_PHASES - 1) { const int q = (p - 1) % 9; layer = (p - 1) / 9; cls = q == 0 ? 1 : q == 1 ? 2 : q == 2 ? 3 : q == 3 ? 4 : q == 4 ? 5 : q == 5 ? 6 : q == 6 ? 7 : q == 7 ? 1 : 2; }
            if (cls == REP_CLASS) { for (int r = 0; r < REP_COUNT; ++r) {
                if (cls == 5) hipMemsetAsync((char*)d_ws + fk::WS_CTL + (fk::CW_QUEUE + 64 * layer) * 4, 0, 4, stream);
                fk::launch_range(d_in, fout, d_ws, p, p + 1, stream, 1); } }
        }
#endif
#if KMODE == 2
        if (p == 1 + 2 + 4 - 1) hipMemcpyAsync(fmix, (char*)d_ws + fk::WS_MIX, (size_t)8192 * 2048 * 2, hipMemcpyDeviceToDevice, stream);
#endif
    }
#endif
#if KMODE == 2
    {   float* slots = (float*)((char*)d_ws + fk::WS_CTL) + 12288;
        const float* o = (const float*)d_out; int s = 0;
        auto cmpo = [&](size_t off, size_t n) { pb::cmp(false, out2 + off, n, o + off, n, 1, (int)n, slots, s++, stream); };
        for (int l = 0; l < 4; ++l) {
            cmpo(fk::O_PK + (size_t)l * 8192 * 512, (size_t)8192 * 512); cmpo(fk::O_PV + (size_t)l * 8192 * 512, (size_t)8192 * 512);
            cmpo(fk::O_SK + (size_t)l * 8 * 512, 8 * 512); cmpo(fk::O_SV + (size_t)l * 8 * 512, 8 * 512);
            cmpo(fk::O_PSH + (size_t)l * 4 * 2560, 4 * 2560); cmpo(fk::O_SSH + (size_t)l * 8 * 2560, 8 * 2560);
            cmpo(fk::O_PCV + (size_t)l * 4 * 1536, 4 * 1536); cmpo(fk::O_SCV + (size_t)l * 8 * 1536, 8 * 1536);
            cmpo(fk::O_PWKV + (size_t)l * 4 * 12 * 4096, (size_t)4 * 12 * 4096); cmpo(fk::O_SWKV + (size_t)l * 8 * 12 * 4096, (size_t)8 * 12 * 4096);
            if (l == 0) {
#if !PROBE_ONE_LAUNCH
                pb::cmp(true, fmix, 2048, snap, 2048, 8192, 512, slots, s++, stream);
                pb::cmp(true, fmix + 512, 2048, snap + 512, 2048, 8192, 768, slots, s++, stream);
                pb::cmp(true, fmix + 1280, 2048, snap + 1280, 2048, 8192, 768, slots, s++, stream);
#else
                s += 3;
#endif
                pb::cmp(false, (const float*)((char*)d_ws + fk::WS_MIXS), 2048, snap + (size_t)8192 * 2048, 2048, 8, 2048, slots, s++, stream);
            }
        }
        cmpo(fk::O_Y, (size_t)8192 * 2048); cmpo(fk::O_YS, 8 * 2048);
        pb::k_encode<<<1, 256, 0, stream>>>(slots, s, (float*)d_out + fk::O_YS, 8 * 2048, 1e-3f);
    }
#endif
}
```

```cpp
#include <hip/hip_runtime.h>
#include <hip/hip_bf16.h>
#include <cstdio>
#include <cstdint>
#include <cmath>
#include <cstring>
#define KMODE 0
#define PROBE_ONE_LAUNCH 0
#define REP_CLASS 0
#define REP_COUNT 1
#define REP_FLAGS 1
namespace fk {
#define GAS __attribute__((address_space(1)))
#define LAS __attribute__((address_space(3)))
typedef unsigned short bf16;
typedef unsigned v4u __attribute__((ext_vector_type(4)));
typedef unsigned v2u __attribute__((ext_vector_type(2)));
typedef float f32x4 __attribute__((ext_vector_type(4)));
typedef float f32x2 __attribute__((ext_vector_type(2)));
typedef float f32x16 __attribute__((ext_vector_type(16)));
typedef short bf16x8 __attribute__((ext_vector_type(8)));
typedef short s16x4 __attribute__((ext_vector_type(4)));
typedef GAS unsigned gu32;

constexpr int D = 2048, NB = 4, T = 2048, MP = NB * T, NS = 8, L = 4;
constexpr int AW = 512, AH = 8, RW = 768, RH = 12, CW = 768, RP = 2560, MIXP = 6400, FF = 5632, PRW = RP + 3 * CW  ;
constexpr int NGU = 2 * FF;
constexpr float EPS = 1e-6f, GN_EPS = 64e-5f;
constexpr int NWAVES = 8, NTHREADS = 512;
constexpr int NCH = 32, CH = 64;
constexpr int NTASK = NB * RH * NCH;

constexpr size_t O_Y = 0, O_YS = 16777216, O_PK = 16793600, O_PV = 33570816, O_PWKV = 50348032, O_PSH = 51134464, O_PCV = 51175424,
                 O_SK = 51200000, O_SV = 51216384, O_SWKV = 51232768, O_SSH = 52805632, O_SCV = 52887552, O_END = 52936704;

constexpr size_t alignup(size_t x) { return (x + 4095) & ~(size_t)4095; }
constexpr int CW_TMO = 0;
constexpr int CW_BAR = 4096;
constexpr int CW_QUEUE = 8192;
constexpr size_t CTL_U32 = 16384;
constexpr size_t WS_CTL = 0;
constexpr size_t WS_SS = WS_CTL + CTL_U32 * 4;
constexpr size_t WS_SACC = WS_SS + (size_t)12 * MP * 8;
constexpr int SA_GU1 = 0, SA_D1 = 8 * NGU, SA_P = SA_D1 + 8 * D, SA_O = SA_P + 8 * MIXP, SA_GU2 = SA_O + 8 * D, SA_D2 = SA_GU2 + 8 * NGU, SA_LAYER = SA_D2 + 8 * D;
constexpr size_t CTL_ZERO_BYTES = alignup(WS_SACC + (size_t)L * SA_LAYER * 8);
constexpr size_t WS_XS = CTL_ZERO_BYTES;
constexpr size_t WS_RSTD = WS_XS + (size_t)13 * NS * D * 4;
constexpr size_t WS_MIXS = alignup(WS_RSTD + 13 * 8 * 4);
constexpr size_t WB_GU = (size_t)NGU * D * 2, WB_D = (size_t)D * FF * 2, WB_IN = (size_t)MIXP * D * 2, WB_OUT = (size_t)D * D * 2;
constexpr size_t WL_GU1 = 0, WL_D1 = WL_GU1 + WB_GU, WL_IN = WL_D1 + WB_D, WL_OUT = WL_IN + WB_IN, WL_GU2 = WL_OUT + WB_OUT, WL_D2 = WL_GU2 + WB_GU, WL_W2T = WL_D2 + WB_D,
                 WL_A2T = WL_W2T + (size_t)RW * 64 * 2, WL_G2T = WL_A2T + (size_t)RW * 64 * 2, WL_LAYER = alignup(WL_G2T + (size_t)RW * 128 * 2);
constexpr size_t WS_W = alignup(WS_MIXS + (size_t)L * NS * D * 4);
constexpr size_t WS_XB = WS_W + (size_t)L * WL_LAYER;
constexpr size_t WS_H = WS_XB + (size_t)MP * D * 2;
constexpr size_t WS_QN = WS_H + (size_t)MP * FF * 2;
constexpr size_t WS_KN = WS_QN + (size_t)MP * AW * 2;
constexpr size_t WS_VB = WS_KN + (size_t)MP * AW * 2;
constexpr size_t WS_PR = WS_VB + (size_t)MP * AW * 2;
constexpr size_t WS_MIX = WS_PR + (size_t)MP * PRW * 2;
constexpr size_t WS_OG = WS_MIX + (size_t)MP * D * 2;
constexpr size_t WS_LSE = WS_OG + (size_t)3 * MP * AW * 4;
constexpr size_t WS_PC = WS_LSE + (size_t)3 * MP * AH * 4;
constexpr size_t WS_RT = WS_PC + (size_t)NTASK * 2 * 4096 * 4;
constexpr size_t WS_YZ = WS_RT + (size_t)48 * T * 64 * 4;
constexpr size_t WS_GG = WS_YZ + (size_t)48 * T * 64 * 4;
constexpr size_t WS_BON = WS_GG + (size_t)48 * T * 64 * 4;
constexpr size_t WS_SC = WS_BON + (size_t)48 * T * 64 * 4;
constexpr size_t WS_FAST_END = WS_SC + (size_t)NTASK * 4096 * 4;

constexpr int LDS_BYTES = 147456;
constexpr int RING_BYTES = 131072;
constexpr int MISC_OFF = LDS_BYTES - 256;
constexpr int PTAB_OFF = LDS_BYTES - 1024;

#define RLX_AGENT __ATOMIC_RELAXED, __HIP_MEMORY_SCOPE_AGENT
#define LDS_WAIT() asm volatile("s_waitcnt lgkmcnt(0)" ::: "memory")
#define VM_WAIT() asm volatile("s_waitcnt vmcnt(0)" ::: "memory")
__device__ __forceinline__ unsigned f2bf(float f) { unsigned u = __builtin_bit_cast(unsigned, f); return (u + 0x7fffu + ((u >> 16) & 1u)) >> 16; }
__device__ __forceinline__ unsigned pk2(float lo, float hi) { return f2bf(lo) | (f2bf(hi) << 16); }
__device__ __forceinline__ float bf2f(unsigned short b) { return __builtin_bit_cast(float, (unsigned)b << 16); }
__device__ __forceinline__ float bflo(unsigned w) { return __builtin_bit_cast(float, w << 16); }
__device__ __forceinline__ float bfhi(unsigned w) { return __builtin_bit_cast(float, w & 0xffff0000u); }
typedef unsigned long long u64;
constexpr float SS_SCALE = 16777216.0f, SS_INV = 1.0f / 16777216.0f;
__device__ __forceinline__ u64 ss_enc(float s) { return (u64)((double)s * 16777216.0); }
__device__ __forceinline__ float ss_dec(u64 v) { return (float)v * SS_INV; }
__device__ __forceinline__ u64 fx_enc(float a) { return (u64)(long long)__double2ll_rn((double)a * 4294967296.0); }
__device__ __forceinline__ float fx_dec(u64 v) { return (float)((double)(long long)v * 2.3283064365386963e-10); }
__device__ __forceinline__ float sigmoidf_(float x) { return 1.0f / (1.0f + __expf(-x)); }
__device__ __forceinline__ float wave_sum(float v) {
#pragma unroll
    for (int o = 1; o < 64; o <<= 1) v += __shfl_xor(v, o);
    return v;
}
__device__ __forceinline__ float dpp_x1(float x) { return __builtin_bit_cast(float, __builtin_amdgcn_update_dpp(0, __builtin_bit_cast(int, x), 0xB1, 0xF, 0xF, true)); }
__device__ __forceinline__ float dpp_x2(float x) { return __builtin_bit_cast(float, __builtin_amdgcn_update_dpp(0, __builtin_bit_cast(int, x), 0x4E, 0xF, 0xF, true)); }
__device__ __forceinline__ float dpp_hm(float x) { return __builtin_bit_cast(float, __builtin_amdgcn_update_dpp(0, __builtin_bit_cast(int, x), 0x141, 0xF, 0xF, true)); }
__device__ __forceinline__ float dpp_rm(float x) { return __builtin_bit_cast(float, __builtin_amdgcn_update_dpp(0, __builtin_bit_cast(int, x), 0x140, 0xF, 0xF, true)); }
__device__ __forceinline__ float sum8(float x) { x += dpp_x1(x); x += dpp_x2(x); x += dpp_hm(x); return x; }
__device__ __forceinline__ float sum16(float x) { x = sum8(x); x += dpp_rm(x); return x; }

#define XB_TMO      128
#define XB_XCNT(j)  (256  + 64 * (j))
#define XB_XSUB(j)  (1280 + 64 * (j))
#define XB_XGEN(j)  (2304 + 64 * (j))
#define XB_TOP      3328
#define XB_TOPGEN   3392
#define XCD_BAR_WORDS 3456
#define XB_SPIN_CAP (1u << 20)
__device__ __forceinline__ unsigned xb_ld(unsigned* p)              { return __hip_atomic_load(p, __ATOMIC_RELAXED, __HIP_MEMORY_SCOPE_AGENT); }
__device__ __forceinline__ unsigned xb_add(unsigned* p, unsigned v) { return __hip_atomic_fetch_add(p, v, __ATOMIC_RELAXED, __HIP_MEMORY_SCOPE_AGENT); }
__device__ __forceinline__ unsigned xb_xcc_id() { return (unsigned)__builtin_amdgcn_s_getreg((3 << 11) | 20) & 0xFu; }
#define XB_SPIN(cond, bar) do { unsigned _sp = 0; while (cond) { __builtin_amdgcn_s_sleep(1); \
    if ((++_sp & 255u) == 0u) { if (xb_ld(&(bar)[XB_TMO])) break; if (_sp > XB_SPIN_CAP) { atomicAdd(&(bar)[XB_TMO], 1u); break; } } } } while (0)
struct XcdBarrier { unsigned* bar; unsigned x; volatile LAS unsigned* st; };
__device__ __forceinline__ XcdBarrier xcd_barrier_post(unsigned* bar, volatile LAS unsigned* st) {
    XcdBarrier b; b.bar = bar; b.x = xb_xcc_id(); b.st = st;
    if (threadIdx.x == 0) (void)xb_add(&bar[XB_XCNT(b.x)], 1u);
    return b;
}
__device__ __forceinline__ void xcd_barrier_complete(unsigned* bar, unsigned x, unsigned& nloc, unsigned& nx) {
    const unsigned G = gridDim.x * gridDim.y * gridDim.z;
    unsigned sum, cnt, mine, sp = 0u;
    for (;;) {
        sum = 0u; cnt = 0u; mine = 0u;
#pragma unroll
        for (unsigned j = 0; j < 16; ++j) { const unsigned c = xb_ld(&bar[XB_XCNT(j)]); sum += c; cnt += (c > 0u) ? 1u : 0u; mine = (j == x) ? c : mine; }
        if (sum == G) break;
        __builtin_amdgcn_s_sleep(1);
        if ((++sp & 255u) == 0u) { if (xb_ld(&bar[XB_TMO])) break; if (sp > XB_SPIN_CAP) { atomicAdd(&bar[XB_TMO], 1u); break; } }
    }
    nloc = mine > 0u ? mine : 1u; nx = cnt > 0u ? cnt : 1u;
}
__device__ __forceinline__ void xcd_barrier(const XcdBarrier& b) {
    asm volatile("s_waitcnt vmcnt(0)" ::: "memory");
    __syncthreads();
    int t_ = threadIdx.x; asm volatile("" : "+v"(t_));
    if (t_ == 0) {
        unsigned* bar = b.bar;
        __builtin_amdgcn_s_waitcnt(0);
        unsigned nloc = b.st[0], nx = b.st[1];
        if (nloc == 0u) { xcd_barrier_complete(bar, b.x, nloc, nx); b.st[0] = nloc; b.st[1] = nx; }
        const unsigned old = xb_add(&bar[XB_XSUB(b.x)], 1u);
        const unsigned gen = old / nloc;
        if (old + 1u == (gen + 1u) * nloc) {
            __builtin_amdgcn_fence(__ATOMIC_RELEASE, "agent");
            asm volatile("s_waitcnt vmcnt(0)" ::: "memory");
            const unsigned og = xb_add(&bar[XB_TOP], 1u);
            const unsigned tg = og / nx;
            if (og + 1u == (tg + 1u) * nx) xb_add(&bar[XB_TOPGEN], 1u);
            else XB_SPIN(xb_ld(&bar[XB_TOPGEN]) == tg, bar);
            __builtin_amdgcn_fence(__ATOMIC_ACQUIRE, "agent");
            xb_add(&bar[XB_XGEN(b.x)], 1u);
            asm volatile("s_waitcnt vmcnt(0)" ::: "memory");
        } else {
            XB_SPIN(xb_ld(&bar[XB_XGEN(b.x)]) == gen, bar);
            __builtin_amdgcn_fence(__ATOMIC_ACQUIRE, "agent");
            asm volatile("s_waitcnt vmcnt(0)" ::: "memory");
        }
    }
    __syncthreads();
}
}
namespace pg8 {
#define PG8_LAS __attribute__((address_space(3)))
typedef unsigned short bf16_t;
typedef short bf16x8 __attribute__((ext_vector_type(8)));
typedef float f32x4 __attribute__((ext_vector_type(4)));
typedef unsigned u32x4 __attribute__((ext_vector_type(4)));
constexpr int BM = 256, BK = 64, HALF = 128, HTB = HALF * BK * 2  , STAGE_BYTES = 8 * HTB, NXCD = 8, WGM = 8;

__host__ __device__ __forceinline__ int lds_byte(int r, int c) { const int st = (r >> 4) * 2 + (c >> 5), rr = r & 15, cc = c & 31, ob = rr * 64 + cc * 2; return st * 1024 + (ob ^ (((ob >> 9) & 1) << 5)); }
__host__ __device__ __forceinline__ void stage_rc(int b, int& R, int& C) { const int st = b / 1024, sb = b % 1024, swz = sb ^ (((sb >> 9) & 1) << 5); R = (st >> 1) * 16 + swz / 64; C = (st & 1) * 32 + (swz % 64) / 2; }
__host__ __device__ __forceinline__ int perm32(int rho) { const int n = rho >> 4, i = rho & 15; return 8 * (i >> 2) + 4 * n + (i & 3); }

struct Unit { int pm, pn; };
struct Gemm { const bf16_t* A; const bf16_t* Bt; int M, N, K; };

struct StaticOrder {
    int nM, nN, nwg, G, c;
    __host__ __device__ void init(int M, int N, int G_, int c_) { nM = M / BM; nN = N / BM; nwg = nM * nN; G = G_; c = c_; }
    __host__ __device__ bool next(int i, Unit& u) const {
        const long L = (long)i * G + c; if (L >= nwg) return false;
        int wgid = (int)L; { const int q = nwg / NXCD, r = nwg % NXCD, xcd = wgid % NXCD, off = wgid / NXCD; wgid = (xcd < r ? xcd * (q + 1) : r * (q + 1) + (xcd - r) * q) + off; }
        const int nig = WGM * nN, gid = wgid / nig, fm = gid * WGM, gsz = (nM - fm) < WGM ? (nM - fm) : WGM;
        u.pm = fm + ((wgid % nig) % gsz); u.pn = (wgid % nig) / gsz; return true;
    }
    __device__ __forceinline__ void a_ready(const Unit&) const {}
    __device__ __forceinline__ void done(const Unit&) const {}
};

__device__ __forceinline__ unsigned cvt_pk_bf16(float lo, float hi) { unsigned r; asm volatile("v_cvt_pk_bf16_f32 %0, %1, %2" : "=v"(r) : "v"(lo), "v"(hi)); return r; }
__device__ __forceinline__ u32x4 pack8(const f32x4& a, const f32x4& b) { u32x4 w; w.x = cvt_pk_bf16(a[0], a[1]); w.y = cvt_pk_bf16(a[2], a[3]); w.z = cvt_pk_bf16(b[0], b[1]); w.w = cvt_pk_bf16(b[2], b[3]); return w; }
__device__ __forceinline__ float silu_f(float g) { return g * __builtin_amdgcn_rcpf(1.0f + __expf(-g)); }
constexpr float kEps = 1e-6f;

struct EpiSwiglu {
    static constexpr bool PERM = true, AFTER_DRAIN = false;
    bf16_t* H; const unsigned long long* ss; int ldh;
    __device__ __forceinline__ void operator()(const f32x4 (&acc)[2][2][4][2], const Unit& u, int wr, int wc, int fr, int fq) const {
        const int row0 = u.pm * BM + wr * 64 + fr, col0 = u.pn * HALF + wc * 32 + 8 * fq;
#pragma unroll
        for (int ai = 0; ai < 2; ++ai)
#pragma unroll
            for (int m = 0; m < 4; ++m) { const int row = row0 + ai * HALF + m * 16; const float rs = __builtin_amdgcn_rsqf((float)ss[row] * (1.0f / (16777216.0f * 2048.0f)) + kEps);
                f32x4 h0, h1;
#pragma unroll
                for (int j = 0; j < 4; ++j) { h0[j] = silu_f(acc[ai][0][m][0][j] * rs) * (acc[ai][1][m][0][j] * rs); h1[j] = silu_f(acc[ai][0][m][1][j] * rs) * (acc[ai][1][m][1][j] * rs); }
                *(u32x4*)(H + (size_t)row * ldh + col0) = pack8(h0, h1); }
    }
};
struct EpiResid {
    static constexpr bool PERM = true, AFTER_DRAIN = false;
    float* X; bf16_t* XB; unsigned long long* ssn; float coef;
    __device__ __forceinline__ void operator()(const f32x4 (&acc)[2][2][4][2], const Unit& u, int wr, int wc, int fr, int fq) const {
        const int row0 = u.pm * BM + wr * 64 + fr, col0 = u.pn * BM + wc * 32 + 8 * fq;
#pragma unroll
        for (int ai = 0; ai < 2; ++ai)
#pragma unroll
            for (int m = 0; m < 4; ++m) { const int row = row0 + ai * HALF + m * 16; float part = 0.f;
#pragma unroll
                for (int bj = 0; bj < 2; ++bj) { float* xp = X + (size_t)row * 2048 + col0 + bj * HALF;
                    f32x4 x0 = *(const f32x4*)xp, x1 = *(const f32x4*)(xp + 4);
                    x0 = x0 + acc[ai][bj][m][0] * coef; x1 = x1 + acc[ai][bj][m][1] * coef;
                    *(f32x4*)xp = x0; *(f32x4*)(xp + 4) = x1;
                    *(u32x4*)(XB + (size_t)row * 2048 + col0 + bj * HALF) = pack8(x0, x1);
                    part += (x0[0] * x0[0] + x0[1] * x0[1]) + (x0[2] * x0[2] + x0[3] * x0[3]) + (x1[0] * x1[0] + x1[1] * x1[1]) + (x1[2] * x1[2] + x1[3] * x1[3]); }
                part += __shfl_xor(part, 16); part += __shfl_xor(part, 32);
                if (ssn != nullptr && fq == 0) (void)__hip_atomic_fetch_add(ssn + row, (unsigned long long)((double)part * 16777216.0), __ATOMIC_RELAXED, __HIP_MEMORY_SCOPE_AGENT); }
    }
};
struct EpiWin {
    static constexpr bool PERM = true, AFTER_DRAIN = false;
    const unsigned long long* ss; bf16_t *QN, *PR; float *outK, *outSh; const float *qg, *kg; size_t qkv_stride, kv_out_stride;
    __device__ __forceinline__ void operator()(const f32x4 (&acc)[2][2][4][2], const Unit& u, int wr, int wc, int fr, int fq) const {
        const int row0 = u.pm * BM + wr * 64 + fr;
        if (u.pn < 6) {
            const int type = u.pn >> 1, head = 4 * (u.pn & 1) + wc;
            f32x4 gn[2][2];
#pragma unroll
            for (int bj = 0; bj < 2; ++bj)
#pragma unroll
                for (int n = 0; n < 2; ++n) { const int d = 32 * bj + 8 * fq + 4 * n;
                    const f32x4 gq = *(const f32x4*)(qg + d) * 0.125f, gk = *(const f32x4*)(kg + d);
                    gn[bj][n] = type == 0 ? gq : (type == 1 ? gk : (f32x4){1.f, 1.f, 1.f, 1.f}); }
            bf16_t* const dst = QN + (size_t)type * qkv_stride;
            float* const od = outK + (size_t)(type >> 1) * kv_out_stride;
#pragma unroll
            for (int ai = 0; ai < 2; ++ai)
#pragma unroll
                for (int m = 0; m < 4; ++m) { const int row = row0 + ai * HALF + m * 16; const float rs = __builtin_amdgcn_rsqf((float)ss[row] * (1.0f / (16777216.0f * 2048.0f)) + kEps);
                    f32x4 v[2][2]; float q = 0.f;
#pragma unroll
                    for (int bj = 0; bj < 2; ++bj)
#pragma unroll
                        for (int n = 0; n < 2; ++n) { v[bj][n] = acc[ai][bj][m][n] * rs; q += (v[bj][n][0] * v[bj][n][0] + v[bj][n][1] * v[bj][n][1]) + (v[bj][n][2] * v[bj][n][2] + v[bj][n][3] * v[bj][n][3]); }
                    q += __shfl_xor(q, 16); q += __shfl_xor(q, 32);
                    const float hn = type < 2 ? __builtin_amdgcn_rsqf(q * (1.0f / 64.0f) + kEps) : 1.0f;
#pragma unroll
                    for (int bj = 0; bj < 2; ++bj) { const f32x4 a = v[bj][0] * hn * gn[bj][0], b = v[bj][1] * hn * gn[bj][1];
                        const size_t o = (size_t)row * 512 + head * 64 + 32 * bj + 8 * fq;
                        *(u32x4*)(dst + o) = pack8(a, b);
                        if (type >= 1) { *(f32x4*)(od + o) = a; *(f32x4*)(od + o + 4) = b; } } }
        } else {
            const int colp = u.pn * BM + wc * 32 + 8 * fq - 1536;
#pragma unroll
            for (int ai = 0; ai < 2; ++ai)
#pragma unroll
                for (int m = 0; m < 4; ++m) { const int row = row0 + ai * HALF + m * 16; const float rs = __builtin_amdgcn_rsqf((float)ss[row] * (1.0f / (16777216.0f * 2048.0f)) + kEps);
#pragma unroll
                    for (int bj = 0; bj < 2; ++bj) { const f32x4 a = acc[ai][bj][m][0] * rs, b = acc[ai][bj][m][1] * rs; const int c = colp + bj * HALF;
                        *(u32x4*)(PR + (size_t)row * 4864 + c) = pack8(a, b);
                        if (u.pn < 16 && (row & 2047) == 2047) { float* o = outSh + (size_t)(row >> 11) * 2560 + c; *(f32x4*)o = a; *(f32x4*)(o + 4) = b; } } }
        }
    }
};
template <class Epi, class Sched, bool ALIGN_EPI = false, bool SP2 = false>
__device__ __forceinline__ void gemm_phase(PG8_LAS unsigned char* lds, const Gemm g, const Sched& S, const Epi& E, const int tid) {
    const int wid = __builtin_amdgcn_readfirstlane(tid >> 6), lane = tid & 63, wr = wid >> 2, wc = wid & 3, fr = lane & 15, fq = lane >> 4;
    const int K = g.K, nt = K / BK;
    unsigned voffA[2], voffB[2];
#pragma unroll
    for (int i = 0; i < 2; ++i) { int R, C; stage_rc(tid * 16 + i * 8192, R, C); const int Rb = Epi::PERM ? ((R & ~31) + perm32(R & 31)) : R;
        voffA[i] = (unsigned)(R * K + C) * 2u; voffB[i] = (unsigned)(Rb * K + C) * 2u; }
    const size_t kstep = (size_t)(BK * 2);
    const size_t hstep = (size_t)HALF * K * 2;
    const size_t tstep = 2 * hstep;
    const unsigned ldsw = (unsigned)wid * 1024u;
    const int aoff = lds_byte(wr * 64 + fr, fq * 8), boff = lds_byte(wc * 32 + fr, fq * 8);
#define PG8_SA(b, h) (((b) * 2 + (h)) * HTB)
#define PG8_SB(b, h) ((4 + (b) * 2 + (h)) * HTB)
#define PG8_STAGE(bufoff, gbase, voff) do { _Pragma("unroll") for (int _i = 0; _i < 2; ++_i) \
        __builtin_amdgcn_global_load_lds((const unsigned*)((const char*)(gbase) + (voff)[_i]), (PG8_LAS unsigned*)(lds + (bufoff) + ldsw + _i * 8192), 16, 0, 0); } while (0)
#define PG8_LDA(dst, b, h) do { _Pragma("unroll") for (int m = 0; m < 4; ++m) _Pragma("unroll") for (int k = 0; k < 2; ++k) dst[m][k] = *(const PG8_LAS bf16x8*)(lds + PG8_SA(b, h) + aoff + m * 2048 + k * 1024); } while (0)
#define PG8_LDB(dst, b, h) do { _Pragma("unroll") for (int n = 0; n < 2; ++n) _Pragma("unroll") for (int k = 0; k < 2; ++k) dst[n][k] = *(const PG8_LAS bf16x8*)(lds + PG8_SB(b, h) + boff + n * 2048 + k * 1024); } while (0)
#define PG8_MMA(ai, bj, At, Bt) do { __builtin_amdgcn_s_setprio(1); _Pragma("unroll") for (int m = 0; m < 4; ++m) _Pragma("unroll") for (int n = 0; n < 2; ++n) _Pragma("unroll") for (int k = 0; k < 2; ++k) \
        acc[ai][bj][m][n] = __builtin_amdgcn_mfma_f32_16x16x32_bf16(Bt[n][k], At[m][k], acc[ai][bj][m][n], 0, 0, 0); __builtin_amdgcn_s_setprio(0); } while (0)
#define PG8_WAIT_V(n) asm volatile("s_waitcnt vmcnt(" #n ")" ::: "memory")
#define PG8_WAIT_L(n) asm volatile("s_waitcnt lgkmcnt(" #n ")" ::: "memory")
#define PG8_BAR __builtin_amdgcn_s_barrier()
#define PG8_SCHED __builtin_amdgcn_sched_barrier(0)
    Unit cur, nxt; int ui = 0;
    if (!S.next(0, cur)) return;
    f32x4 acc[2][2][4][2];
#pragma unroll
    for (int a = 0; a < 2; ++a)
#pragma unroll
        for (int b = 0; b < 2; ++b)
#pragma unroll
            for (int m = 0; m < 4; ++m)
#pragma unroll
                for (int n = 0; n < 2; ++n) acc[a][b][m][n] = (f32x4){0.f, 0.f, 0.f, 0.f};
    bf16x8 At[4][2], B0[2][2], B1[2][2];
    const char* cA = (const char*)g.A + (size_t)cur.pm * tstep; const char* cB = (const char*)g.Bt + (size_t)cur.pn * tstep;
    S.a_ready(cur);
    if constexpr (SP2) {
        PG8_STAGE(PG8_SB(0, 0), cB, voffB); PG8_STAGE(PG8_SB(0, 1), cB + hstep, voffB); PG8_STAGE(PG8_SA(0, 0), cA, voffA); PG8_STAGE(PG8_SA(0, 1), cA + hstep, voffA);
        if (wr == 1) PG8_BAR;
        PG8_WAIT_V(2); PG8_BAR;
        PG8_STAGE(PG8_SB(1, 0), cB + kstep, voffB); PG8_STAGE(PG8_SA(1, 0), cA + kstep, voffA); PG8_STAGE(PG8_SB(1, 1), cB + hstep + kstep, voffB);
        PG8_WAIT_V(6); PG8_BAR;
    } else {
        PG8_STAGE(PG8_SB(0, 0), cB, voffB); PG8_STAGE(PG8_SA(0, 0), cA, voffA); PG8_STAGE(PG8_SB(0, 1), cB + hstep, voffB); PG8_STAGE(PG8_SA(0, 1), cA + hstep, voffA);
        if (wr == 1) PG8_BAR;
        PG8_WAIT_V(4); PG8_BAR;
        PG8_STAGE(PG8_SB(1, 0), cB + kstep, voffB); PG8_STAGE(PG8_SA(1, 0), cA + kstep, voffA); PG8_STAGE(PG8_SB(1, 1), cB + hstep + kstep, voffB);
        PG8_WAIT_V(6); PG8_BAR;
    }
    for (;;) {
        const bool has_next = S.next(ui + 1, nxt);
        const char* nA = has_next ? (const char*)g.A + (size_t)nxt.pm * tstep : cA; const char* nB = has_next ? (const char*)g.Bt + (size_t)nxt.pn * tstep : cB;
        for (int t = 0; t < nt; t += 2) {
            const bool last = (t == nt - 2);
            const char* a1 = cA + (size_t)(t + 1) * kstep;
            const char* a2 = last ? nA : cA + (size_t)(t + 2) * kstep; const char* b2 = last ? nB : cB + (size_t)(t + 2) * kstep;
            const char* a3 = a2 + kstep; const char* b3 = b2 + kstep;
            if (last && has_next) S.a_ready(nxt);
            if constexpr (SP2) {
            PG8_LDB(B0, 0, 0); PG8_LDB(B1, 0, 1); PG8_SCHED; PG8_LDA(At, 0, 0); PG8_STAGE(PG8_SA(1, 1), a1 + hstep, voffA);
            PG8_WAIT_V(8); PG8_WAIT_L(0); PG8_BAR; PG8_MMA(0, 0, At, B0); PG8_MMA(0, 1, At, B1); PG8_BAR; PG8_SCHED;
            PG8_LDA(At, 0, 1); PG8_STAGE(PG8_SB(0, 0), b2, voffB); PG8_STAGE(PG8_SB(0, 1), b2 + hstep, voffB); PG8_STAGE(PG8_SA(0, 0), a2, voffA);
            PG8_WAIT_V(8); PG8_WAIT_L(0); PG8_BAR; PG8_MMA(1, 0, At, B0); PG8_MMA(1, 1, At, B1); PG8_BAR; PG8_SCHED;
            PG8_LDB(B0, 1, 0); PG8_LDB(B1, 1, 1); PG8_SCHED; PG8_LDA(At, 1, 0); PG8_STAGE(PG8_SA(0, 1), a2 + hstep, voffA);
            PG8_WAIT_V(8); PG8_WAIT_L(0); PG8_BAR; PG8_MMA(0, 0, At, B0); PG8_MMA(0, 1, At, B1); PG8_BAR; PG8_SCHED;
            PG8_LDA(At, 1, 1); PG8_STAGE(PG8_SB(1, 0), b3, voffB); PG8_STAGE(PG8_SB(1, 1), b3 + hstep, voffB); PG8_STAGE(PG8_SA(1, 0), a3, voffA);
            PG8_WAIT_V(8); PG8_WAIT_L(0); PG8_BAR; PG8_MMA(1, 0, At, B0); PG8_MMA(1, 1, At, B1); PG8_BAR; PG8_SCHED;
            } else {
            PG8_LDB(B0, 0, 0); PG8_SCHED; PG8_LDA(At, 0, 0); PG8_STAGE(PG8_SA(1, 1), a1 + hstep, voffA);
            PG8_WAIT_L(8); PG8_BAR; PG8_WAIT_L(0); PG8_MMA(0, 0, At, B0); PG8_BAR; PG8_SCHED;
            PG8_LDB(B1, 0, 1); PG8_STAGE(PG8_SB(0, 0), b2, voffB);
            PG8_BAR; PG8_WAIT_L(0); PG8_MMA(0, 1, At, B1); PG8_BAR;
            PG8_LDA(At, 0, 1); PG8_STAGE(PG8_SA(0, 0), a2, voffA);
            PG8_BAR; PG8_WAIT_L(0); PG8_MMA(1, 0, At, B0); PG8_BAR; PG8_SCHED;
            PG8_STAGE(PG8_SB(0, 1), b2 + hstep, voffB);
            PG8_WAIT_V(6); PG8_BAR; PG8_MMA(1, 1, At, B1); PG8_BAR;
            PG8_LDB(B0, 1, 0); PG8_SCHED; PG8_LDA(At, 1, 0); PG8_STAGE(PG8_SA(0, 1), a2 + hstep, voffA);
            PG8_WAIT_L(8); PG8_BAR; PG8_WAIT_L(0); PG8_MMA(0, 0, At, B0); PG8_BAR; PG8_SCHED;
            PG8_LDB(B1, 1, 1); PG8_STAGE(PG8_SB(1, 0), b3, voffB);
            PG8_BAR; PG8_WAIT_L(0); PG8_MMA(0, 1, At, B1); PG8_BAR;
            PG8_LDA(At, 1, 1); PG8_STAGE(PG8_SA(1, 0), a3, voffA);
            PG8_BAR; PG8_WAIT_L(0); PG8_MMA(1, 0, At, B0); PG8_BAR; PG8_SCHED;
            PG8_STAGE(PG8_SB(1, 1), b3 + hstep, voffB);
            PG8_WAIT_V(6); PG8_BAR; PG8_MMA(1, 1, At, B1); PG8_BAR;
            }
        }
        if constexpr (ALIGN_EPI) { if (wr == 0) PG8_BAR; }
        if constexpr (!Epi::AFTER_DRAIN) { E(acc, cur, wr, wc, fr, fq); S.done(cur); }
        if (!has_next) break;
#pragma unroll
        for (int a = 0; a < 2; ++a)
#pragma unroll
            for (int b = 0; b < 2; ++b)
#pragma unroll
                for (int m = 0; m < 4; ++m)
#pragma unroll
                    for (int n = 0; n < 2; ++n) acc[a][b][m][n] = (f32x4){0.f, 0.f, 0.f, 0.f};
        cur = nxt; cA = nA; cB = nB; ++ui;
        if constexpr (ALIGN_EPI) { if (wr == 1) PG8_BAR; }
    }
    PG8_WAIT_V(0);
    if constexpr (!ALIGN_EPI) { if (wr == 0) PG8_BAR; }
    PG8_BAR;
    if constexpr (Epi::AFTER_DRAIN) { E.fused(acc, cur, wr, wc, fr, fq, lds, wid, lane); S.done(cur); }
#undef PG8_SA
#undef PG8_SB
#undef PG8_STAGE
#undef PG8_LDA
#undef PG8_LDB
#undef PG8_MMA
#undef PG8_WAIT_V
#undef PG8_WAIT_L
#undef PG8_BAR
#undef PG8_SCHED
}
}
namespace fk {
struct Frame {
    LAS unsigned char* lds;
    volatile LAS unsigned* MISC;
    gu32* ctl;
    int tid, lane, wave, G, bid;
    const LAS unsigned* ptab;
    float* out;
    unsigned char* ws;
};
__device__ __forceinline__ const float* inp(const Frame& F, int i) { const unsigned lo = __builtin_amdgcn_readfirstlane(F.ptab[2 * i]), hi = __builtin_amdgcn_readfirstlane(F.ptab[2 * i + 1]); return (const float*)(((unsigned long long)hi << 32) | lo); }
__device__ __forceinline__ unsigned char* wlayer(const Frame& F, int l) { return F.ws + WS_W + (size_t)l * WL_LAYER; }
__device__ __forceinline__ u64* ssarr(const Frame& F, int j) { return (u64*)(F.ws + WS_SS) + (size_t)j * MP; }
__device__ __forceinline__ u64* sacc(const Frame& F, int l, int off) { return (u64*)(F.ws + WS_SACC) + (size_t)l * SA_LAYER + off; }
__device__ __forceinline__ float* xsbuf(const Frame& F, int j) { return (float*)(F.ws + WS_XS) + (size_t)j * NS * D; }
__device__ __forceinline__ float* rstdbuf(const Frame& F, int j) { return (float*)(F.ws + WS_RSTD) + j * 8; }

#define LDS_BARRIER() do { asm volatile("s_waitcnt lgkmcnt(0)" ::: "memory"); __builtin_amdgcn_s_barrier(); asm volatile("" ::: "memory"); } while (0)
#define RELAUNDER(F) do { int t_ = threadIdx.x; asm volatile("" : "+v"(t_)); (F).tid = t_; (F).lane = t_ & 63; (F).wave = __builtin_amdgcn_readfirstlane(t_ >> 6); } while (0)
template <int MAP> __device__ __forceinline__ int dest_row(int n) {
    if (MAP == 1) return (n >> 7) * 256 + (n & 127);
    if (MAP == 2) return (n >> 7) * 256 + 128 + (n & 127);
    if (MAP == 3) { if (n >= 1536) return n; const int tile = n >> 8, loc = n & 255, hh = loc >> 6, d = loc & 63; return tile * 256 + (d >> 5) * 128 + hh * 32 + (d & 31); }
    return n;
}
template <int MAP> __device__ __forceinline__ void transpose_item(const float* W, const float* gk, int K, int N, bf16* WT, LAS float* scr, int item, int lane) {
    const int nblk = N >> 6, kb = item / nblk, nb = item - kb * nblk, k0 = kb * 64, n0 = nb * 64;
    const int lr = lane >> 4, lc = (lane & 15) * 4;
    f32x4 vv[16];
#pragma unroll
    for (int i = 0; i < 16; ++i) vv[i] = *(const GAS f32x4*)(W + (size_t)(k0 + 4 * i + lr) * N + n0 + lc);
#pragma unroll
    for (int i = 0; i < 16; ++i) { const int kk = 4 * i + lr; f32x4 v = vv[i];
        if (gk != nullptr) v = v * gk[k0 + kk];
        LAS float* s = scr + kk * 65 + lc; s[0] = v[0]; s[1] = v[1]; s[2] = v[2]; s[3] = v[3]; }
    LDS_WAIT(); asm volatile("" ::: "memory");
    const int c = lane & 7;
#pragma unroll
    for (int jj = 0; jj < 8; ++jj) { const int n = (lane >> 3) + 8 * jj; const LAS float* s = scr + (8 * c) * 65 + n;
        v4u o; o.x = pk2(s[0], s[65]); o.y = pk2(s[2 * 65], s[3 * 65]); o.z = pk2(s[4 * 65], s[5 * 65]); o.w = pk2(s[6 * 65], s[7 * 65]);
        *(GAS v4u*)(WT + (size_t)dest_row<MAP>(n0 + n) * K + k0 + 8 * c) = o; }
    LDS_WAIT(); asm volatile("" ::: "memory");
}
__device__ __forceinline__ void p0_prologue(Frame& F) {
    LAS float* scr = (LAS float*)(F.lds + F.wave * 16640);
    const int gw = F.bid * NWAVES + F.wave, NGW = F.G * NWAVES;
    constexpr int I_GU = (D / 64) * (FF / 64), I_DN = (FF / 64) * (D / 64), I_IN = (D / 64) * (MIXP / 64), I_OUT = (D / 64) * (D / 64);
    constexpr int PER_LAYER = 6 * I_GU + I_IN + I_OUT;
    static_assert(I_GU == I_DN, "item counts");
    for (int it = gw; it < L * PER_LAYER; it += NGW) {
        const int l = it / PER_LAYER; int r = it - l * PER_LAYER;
        unsigned char* wl = wlayer(F, l);
        const size_t o1 = (size_t)l * D * FF, o2 = (size_t)l * D;
        if (r < I_GU) { transpose_item<1>(inp(F, 8) + o1, inp(F, 7) + o2, D, FF, (bf16*)(wl + WL_GU1), scr, r, F.lane); continue; } r -= I_GU;
        if (r < I_GU) { transpose_item<2>(inp(F, 9) + o1, inp(F, 7) + o2, D, FF, (bf16*)(wl + WL_GU1), scr, r, F.lane); continue; } r -= I_GU;
        if (r < I_DN) { transpose_item<0>(inp(F, 10) + o1, nullptr, FF, D, (bf16*)(wl + WL_D1), scr, r, F.lane); continue; } r -= I_DN;
        if (r < I_IN) { transpose_item<3>(inp(F, 12) + (size_t)l * D * MIXP, inp(F, 11) + o2, D, MIXP, (bf16*)(wl + WL_IN), scr, r, F.lane); continue; } r -= I_IN;
        if (r < I_OUT) { transpose_item<0>(inp(F, 28) + (size_t)l * D * D, nullptr, D, D, (bf16*)(wl + WL_OUT), scr, r, F.lane); continue; } r -= I_OUT;
        if (r < I_GU) { transpose_item<1>(inp(F, 30) + o1, inp(F, 29) + o2, D, FF, (bf16*)(wl + WL_GU2), scr, r, F.lane); continue; } r -= I_GU;
        if (r < I_GU) { transpose_item<2>(inp(F, 31) + o1, inp(F, 29) + o2, D, FF, (bf16*)(wl + WL_GU2), scr, r, F.lane); continue; } r -= I_GU;
        transpose_item<0>(inp(F, 32) + o1, nullptr, FF, D, (bf16*)(wl + WL_D2), scr, r, F.lane);
    }
    const int gt = F.bid * NTHREADS + F.tid, NGT = F.G * NTHREADS;
    for (int i = gt; i < L * RW * 256; i += NGT) { const int l = i / (RW * 256), r = i - l * RW * 256, c = r >> 8, j = r & 255;
        unsigned char* wl = wlayer(F, l);
        if (j < 64) ((bf16*)(wl + WL_W2T))[c * 64 + j] = (bf16)f2bf(inp(F, 17)[((size_t)l * 64 + j) * RW + c]);
        else if (j < 128) ((bf16*)(wl + WL_A2T))[c * 64 + (j - 64)] = (bf16)f2bf(inp(F, 19)[((size_t)l * 64 + (j - 64)) * RW + c]);
        else ((bf16*)(wl + WL_G2T))[c * 128 + (j - 128)] = (bf16)f2bf(inp(F, 20)[((size_t)l * 128 + (j - 128)) * RW + c]); }
    u64* ss0 = ssarr(F, 0); bf16* XB = (bf16*)(F.ws + WS_XB);
    for (int m = gw; m < MP; m += NGW) { const GAS f32x4* xr = (const GAS f32x4*)(inp(F, 0) + (size_t)m * D) + F.lane; GAS f32x4* xo = (GAS f32x4*)(F.out + O_Y + (size_t)m * D) + F.lane;
        GAS v2u* xb = (GAS v2u*)(XB + (size_t)m * D) + F.lane; float s = 0.f;
#pragma unroll
        for (int j = 0; j < 8; ++j) { const f32x4 v = xr[64 * j]; xo[64 * j] = v; v2u p; p.x = pk2(v[0], v[1]); p.y = pk2(v[2], v[3]); xb[64 * j] = p; s += (v[0] * v[0] + v[1] * v[1]) + (v[2] * v[2] + v[3] * v[3]); }
        s = wave_sum(s); if (F.lane == 0) ss0[m] = ss_enc(s); }
}

__device__ __forceinline__ void sample_x_prep(Frame& F, int j, const float* xprev, const u64* accprev, float c, LAS bf16* Alds, LAS float* red, int writer) {
    f32x4 v[8]; float sq[8];
#pragma unroll
    for (int i = 0; i < 8; ++i) { v[i] = *(const GAS f32x4*)(xprev + i * D + 4 * F.tid);
        if (accprev != nullptr) { const u64* ap = accprev + i * D + 4 * F.tid; v[i] = v[i] + (f32x4){fx_dec(ap[0]), fx_dec(ap[1]), fx_dec(ap[2]), fx_dec(ap[3])} * c; }
        sq[i] = wave_sum((v[i][0] * v[i][0] + v[i][1] * v[i][1]) + (v[i][2] * v[i][2] + v[i][3] * v[i][3]));
        v2u p; p.x = pk2(v[i][0], v[i][1]); p.y = pk2(v[i][2], v[i][3]); *(LAS v2u*)(Alds + i * D + 4 * F.tid) = p; }
    if (F.lane == 0) {
#pragma unroll
        for (int i = 0; i < 8; ++i) red[F.wave * 8 + i] = sq[i]; }
    __syncthreads();
    if (F.bid == writer) {
        if (j > 0) {
#pragma unroll
            for (int i = 0; i < 8; ++i) *(GAS f32x4*)(xsbuf(F, j) + i * D + 4 * F.tid) = v[i]; }
        if (F.tid < 8) { float s = 0.f;
#pragma unroll
            for (int w = 0; w < 8; ++w) s += red[w * 8 + F.tid];
            rstdbuf(F, j)[F.tid] = 1.0f / sqrtf(s * (1.0f / D) + EPS); }
    }
}
template <int NKS> __device__ __forceinline__ void skinny_task(const bf16* Bt, int K, int cg, int k0, const LAS bf16* Alds, int lda, int a_k0, u64* accout, int N, int lane) {
    const bf16* brow = Bt + (size_t)(cg * 16 + (lane & 15)) * K + k0 + 8 * (lane >> 4);
    const LAS bf16* arow = Alds + (lane & 7) * lda + (k0 - a_k0) + 8 * (lane >> 4);
    bf16x8 w[NKS];
#pragma unroll
    for (int ks = 0; ks < NKS; ++ks) w[ks] = *(const GAS bf16x8*)(brow + 32 * ks);
    f32x4 acc = (f32x4){0.f, 0.f, 0.f, 0.f};
#pragma unroll
    for (int ks = 0; ks < NKS; ++ks) { const bf16x8 x = *(const LAS bf16x8*)(arow + 32 * ks); acc = __builtin_amdgcn_mfma_f32_16x16x32_bf16(w[ks], x, acc, 0, 0, 0); }
    if ((lane & 15) < 8) { u64* o = accout + (size_t)(lane & 15) * N + cg * 16 + 4 * (lane >> 4);
#pragma unroll
        for (int r = 0; r < 4; ++r) (void)__hip_atomic_fetch_add(o + r, fx_enc(acc[r]), __ATOMIC_RELAXED, __HIP_MEMORY_SCOPE_AGENT); }
}
template <int KS, int NKS> __device__ __forceinline__ void skinny_gemm(Frame& F, const bf16* Bt, int N, int K, const LAS bf16* Alds, int lda, bool a_is_slice, u64* accout, int first = 0, int nact = 0) {
    if (nact == 0) nact = F.G;
    const int bb = F.bid - first, ks = bb % KS, jj = bb / KS, per = nact / KS;
    const int k0 = ks * 32 * NKS;
    for (int cg = jj * NWAVES + F.wave; cg < N / 16; cg += per * NWAVES) skinny_task<NKS>(Bt, K, cg, k0, Alds, lda, a_is_slice ? k0 : 0, accout, N, F.lane);
}
__device__ __forceinline__ void sample_proj(Frame& F, int j, const float* xprev, const u64* accprev, float c, const bf16* Bt, int N, u64* accout, int first) {
    if (F.bid < first) return;
    LAS bf16* Alds = (LAS bf16*)F.lds; LAS float* red = (LAS float*)(F.lds + 65536);
    sample_x_prep(F, j, xprev, accprev, c, Alds, red, first);
    __syncthreads();
    skinny_gemm<4, 16>(F, Bt, N, D, Alds, D, false, accout, first, F.G - first);
    __syncthreads();
}
__device__ __forceinline__ void sample_down(Frame& F, const u64* accgu, const float* rstd, const bf16* Bt, u64* accout) {
    LAS bf16* Alds = (LAS bf16*)F.lds; constexpr int KS = 16, KL = FF / KS;
    const int k0 = (F.bid % KS) * KL;
    for (int e = F.tid; e < 8 * KL; e += NTHREADS) { const int r = e / KL, kk = e - r * KL, k = k0 + kk; const float rs = rstd[r];
        const int rho = (k >> 7) * 256 + (k & 127); const float g = fx_dec(accgu[(size_t)r * NGU + rho]) * rs, u = fx_dec(accgu[(size_t)r * NGU + rho + 128]) * rs;
        Alds[r * KL + kk] = (bf16)f2bf(g / (1.0f + __expf(-g)) * u); }
    __syncthreads();
    skinny_gemm<16, 11>(F, Bt, D, FF, Alds, KL, true, accout);
    __syncthreads();
}
__device__ __forceinline__ void sample_wout(Frame& F, const float* mixs, const bf16* Bt, u64* accout) {
    LAS bf16* Alds = (LAS bf16*)F.lds;
#pragma unroll
    for (int i = 0; i < 8; ++i) { const f32x4 v = *(const GAS f32x4*)(mixs + i * D + 4 * F.tid); v2u p; p.x = pk2(v[0], v[1]); p.y = pk2(v[2], v[3]); *(LAS v2u*)(Alds + i * D + 4 * F.tid) = p; }
    __syncthreads();
    skinny_gemm<16, 4>(F, Bt, D, D, Alds, D, false, accout);
    __syncthreads();
}

__device__ __forceinline__ float fmul_(float a, float b) { float r; asm("v_mul_f32_e32 %0, %1, %2" : "=v"(r) : "v"(a), "v"(b)); return r; }
__device__ __forceinline__ void fmac_(float& acc, float a, float b) { asm("v_fmac_f32_e32 %0, %1, %2" : "+v"(acc) : "v"(a), "v"(b)); }
constexpr int M1_TASK_LDS = 44544;
constexpr int LORS = 264;
__device__ __forceinline__ int m1_col(int ch, int h) { const int a = (ch >> 3) * RW + 64 * h + 8 * (ch & 7), b = 3 * RW - 192 + 8 * ch; return ch < 24 ? a : b; }
__device__ __forceinline__ void m1_phase(Frame& F, int l, bool noscan = false) {
    RELAUNDER(F);
    const int half = F.wave >> 2, wv = F.wave & 3, tid2 = F.tid & 255, lane = F.lane, kg = lane & 7, rg = lane >> 3;
    LAS unsigned char* tb = F.lds + half * M1_TASK_LDS;
    LAS float* VW = (LAS float*)tb;
    LAS float* VA = VW + 1024;
    LAS float* VBv = VW + 2048;
    LAS float* VK = VW + 3072;
    LAS float* VR = VW + 4096;
    LAS float* VV = VW + 5120;
    LAS bf16* LOR = (LAS bf16*)(tb + 24576);
    constexpr int KR_OFF = (24576 + 16 * LORS * 2) / 4;
    LAS float* KR = VW + KR_OFF;
    LAS float* AS = KR + 1024;
    LAS float* MUl = AS + 1024;
    LAS float* CST = MUl + 448;
    LAS bf16* LORW = (LAS bf16*)(F.lds + 2 * M1_TASK_LDS);
    const bf16* PR = (const bf16*)(F.ws + WS_PR);
    const unsigned char* wl = wlayer(F, l);
    const bf16* w2T = (const bf16*)(wl + WL_W2T); const bf16* a2T = (const bf16*)(wl + WL_A2T); const bf16* g2T = (const bf16*)(wl + WL_G2T);
    const float* mu = inp(F, 15) + (size_t)l * RP; const float* w0 = inp(F, 16) + (size_t)l * RW; const float* a0 = inp(F, 18) + (size_t)l * RW;
    const float* k_k = inp(F, 21) + (size_t)l * RW; const float* k_a = inp(F, 22) + (size_t)l * RW; const float* r_k = inp(F, 23) + (size_t)l * RW;
    float* RT = (float*)(F.ws + WS_RT); float* GG = (float*)(F.ws + WS_GG); float* BON = (float*)(F.ws + WS_BON); float* PC = (float*)(F.ws + WS_PC);
    for (int item = F.bid; item < NTASK / 2; item += F.G) {
        const int task = item * 2 + half, nh = task / NCH, c = task - nh * NCH, n = nh / RH, h = nh - n * RH;
        { const int i0 = tid2, i1 = tid2 + 256; const float m0_ = mu[m1_col(i0 >> 3, h) + (i0 & 7)]; const float m1_ = i1 < 448 ? mu[m1_col(i1 >> 3, h) + (i1 & 7)] : 0.f;
          const int cc = 64 * h + (tid2 & 63), which = tid2 >> 6;
          const float c0_ = which == 0 ? k_k[cc] : (which == 1 ? k_a[cc] : (which == 2 ? r_k[cc] : w0[cc])); const float c1_ = a0[cc];
          MUl[i0] = m0_; if (i1 < 448) MUl[i1] = m1_; CST[tid2] = c0_; if (tid2 < 64) CST[256 + tid2] = c1_; }
        const int ci = 16 * wv + (lane & 15), kq = 8 * (lane >> 4);
        { v4u lw[4];
#pragma unroll
          for (int u = 0; u < 4; ++u) { const int q = F.tid + NTHREADS * u, row = q >> 5, cc = q & 31; const size_t cr = (size_t)(64 * h + row);
            const bf16* src = cc < 16 ? (cc < 8 ? w2T + cr * 64 + 8 * cc : a2T + cr * 64 + 8 * (cc - 8)) + 0 : g2T + cr * 128 + 8 * (cc - 16);
            lw[u] = *(const GAS v4u*)src; }
#pragma unroll
          for (int u = 0; u < 4; ++u) { const int q = F.tid + NTHREADS * u, row = q >> 5, cc = q & 31; *(LAS v4u*)(LORW + row * LORS + 8 * cc) = lw[u]; } }
        v4u pre[4], prq[4];
#define M1_PREFETCH(t0_) do { _Pragma("unroll") for (int it = 0; it < 4; ++it) { const int q = tid2 + 256 * it; if (q < 16 * 56) { const int tok = q / 56, ch = q - tok * 56; const int col = m1_col(ch, h); \
            const size_t row = (size_t)n * T + (t0_) + tok; pre[it] = *(const GAS v4u*)(PR + row * PRW + col); prq[it] = (v4u){0u, 0u, 0u, 0u}; if ((t0_) + tok > 0) prq[it] = *(const GAS v4u*)(PR + (row - 1) * PRW + col); } } } while (0)
        M1_PREFETCH(c * CH);
        float S[4][8];
#pragma unroll
        for (int i = 0; i < 4; ++i)
#pragma unroll
            for (int j = 0; j < 8; ++j) S[i][j] = (wv < 2 && (32 * wv + 4 * rg + i) == (8 * kg + j)) ? 1.0f : 0.0f;
        LDS_BARRIER();
#pragma unroll 1
        for (int sc = 0; sc < 4; ++sc) {
            const int t0 = c * CH + sc * 16;
#pragma unroll
            for (int it = 0; it < 4; ++it) { const int q = tid2 + 256 * it; if (q < 16 * 56) { const int tok = q / 56, ch = q - tok * 56;
                const v4u p8 = pre[it], q8 = prq[it];
                const f32x4 m0 = *(const LAS f32x4*)(MUl + ch * 8), m1 = *(const LAS f32x4*)(MUl + ch * 8 + 4);
                float xm[8];
                { const unsigned pw[4] = {p8.x, p8.y, p8.z, p8.w}, qw[4] = {q8.x, q8.y, q8.z, q8.w};
#pragma unroll
                  for (int e = 0; e < 4; ++e) { const float pl = bflo(pw[e]), ph = bfhi(pw[e]), ql = bflo(qw[e]), qh = bfhi(qw[e]);
                      const float ml = e < 2 ? m0[2 * e] : m1[2 * e - 4], mh = e < 2 ? m0[2 * e + 1] : m1[2 * e - 3];
                      xm[2 * e] = pl + (ql - pl) * ml; xm[2 * e + 1] = ph + (qh - ph) * mh; } }
                if (ch < 24) { LAS float* dst = VW + (ch < 8 ? 4096 : (ch < 16 ? KR_OFF : 5120)) + tok * 64 + 8 * (ch & 7);
                    *(LAS f32x4*)dst = (f32x4){xm[0], xm[1], xm[2], xm[3]}; *(LAS f32x4*)(dst + 4) = (f32x4){xm[4], xm[5], xm[6], xm[7]}; }
                else { const int jc = 8 * (ch - 24);
                    const float sc_ = jc < 64 ? -2.8853900817779268f : -1.4426950408889634f, al_ = jc < 64 ? 2.0f : 1.0f, be_ = jc < 64 ? -1.0f : 0.0f; const bool isid = jc >= 64 && jc < 128;
#pragma unroll
                    for (int e = 0; e < 8; ++e) { const float sg = __builtin_amdgcn_rcpf(1.0f + __builtin_amdgcn_exp2f(sc_ * xm[e])); const float r_ = al_ * sg + be_; xm[e] = isid ? xm[e] : r_; }
                    v4u o; o.x = pk2(xm[0], xm[1]); o.y = pk2(xm[2], xm[3]); o.z = pk2(xm[4], xm[5]); o.w = pk2(xm[6], xm[7]);
                    *(LAS v4u*)(LOR + tok * LORS + jc) = o; }
            } asm volatile("" ::: "memory"); }
            if (sc < 3) M1_PREFETCH(t0 + 16);
            LDS_BARRIER();
            { f32x4 aw = (f32x4){0.f, 0.f, 0.f, 0.f}, aa = aw, ag = aw;
              const LAS bf16* arow = LOR + (lane & 15) * LORS + kq; const LAS bf16* brow = LORW + ci * LORS + kq;
#pragma unroll
              for (int ks = 0; ks < 2; ++ks) { const bf16x8 a = *(const LAS bf16x8*)(arow + 32 * ks), b = *(const LAS bf16x8*)(brow + 32 * ks); aw = __builtin_amdgcn_mfma_f32_16x16x32_bf16(a, b, aw, 0, 0, 0); }
#pragma unroll
              for (int ks = 0; ks < 2; ++ks) { const bf16x8 a = *(const LAS bf16x8*)(arow + 64 + 32 * ks), b = *(const LAS bf16x8*)(brow + 64 + 32 * ks); aa = __builtin_amdgcn_mfma_f32_16x16x32_bf16(a, b, aa, 0, 0, 0); }
#pragma unroll
              for (int ks = 0; ks < 4; ++ks) { const bf16x8 a = *(const LAS bf16x8*)(arow + 128 + 32 * ks), b = *(const LAS bf16x8*)(brow + 128 + 32 * ks); ag = __builtin_amdgcn_mfma_f32_16x16x32_bf16(a, b, ag, 0, 0, 0); }
              const float w0c = CST[192 + ci], a0c = CST[256 + ci];
#pragma unroll
              for (int r = 0; r < 4; ++r) { const int tok = 4 * (lane >> 4) + r;
                  VW[tok * 64 + ci] = __expf(-0.60653065971f * sigmoidf_(w0c + aw[r]));
                  AS[tok * 64 + ci] = sigmoidf_(a0c + aa[r]);
                  GG[((size_t)nh * T + t0 + tok) * 64 + ci] = ag[r]; } }
            LDS_BARRIER();
            { const int tok = tid2 >> 4, i4 = 4 * (tid2 & 15);
              const f32x4 kr = *(const LAS f32x4*)(KR + tok * 64 + i4), as = *(const LAS f32x4*)(AS + tok * 64 + i4), rr = *(const LAS f32x4*)(VR + tok * 64 + i4), vv = *(const LAS f32x4*)(VV + tok * 64 + i4);
              const f32x4 kkw = *(const LAS f32x4*)(CST + i4), kaw = *(const LAS f32x4*)(CST + 64 + i4), rkw = *(const LAS f32x4*)(CST + 128 + i4);
              f32x4 kk = kr * kkw; float sq = (kk[0] * kk[0] + kk[1] * kk[1]) + (kk[2] * kk[2] + kk[3] * kk[3]); sq = sum16(sq);
              kk = kk * __builtin_amdgcn_rsqf(fmaxf(sq, 1e-24f));
              const f32x4 km = kr * ((as - 1.0f) * kaw + 1.0f);
              float bs = (rr[0] * km[0] * rkw[0] + rr[1] * km[1] * rkw[1]) + (rr[2] * km[2] * rkw[2] + rr[3] * km[3] * rkw[3]); bs = sum16(bs);
              *(LAS f32x4*)(VA + tok * 64 + i4) = -kk; *(LAS f32x4*)(VBv + tok * 64 + i4) = kk * as; *(LAS f32x4*)(VK + tok * 64 + i4) = km;
              *(GAS f32x4*)(BON + ((size_t)nh * T + t0 + tok) * 64 + i4) = vv * bs; }
            LDS_BARRIER();
            if (!noscan) { float* yout = RT + (size_t)(wv >> 1) * ((WS_YZ - WS_RT) / 4) + ((size_t)nh * T + t0) * 64 + 32 * (wv & 1) + 4 * rg;
              const int vofs = 32 * (wv & 1) + 4 * rg;
#pragma unroll 1
              for (int st = 0; st < 16; ++st) {
                  float av[8], wv8[8], bv8[8], kv8[8], rv8[8];
                  { const f32x4 t0v = *(const LAS f32x4*)(VA + st * 64 + 8 * kg), t1v = *(const LAS f32x4*)(VA + st * 64 + 8 * kg + 4);
#pragma unroll
                    for (int j = 0; j < 4; ++j) { av[j] = t0v[j]; av[4 + j] = t1v[j]; } }
                  float sa[4];
#pragma unroll
                  for (int i = 0; i < 4; ++i) { float s = fmul_(S[i][0], av[0]);
#pragma unroll
                      for (int j = 1; j < 8; ++j) fmac_(s, S[i][j], av[j]);
                      sa[i] = sum8(s); }
                  { const f32x4 t0v = *(const LAS f32x4*)(VW + st * 64 + 8 * kg), t1v = *(const LAS f32x4*)(VW + st * 64 + 8 * kg + 4);
#pragma unroll
                    for (int j = 0; j < 4; ++j) { wv8[j] = t0v[j]; wv8[4 + j] = t1v[j]; } }
                  { const f32x4 t0v = *(const LAS f32x4*)(VBv + st * 64 + 8 * kg), t1v = *(const LAS f32x4*)(VBv + st * 64 + 8 * kg + 4);
#pragma unroll
                    for (int j = 0; j < 4; ++j) { bv8[j] = t0v[j]; bv8[4 + j] = t1v[j]; } }
                  { const f32x4 t0v = *(const LAS f32x4*)(VR + st * 64 + 8 * kg), t1v = *(const LAS f32x4*)(VR + st * 64 + 8 * kg + 4);
#pragma unroll
                    for (int j = 0; j < 4; ++j) { rv8[j] = t0v[j]; rv8[4 + j] = t1v[j]; } }
                  f32x4 y;
                  if (wv >= 2) {
                      { const f32x4 t0v = *(const LAS f32x4*)(VK + st * 64 + 8 * kg), t1v = *(const LAS f32x4*)(VK + st * 64 + 8 * kg + 4);
#pragma unroll
                        for (int j = 0; j < 4; ++j) { kv8[j] = t0v[j]; kv8[4 + j] = t1v[j]; } }
                      const f32x4 vv = *(const LAS f32x4*)(VV + st * 64 + vofs);
#pragma unroll
                      for (int i = 0; i < 4; ++i) { float yy;
#pragma unroll
                          for (int j = 0; j < 8; ++j) { float sn = fmul_(S[i][j], wv8[j]); fmac_(sn, sa[i], bv8[j]); fmac_(sn, vv[i], kv8[j]); S[i][j] = sn; if (j == 0) yy = fmul_(sn, rv8[0]); else fmac_(yy, sn, rv8[j]); }
                          y[i] = sum8(yy); }
                  } else {
#pragma unroll
                      for (int i = 0; i < 4; ++i) { float yy;
#pragma unroll
                          for (int j = 0; j < 8; ++j) { float sn = fmul_(S[i][j], wv8[j]); fmac_(sn, sa[i], bv8[j]); S[i][j] = sn; if (j == 0) yy = fmul_(sn, rv8[0]); else fmac_(yy, sn, rv8[j]); }
                          y[i] = sum8(yy); }
                  }
                  if (kg == 0) *(GAS f32x4*)(yout + st * 64) = y;
              } }
            LDS_BARRIER();
        }
#undef M1_PREFETCH
        if (!noscan) { float* pc = PC + ((size_t)task * 2 + (wv >> 1)) * 4096 + (size_t)(32 * (wv & 1) + 4 * rg) * 64 + 8 * kg;
#pragma unroll
          for (int i = 0; i < 4; ++i) { *(GAS f32x4*)(pc + i * 64) = (f32x4){S[i][0], S[i][1], S[i][2], S[i][3]}; *(GAS f32x4*)(pc + i * 64 + 4) = (f32x4){S[i][4], S[i][5], S[i][6], S[i][7]}; } }
    }
}

__device__ __forceinline__ void m2_carry(Frame& F, int l) {
    RELAUNDER(F);
    const int nh = F.bid >> 2, qv = F.bid & 3, i = F.tid >> 5, x = F.tid & 31;
    LAS float* Sl = (LAS float*)F.lds;
    LAS float* Pl = (LAS float*)(F.lds + 8192);
    const float* PC = (const float*)(F.ws + WS_PC); float* SC = (float*)(F.ws + WS_SC);
    float zz = 0.f; asm volatile("" : "+v"(zz));
    f32x2 s = (f32x2){zz, zz};
    *(LAS f32x2*)(Sl + i * 64 + 2 * x) = s;
    int cur = 0;
    f32x4 p0, p1; f32x2 z;
    { const float* pc = PC + (size_t)(nh * NCH) * 2 * 4096; p0 = *(const GAS f32x4*)(pc + 8 * F.tid); p1 = *(const GAS f32x4*)(pc + 8 * F.tid + 4); z = *(const GAS f32x2*)(pc + 4096 + (16 * qv + i) * 64 + 2 * x); }
    for (int c = 0; c < NCH; ++c) {
        const int task = nh * NCH + c;
        *(GAS f32x2*)(SC + (size_t)task * 4096 + (16 * qv + i) * 64 + 2 * x) = s;
        *(LAS f32x4*)(Pl + 8 * F.tid) = p0; *(LAS f32x4*)(Pl + 8 * F.tid + 4) = p1;
        LDS_BARRIER();
        f32x2 o = z;
        if (c + 1 < NCH) { const float* pc = PC + (size_t)(task + 1) * 2 * 4096; p0 = *(const GAS f32x4*)(pc + 8 * F.tid); p1 = *(const GAS f32x4*)(pc + 8 * F.tid + 4); z = *(const GAS f32x2*)(pc + 4096 + (16 * qv + i) * 64 + 2 * x); }
        const LAS float* sr = Sl + cur * 1024 + i * 64;
#pragma unroll 8
        for (int k = 0; k < 64; ++k) { const float sv = sr[k]; const f32x2 pp = *(const LAS f32x2*)(Pl + k * 64 + 2 * x); o[0] += sv * pp[0]; o[1] += sv * pp[1]; }
        s = o; cur ^= 1;
        *(LAS f32x2*)(Sl + cur * 1024 + i * 64 + 2 * x) = s;
        LDS_BARRIER();
    }
    const int n = nh / RH, h = nh - n * RH;
    *(GAS f32x2*)(F.out + O_PWKV + ((((size_t)l * NB + n) * RH + h) * 64 + 16 * qv + i) * 64 + 2 * x) = s;
}
__device__ __forceinline__ int crow(int r, int hi) { return (r & 3) + 8 * (r >> 2) + 4 * hi; }
typedef __bf16 bf16x2_t __attribute__((ext_vector_type(2)));
__device__ __forceinline__ unsigned cvtpk_s(float lo, float hi) { f32x2 v = {lo, hi}; bf16x2_t b = __builtin_convertvector(v, bf16x2_t); return __builtin_bit_cast(unsigned, b); }
typedef short v4i16_t __attribute__((ext_vector_type(4)));
__device__ __forceinline__ s16x4 vtr(const LAS unsigned char* p) { return __builtin_bit_cast(s16x4, __builtin_amdgcn_ds_read_tr16_b64_v4i16((LAS v4i16_t*)p)); }
__device__ __forceinline__ void m2_attn_item(Frame& F, int it) {
    const int half = F.wave >> 2, wv = F.wave & 3, tid2 = F.tid & 255, lane = F.lane, l31 = lane & 31, hi = lane >> 5;
    const int unit = it * 2 + half, g = unit >> 9, rem = unit & 511, nh = rem >> 4, idx = rem & 15, n = nh >> 3, h = nh & 7;
    const int dil = g == 0 ? 1 : (g == 1 ? 4 : 16), r = g == 0 ? 0 : (g == 1 ? (idx >> 2) : idx), b = g == 0 ? idx : (g == 1 ? (idx & 3) : 0);
    LAS unsigned char* Vl = F.lds + half * 32768;
    const bf16* QN = (const bf16*)(F.ws + WS_QN); const bf16* KN = (const bf16*)(F.ws + WS_KN); const bf16* VB = (const bf16*)(F.ws + WS_VB);
    const size_t rowbase = (size_t)n * T + r;
    for (int q = tid2; q < 2048; q += 256) { const int key = q >> 3, ch = q & 7, sp = 128 * (b - 1) + key; v4u v = (v4u){0u, 0u, 0u, 0u};
        if (sp >= 0) v = *(const GAS v4u*)(VB + (rowbase + (size_t)dil * sp) * AW + h * 64 + 8 * ch);
        *(LAS v4u*)(Vl + key * 128 + ch * 16) = v; }
    const int sq = 128 * b + 32 * wv + l31;
    bf16x8 qf[4];
    { const bf16* qp = QN + (rowbase + (size_t)dil * sq) * AW + h * 64 + 8 * hi;
#pragma unroll
      for (int ks = 0; ks < 4; ++ks) qf[ks] = *(const GAS bf16x8*)(qp + 16 * ks); }
    const float slope = exp2f(-(float)(h + 1)) * (float)dil;
    f32x16 sc[5];
#pragma unroll
    for (int kt = 0; kt < 5; ++kt) {
        const int kl0 = 32 * wv + 32 * kt;
        int sp = 128 * (b - 1) + kl0 + l31; sp = sp < 0 ? 0 : sp;
        const bf16* kp = KN + (rowbase + (size_t)dil * sp) * AW + h * 64 + 8 * hi;
        f32x16 a;
#pragma unroll
        for (int e = 0; e < 16; ++e) a[e] = 0.f;
#pragma unroll
        for (int ks = 0; ks < 4; ++ks) { const bf16x8 kf = *(const GAS bf16x8*)(kp + 16 * ks); a = __builtin_amdgcn_mfma_f32_32x32x16_bf16(kf, qf[ks], a, 0, 0, 0); }
#pragma unroll
        for (int e = 0; e < 16; ++e) { const int kl = kl0 + crow(e, hi), delta = 128 + 32 * wv + l31 - kl; const bool ok = delta >= 0 && delta <= 128 && (128 * (b - 1) + kl) >= 0;
            a[e] = ok ? a[e] - slope * (float)delta : -INFINITY; }
        sc[kt] = a;
    }
    float m = -INFINITY;
#pragma unroll
    for (int kt = 0; kt < 5; ++kt)
#pragma unroll
        for (int e = 0; e < 16; ++e) m = fmaxf(m, sc[kt][e]);
    m = fmaxf(m, __shfl_xor(m, 32));
    float lsum = 0.f;
#pragma unroll
    for (int kt = 0; kt < 5; ++kt)
#pragma unroll
        for (int e = 0; e < 16; ++e) { const float p = __expf(sc[kt][e] - m); sc[kt][e] = p; lsum += p; }
    lsum += __shfl_xor(lsum, 32);
    __syncthreads();
    f32x16 o[2];
#pragma unroll
    for (int e = 0; e < 16; ++e) { o[0][e] = 0.f; o[1][e] = 0.f; }
    const int i16 = lane & 15, qq = i16 >> 2, pp = i16 & 3, blk = (lane >> 4) & 1;
#pragma unroll
    for (int kt = 0; kt < 5; ++kt) {
        const int kl0 = 32 * wv + 32 * kt;
#pragma unroll
        for (int s2 = 0; s2 < 2; ++s2) {
            v4u pw; pw.x = cvtpk_s(sc[kt][8 * s2], sc[kt][8 * s2 + 1]); pw.y = cvtpk_s(sc[kt][8 * s2 + 2], sc[kt][8 * s2 + 3]); pw.z = cvtpk_s(sc[kt][8 * s2 + 4], sc[kt][8 * s2 + 5]); pw.w = cvtpk_s(sc[kt][8 * s2 + 6], sc[kt][8 * s2 + 7]);
            const bf16x8 pf = __builtin_bit_cast(bf16x8, pw);
#pragma unroll
            for (int dt = 0; dt < 2; ++dt) {
                const LAS unsigned char* base = Vl + (kl0 + 16 * s2 + 4 * hi + qq) * 128 + (32 * dt + 16 * blk + 4 * pp) * 2;
                const s16x4 lo = vtr(base), hh = vtr(base + 8 * 128);
                const bf16x8 vf = (bf16x8){lo[0], lo[1], lo[2], lo[3], hh[0], hh[1], hh[2], hh[3]};
                o[dt] = __builtin_amdgcn_mfma_f32_32x32x16_bf16(vf, pf, o[dt], 0, 0, 0);
            }
        }
    }
    const float inv = 1.0f / lsum;
    float* og = (float*)(F.ws + WS_OG) + ((size_t)g * MP + rowbase + (size_t)dil * sq) * AW + h * 64;
#pragma unroll
    for (int dt = 0; dt < 2; ++dt)
#pragma unroll
        for (int rq = 0; rq < 4; ++rq) *(GAS f32x4*)(og + 32 * dt + 8 * rq + 4 * hi) = (f32x4){o[dt][4 * rq] * inv, o[dt][4 * rq + 1] * inv, o[dt][4 * rq + 2] * inv, o[dt][4 * rq + 3] * inv};
    if (hi == 0) ((float*)(F.ws + WS_LSE))[((size_t)g * MP + rowbase + (size_t)dil * sq) * AH + h] = m + __logf(lsum);
    __syncthreads();
}
__device__ __forceinline__ void ld8f(const bf16* p, float (&o)[8]) { const v4u v = *(const GAS v4u*)p; o[0] = bflo(v.x); o[1] = bfhi(v.x); o[2] = bflo(v.y); o[3] = bfhi(v.y); o[4] = bflo(v.z); o[5] = bfhi(v.z); o[6] = bflo(v.w); o[7] = bfhi(v.w); }
__device__ __forceinline__ void m2_conv_item(Frame& F, int l, int it) {
    if (F.tid >= 384) return;
    const int c8 = F.tid % 96, rs = F.tid / 96, c = 8 * c8;
    const bf16* PR = (const bf16*)(F.ws + WS_PR) + RP; bf16* MIX = (bf16*)(F.ws + WS_MIX);
    const float* cw = inp(F, 26) + (size_t)l * 3 * CW; const float* cb = inp(F, 27) + (size_t)l * CW;
    float w0[8], w1[8], w2[8], bb[8];
#pragma unroll
    for (int e = 0; e < 8; ++e) { w0[e] = cw[c + e]; w1[e] = cw[CW + c + e]; w2[e] = cw[2 * CW + c + e]; bb[e] = cb[c + e]; }
    const int row0 = it * 64 + rs * 16, t00 = row0 & (T - 1);
    float z1[8], z2[8];
#pragma unroll
    for (int e = 0; e < 8; ++e) { z1[e] = 0.f; z2[e] = 0.f; }
    if (t00 >= 1) { float u[8], gc[8]; ld8f(PR + (size_t)(row0 - 1) * PRW + (c), u); ld8f(PR + (size_t)(row0 - 1) * PRW + (2 * CW + c), gc);
#pragma unroll
        for (int e = 0; e < 8; ++e) z1[e] = gc[e] * u[e]; }
    if (t00 >= 2) { float u[8], gc[8]; ld8f(PR + (size_t)(row0 - 2) * PRW + (c), u); ld8f(PR + (size_t)(row0 - 2) * PRW + (2 * CW + c), gc);
#pragma unroll
        for (int e = 0; e < 8; ++e) z2[e] = gc[e] * u[e]; }
    for (int rr = 0; rr < 16; ++rr) { const size_t row = (size_t)row0 + rr; float u[8], gb[8], gc[8], y[8]; ld8f(PR + (size_t)(row) * PRW + (c), u); ld8f(PR + (size_t)(row) * PRW + (CW + c), gb); ld8f(PR + (size_t)(row) * PRW + (2 * CW + c), gc);
#pragma unroll
        for (int e = 0; e < 8; ++e) { const float z0 = gc[e] * u[e]; y[e] = gb[e] * (bb[e] + w0[e] * z2[e] + w1[e] * z1[e] + w2[e] * z0); z2[e] = z1[e]; z1[e] = z0; }
        v4u o; o.x = pk2(y[0], y[1]); o.y = pk2(y[2], y[3]); o.z = pk2(y[4], y[5]); o.w = pk2(y[6], y[7]);
        *(GAS v4u*)(MIX + row * D + AW + RW + c) = o;
        if ((row & (T - 1)) == T - 1) { float* oc = F.out + O_PCV + ((size_t)l * NB + (row >> 11)) * 2 * CW + c;
#pragma unroll
            for (int e = 0; e < 8; ++e) { oc[e] = z2[e]; oc[CW + e] = z1[e]; } }
    }
}
__device__ __forceinline__ void m2_sample_attn(Frame& F, int l, int n) {
    LAS float* P = (LAS float*)F.lds;
    LAS float* QS = P + 1536;
    LAS float* SCO = QS + 8 * 192;
    const u64* accp = sacc(F, l, SA_P) + (size_t)n * MIXP; const float rs = rstdbuf(F, 3 * l + 1)[n];
    for (int c = F.tid; c < 3 * AW; c += NTHREADS) P[c] = fx_dec(accp[dest_row<3>(c)]) * rs;
    __syncthreads();
    float* out = F.out; float* mixs = (float*)(F.ws + WS_MIXS) + ((size_t)l * NS + n) * D;
    const int h = F.wave, lane = F.lane;
    float q = P[h * 64 + lane], k = P[AW + h * 64 + lane], v = P[2 * AW + h * 64 + lane];
    q = q * (1.0f / sqrtf(wave_sum(q * q) * (1.0f / 64.f) + EPS)) * inp(F, 13)[l * 64 + lane];
    k = k * (1.0f / sqrtf(wave_sum(k * k) * (1.0f / 64.f) + EPS)) * inp(F, 14)[l * 64 + lane];
    out[O_SK + ((size_t)l * NS + n) * AW + h * 64 + lane] = k; out[O_SV + ((size_t)l * NS + n) * AW + h * 64 + lane] = v;
    LAS float* qs = QS + h * 192; qs[lane] = q; qs[64 + lane] = k; qs[128 + lane] = v;
    LDS_WAIT(); asm volatile("" ::: "memory");
    const float slope = exp2f(-(float)(h + 1));
    const float* ck = inp(F, 2) + ((size_t)(l * NS + n) * 2048) * AW + h * 64; const float* cv = inp(F, 3) + ((size_t)(l * NS + n) * 2048) * AW + h * 64;
    LAS float* sc = SCO + h * 396;
    float mx = -INFINITY;
#pragma unroll 1
    for (int g = 0; g < 3; ++g) { const int dil = g == 0 ? 1 : (g == 1 ? 4 : 16);
        const int j0 = lane == 0 ? 64 : lane, j1 = lane == 0 ? 128 : lane + 64;
        const float* k0p = ck + (size_t)(2048 - dil * j0) * AW; const float* k1p = ck + (size_t)(2048 - dil * j1) * AW;
        float s0 = 0.f, s1 = 0.f;
#pragma unroll
        for (int d = 0; d < 64; d += 4) { const f32x4 a = *(const GAS f32x4*)(k0p + d), b = *(const GAS f32x4*)(k1p + d); const f32x4 qq = *(const LAS f32x4*)(qs + d);
            s0 += qq[0] * a[0] + qq[1] * a[1] + qq[2] * a[2] + qq[3] * a[3]; s1 += qq[0] * b[0] + qq[1] * b[1] + qq[2] * b[2] + qq[3] * b[3]; }
        s0 = s0 * 0.125f - slope * (float)(dil * j0); s1 = s1 * 0.125f - slope * (float)(dil * j1);
        sc[g * 132 + j0] = s0; sc[g * 132 + j1] = s1; mx = fmaxf(mx, fmaxf(s0, s1));
        if (lane == 0) { float s = 0.f;
#pragma unroll
            for (int d = 0; d < 64; ++d) s += qs[d] * qs[64 + d];
            s *= 0.125f; sc[g * 132] = s; mx = fmaxf(mx, s); }
    }
#pragma unroll
    for (int o = 1; o < 64; o <<= 1) mx = fmaxf(mx, __shfl_xor(mx, o));
    float ls = 0.f;
    for (int g = 0; g < 3; ++g) for (int j = lane; j <= 128; j += 64) { const float pe = __expf(sc[g * 132 + j] - mx); sc[g * 132 + j] = pe; ls += pe; }
    ls = wave_sum(ls);
    LDS_WAIT(); asm volatile("" ::: "memory");
    const int kq = lane >> 4, d4 = 4 * (lane & 15);
    f32x4 acc = (f32x4){0.f, 0.f, 0.f, 0.f};
#pragma unroll 1
    for (int g = 0; g < 3; ++g) { const int dil = g == 0 ? 1 : (g == 1 ? 4 : 16);
        if (kq == 0) acc = acc + *(const LAS f32x4*)(qs + 128 + d4) * sc[g * 132];
#pragma unroll 8
        for (int j = 4 - kq; j <= 128; j += 4) acc = acc + *(const GAS f32x4*)(cv + (size_t)(2048 - dil * j) * AW + d4) * sc[g * 132 + j];
    }
#pragma unroll
    for (int e = 0; e < 4; ++e) { acc[e] += __shfl_xor(acc[e], 16); acc[e] += __shfl_xor(acc[e], 32); }
    if (lane < 16) *(GAS f32x4*)(mixs + h * 64 + d4) = acc * (1.0f / ls);
    __syncthreads();
}
__device__ __forceinline__ void m2_sample_rwkv(Frame& F, int l, int n) {
    LAS float* P = (LAS float*)F.lds;
    LAS float* XM = P + PRW;
    LAS float* LIN = XM + RP;
    LAS float* VEC = LIN + 256;
    const u64* accp = sacc(F, l, SA_P) + (size_t)n * MIXP; const float rs = rstdbuf(F, 3 * l + 1)[n];
    for (int c = F.tid; c < PRW; c += NTHREADS) P[c] = fx_dec(accp[3 * AW + c]) * rs;
    __syncthreads();
    float* out = F.out; float* mixs = (float*)(F.ws + WS_MIXS) + ((size_t)l * NS + n) * D;
    { const float* sh = inp(F, 5) + ((size_t)l * NS + n) * RP; const float* mu = inp(F, 15) + (size_t)l * RP;
      for (int c = F.tid; c < RP; c += NTHREADS) { const float pv = P[c]; const float x = pv + (sh[c] - pv) * mu[c]; XM[c] = x; out[O_SSH + ((size_t)l * NS + n) * RP + c] = pv;
          if (c >= 3 * RW) { const int j = c - 3 * RW; LIN[j] = j < 64 ? 1.0f - 2.0f / (1.0f + __expf(2.0f * x)) : (j < 128 ? x : sigmoidf_(x)); } } }
    __syncthreads();
    const unsigned char* wl = wlayer(F, l);
    const bf16* w2T = (const bf16*)(wl + WL_W2T); const bf16* a2T = (const bf16*)(wl + WL_A2T); const bf16* g2T = (const bf16*)(wl + WL_G2T);
#pragma unroll 1
    for (int h = F.wave; h < RH; h += NWAVES) { RELAUNDER(F); const int lane = F.lane, c = h * 64 + lane;
        v4u ww[8], wa[8], wg[16];
#pragma unroll
        for (int i = 0; i < 8; ++i) { ww[i] = *(const GAS v4u*)(w2T + (size_t)c * 64 + 8 * i); wa[i] = *(const GAS v4u*)(a2T + (size_t)c * 64 + 8 * i); }
#pragma unroll
        for (int i = 0; i < 16; ++i) wg[i] = *(const GAS v4u*)(g2T + (size_t)c * 128 + 8 * i);
        const float* s0 = inp(F, 4) + ((((size_t)l * NS + n) * RH + h) * 64 + lane) * 64;
        f32x4 st[16];
#pragma unroll
        for (int i = 0; i < 16; ++i) st[i] = *(const GAS f32x4*)(s0 + 4 * i);
        float sw = inp(F, 16)[(size_t)l * RW + c], sa = inp(F, 18)[(size_t)l * RW + c], sg = 0.f;
#pragma unroll
        for (int i = 0; i < 8; ++i) { const unsigned w4[4] = {ww[i].x, ww[i].y, ww[i].z, ww[i].w}, a4[4] = {wa[i].x, wa[i].y, wa[i].z, wa[i].w};
#pragma unroll
            for (int e = 0; e < 4; ++e) { sw += LIN[8 * i + 2 * e] * bflo(w4[e]) + LIN[8 * i + 2 * e + 1] * bfhi(w4[e]); sa += LIN[64 + 8 * i + 2 * e] * bflo(a4[e]) + LIN[64 + 8 * i + 2 * e + 1] * bfhi(a4[e]); } }
#pragma unroll
        for (int i = 0; i < 16; ++i) { const unsigned g4[4] = {wg[i].x, wg[i].y, wg[i].z, wg[i].w};
#pragma unroll
            for (int e = 0; e < 4; ++e) sg += LIN[128 + 8 * i + 2 * e] * bflo(g4[e]) + LIN[128 + 8 * i + 2 * e + 1] * bfhi(g4[e]); }
        const float dec = __expf(-0.60653065971f * sigmoidf_(sw)), a = sigmoidf_(sa);
        const float rr = XM[c], kr = XM[RW + c], vr = XM[2 * RW + c];
        float kk = kr * inp(F, 21)[(size_t)l * RW + c]; kk = kk / fmaxf(sqrtf(wave_sum(kk * kk)), 1e-12f);
        const float km = kr * (1.0f + (a - 1.0f) * inp(F, 22)[(size_t)l * RW + c]);
        const float bon = wave_sum(rr * km * inp(F, 23)[(size_t)l * RW + c]);
        LAS float* ve = VEC + h * 320; ve[lane] = -kk; ve[64 + lane] = kk * a; ve[128 + lane] = km; ve[192 + lane] = rr; ve[256 + lane] = dec;
        LDS_WAIT(); asm volatile("" ::: "memory");
        float* so = out + O_SWKV + ((((size_t)l * NS + n) * RH + h) * 64 + lane) * 64;
        float sdot = 0.f;
#pragma unroll
        for (int i = 0; i < 16; ++i) { const f32x4 a4 = *(const LAS f32x4*)(ve + 4 * i); sdot += st[i][0] * a4[0] + st[i][1] * a4[1] + st[i][2] * a4[2] + st[i][3] * a4[3]; }
        float y = 0.f;
#pragma unroll
        for (int i = 0; i < 16; ++i) { const f32x4 b4 = *(const LAS f32x4*)(ve + 64 + 4 * i), k4 = *(const LAS f32x4*)(ve + 128 + 4 * i), r4 = *(const LAS f32x4*)(ve + 192 + 4 * i), w4 = *(const LAS f32x4*)(ve + 256 + 4 * i);
            const f32x4 sn = st[i] * w4 + b4 * sdot + k4 * vr; y += sn[0] * r4[0] + sn[1] * r4[1] + sn[2] * r4[2] + sn[3] * r4[3];
            *(GAS f32x4*)(so + 4 * i) = sn; }
        const float mean = wave_sum(y) * (1.0f / 64.f), dl = y - mean, var = wave_sum(dl * dl) * (1.0f / 64.f);
        const float yn = dl * (1.0f / sqrtf(var + GN_EPS)) * inp(F, 24)[(size_t)l * RW + c] + inp(F, 25)[(size_t)l * RW + c];
        mixs[AW + c] = (yn + bon * vr) * sg;
    }
    RELAUNDER(F);
    { const float* scv = inp(F, 6) + ((size_t)l * NS + n) * 2 * CW; const float* cw = inp(F, 26) + (size_t)l * 3 * CW; const float* cb = inp(F, 27) + (size_t)l * CW;
      for (int c = F.tid; c < CW; c += NTHREADS) { const float u = P[RP + c], gb = P[RP + CW + c], gc = P[RP + 2 * CW + c], z0 = gc * u, z2 = scv[c], z1 = scv[CW + c];
          mixs[AW + RW + c] = gb * (cb[c] + cw[c] * z2 + cw[CW + c] * z1 + cw[2 * CW + c] * z0);
          float* oc = out + O_SCV + ((size_t)l * NS + n) * 2 * CW; oc[c] = z1; oc[CW + c] = z0; } }
    __syncthreads();
}
__device__ __forceinline__ void m2_phase(Frame& F, int l) {
    if (F.bid < 192) m2_carry(F, l);
    constexpr int N_SMP = 2 * NS, N_ATT = 768, N_CONV = MP / 64, N_ITEMS = N_SMP + N_ATT + N_CONV;
    for (;;) {
        __syncthreads();
        if (F.tid == 0) F.MISC[16] = __hip_atomic_fetch_add((unsigned*)(F.ctl + CW_QUEUE + 64 * l), 1u, RLX_AGENT);
        __syncthreads();
        const int it = (int)F.MISC[16];
        if (it >= N_ITEMS) break;
        RELAUNDER(F);
        if (it < N_SMP) { if (it & 1) m2_sample_rwkv(F, l, it >> 1); else m2_sample_attn(F, l, it >> 1); }
        else if (it < N_SMP + N_ATT) m2_attn_item(F, it - N_SMP);
        else m2_conv_item(F, l, it - N_SMP - N_ATT);
    }
}

__device__ __forceinline__ void m3_phase(Frame& F, int l) {
    const int lane = F.lane;
    bf16* MIX = (bf16*)(F.ws + WS_MIX);
    LAS float* RTl = (LAS float*)(F.lds + F.wave * 16384);
    const float* RT = (const float*)(F.ws + WS_RT); const float* YZ = (const float*)(F.ws + WS_YZ); const float* GG = (const float*)(F.ws + WS_GG); const float* BON = (const float*)(F.ws + WS_BON); const float* SC = (const float*)(F.ws + WS_SC);
    for (int task = F.bid * NWAVES + F.wave; task < NTASK; task += F.G * NWAVES) {
        RELAUNDER(F);
        const int nh = task / NCH, c = task - nh * NCH, n = nh / RH, h = nh - n * RH;
        const size_t tb = ((size_t)nh * T + c * CH) * 64;
        float sr[64];
        if (c > 0) {
#pragma unroll
            for (int k = 0; k < 64; k += 4) { const f32x4 s4 = *(const GAS f32x4*)(SC + (size_t)task * 4096 + lane * 64 + k); sr[k] = s4[0]; sr[k + 1] = s4[1]; sr[k + 2] = s4[2]; sr[k + 3] = s4[3]; }
#pragma unroll
            for (int i = 0; i < 16; ++i) *(LAS f32x4*)(RTl + (i * 64 + lane) * 4) = *(const GAS f32x4*)(RT + tb + (size_t)(i * 64 + lane) * 4);
            LDS_WAIT(); asm volatile("" ::: "memory");
        } else {
#pragma unroll
            for (int k = 0; k < 64; ++k) sr[k] = 0.f;
        }
        const float lw = inp(F, 24)[(size_t)l * RW + h * 64 + lane], lb = inp(F, 25)[(size_t)l * RW + h * 64 + lane];
        for (int t8 = 0; t8 < CH; t8 += 8) {
            float yv[8], bv[8], gv[8];
#pragma unroll
            for (int u = 0; u < 8; ++u) { yv[u] = YZ[tb + (t8 + u) * 64 + lane]; bv[u] = BON[tb + (t8 + u) * 64 + lane]; gv[u] = GG[tb + (t8 + u) * 64 + lane]; }
#pragma unroll
            for (int u = 0; u < 8; ++u) { const int t = t8 + u; float y = yv[u];
                if (c > 0) {
#pragma unroll
                    for (int k = 0; k < 64; k += 4) { const f32x4 r4 = *(const LAS f32x4*)(RTl + t * 64 + k); y += sr[k] * r4[0] + sr[k + 1] * r4[1] + sr[k + 2] * r4[2] + sr[k + 3] * r4[3]; } }
                const float mean = wave_sum(y) * (1.0f / 64.f), dl = y - mean, var = wave_sum(dl * dl) * (1.0f / 64.f);
                const float yn = dl * __builtin_amdgcn_rsqf(var + GN_EPS) * lw + lb;
                const float o = (yn + bv[u]) * gv[u];
                MIX[((size_t)n * T + c * CH + t) * D + AW + h * 64 + lane] = (bf16)f2bf(o); }
        }
        LDS_WAIT(); asm volatile("" ::: "memory");
    }
    const float* OG = (const float*)(F.ws + WS_OG); const float* LSE = (const float*)(F.ws + WS_LSE);
    for (int q = F.bid * NTHREADS + F.tid; q < MP * 64; q += F.G * NTHREADS) { const int row = q >> 6, c8 = (q & 63) * 8, h = c8 >> 6;
        const float l0 = LSE[(size_t)row * AH + h], l1 = LSE[((size_t)MP + row) * AH + h], l2 = LSE[((size_t)2 * MP + row) * AH + h];
        const float mx = fmaxf(l0, fmaxf(l1, l2)), e0 = __expf(l0 - mx), e1 = __expf(l1 - mx), e2 = __expf(l2 - mx), inv = 1.0f / (e0 + e1 + e2);
        f32x4 a = (f32x4){0.f, 0.f, 0.f, 0.f}, b = a;
        { const float* p = OG + (size_t)row * AW + c8; a = a + *(const GAS f32x4*)p * (e0 * inv); b = b + *(const GAS f32x4*)(p + 4) * (e0 * inv); }
        { const float* p = OG + ((size_t)MP + row) * AW + c8; a = a + *(const GAS f32x4*)p * (e1 * inv); b = b + *(const GAS f32x4*)(p + 4) * (e1 * inv); }
        { const float* p = OG + ((size_t)2 * MP + row) * AW + c8; a = a + *(const GAS f32x4*)p * (e2 * inv); b = b + *(const GAS f32x4*)(p + 4) * (e2 * inv); }
        v4u o; o.x = pk2(a[0], a[1]); o.y = pk2(a[2], a[3]); o.z = pk2(b[0], b[1]); o.w = pk2(b[2], b[3]);
        *(GAS v4u*)(MIX + (size_t)row * D + c8) = o; }
}
__device__ __forceinline__ void final_phase(Frame& F) {
    const float* xp = xsbuf(F, 3 * (L - 1) + 2); const u64* ac = sacc(F, L - 1, SA_D2);
    for (int i = F.bid * NTHREADS + F.tid; i < NS * D; i += F.G * NTHREADS) F.out[O_YS + i] = xp[i] + 0.5f * fx_dec(ac[i]);
}
}
namespace fk {
struct Args { const float* in[33]; float* out; unsigned char* ws; int ph_lo, ph_hi, flags, pad; };
constexpr int N_PHASES = 1 + 8 * 2 + L * 5 + 1;
__global__ void __launch_bounds__(NTHREADS, 2) mega(Args args) {
    extern __shared__ __attribute__((aligned(16))) unsigned char lds[];
    Frame F;
    F.lds = (LAS unsigned char*)lds;
    F.MISC = (volatile LAS unsigned*)(F.lds + MISC_OFF);
    F.tid = threadIdx.x; F.lane = F.tid & 63; F.wave = __builtin_amdgcn_readfirstlane(F.tid >> 6);
    F.G = gridDim.x; F.bid = blockIdx.x;
    F.ws = args.ws; F.out = args.out; F.ctl = (gu32*)(args.ws + WS_CTL);
    F.ptab = (const LAS unsigned*)(F.lds + PTAB_OFF);
    if (F.tid < 64) F.MISC[F.tid] = 0u;
    if (F.tid < 33) { const unsigned long long pv = (unsigned long long)args.in[F.tid]; ((LAS unsigned*)(F.lds + PTAB_OFF))[2 * F.tid] = (unsigned)pv; ((LAS unsigned*)(F.lds + PTAB_OFF))[2 * F.tid + 1] = (unsigned)(pv >> 32); }
    __syncthreads();
    const int lo = args.ph_lo, hi = args.ph_hi;
    if (F.tid == 0) F.MISC[20] = (unsigned)args.flags;
    __syncthreads();
#define rerun ((F.MISC[20] & 1u) != 0u)
#define sonly ((F.MISC[20] & 4u) != 0u)
    u64* const dummy = (u64*)(args.ws + WS_FAST_END);
    XcdBarrier bar; bar.bar = (unsigned*)(F.ctl + CW_BAR); bar.x = 0; bar.st = nullptr;
    if (hi - lo > 1) bar = xcd_barrier_post((unsigned*)(F.ctl + CW_BAR), F.MISC + 8);
    int ph = 0;
#define PHASE_BEGIN if (ph >= lo && ph < hi) { { int t_ = threadIdx.x; asm volatile("" : "+v"(t_)); F.tid = t_; F.lane = t_ & 63; F.wave = __builtin_amdgcn_readfirstlane(t_ >> 6); int b_ = blockIdx.x; asm volatile("" : "+s"(b_)); F.bid = b_; }
#define PHASE_END   if (ph + 1 < hi) xcd_barrier(bar); } ++ph;
    bf16* XB = (bf16*)(F.ws + WS_XB); bf16* HB = (bf16*)(F.ws + WS_H); bf16* MIX = (bf16*)(F.ws + WS_MIX);
    float* X = F.out + O_Y;

    PHASE_BEGIN p0_prologue(F); PHASE_END

    for (int s = 0; s < 2 * L; ++s) {
        const int l = s >> 1, second = s & 1;
        unsigned char* wl = wlayer(F, l);
        PHASE_BEGIN
            const int j = 3 * l + (second ? 2 : 0);
            const float* xprev = j == 0 ? inp(F, 1) : (j == 1 ? inp(F, 1) : xsbuf(F, j - 1));
            const u64* accprev = j == 0 ? nullptr : (second ? sacc(F, l, SA_O) : sacc(F, l - 1, SA_D2));
            if (!rerun) sample_proj(F, j, xprev, accprev, second ? 1.0f : 0.5f, (const bf16*)(wl + (second ? WL_GU2 : WL_GU1)), NGU, sonly ? dummy : sacc(F, l, second ? SA_GU2 : SA_GU1), (MP / 256) * (NGU / 256) - 5 * 256);
            if (!sonly) {
            pg8::Gemm g{XB, (const bf16*)(wl + (second ? WL_GU2 : WL_GU1)), MP, NGU, D}; pg8::StaticOrder S; S.init(MP, NGU, F.G, F.bid);
            pg8::EpiSwiglu E{HB, ssarr(F, j), FF};
            pg8::gemm_phase<pg8::EpiSwiglu, pg8::StaticOrder, true, true>(F.lds, g, S, E, F.tid);
            }
        PHASE_END
        PHASE_BEGIN
            const int j = 3 * l + (second ? 2 : 0);
            if (!rerun) sample_down(F, sacc(F, l, second ? SA_GU2 : SA_GU1), rstdbuf(F, j), (const bf16*)(wl + (second ? WL_D2 : WL_D1)), sonly ? dummy : sacc(F, l, second ? SA_D2 : SA_D1));
            if (!sonly) {
            pg8::Gemm g{HB, (const bf16*)(wl + (second ? WL_D2 : WL_D1)), MP, D, FF}; pg8::StaticOrder S; S.init(MP, D, F.G, F.bid);
            u64* ssn = second ? (l + 1 < L ? ssarr(F, 3 * (l + 1)) : nullptr) : ssarr(F, 3 * l + 1);
            pg8::EpiResid E{X, XB, rerun ? nullptr : ssn, rerun ? 0.0f : 0.5f};
            pg8::gemm_phase<pg8::EpiResid, pg8::StaticOrder, true, true>(F.lds, g, S, E, F.tid);
            }
        PHASE_END
        if (!second) {
            PHASE_BEGIN
                const int j = 3 * l + 1;
                if (!rerun) sample_proj(F, j, l == 0 ? inp(F, 1) : xsbuf(F, j - 1), sacc(F, l, SA_D1), 0.5f, (const bf16*)(wl + WL_IN), MIXP, sacc(F, l, SA_P), (MP / 256) * (MIXP / 256) - 3 * 256);
                pg8::Gemm g{XB, (const bf16*)(wl + WL_IN), MP, MIXP, D}; pg8::StaticOrder S; S.init(MP, MIXP, F.G, F.bid);
                static_assert(WS_KN - WS_QN == WS_VB - WS_KN, "QN | KN | VB equally spaced");
                pg8::EpiWin E{ssarr(F, j), (bf16*)(F.ws + WS_QN), (bf16*)(F.ws + WS_PR), F.out + O_PK + (size_t)l * MP * AW, F.out + O_PSH + (size_t)l * NB * RP,
                              inp(F, 13) + l * 64, inp(F, 14) + l * 64, (WS_KN - WS_QN) / 2, O_PV - O_PK};
                pg8::gemm_phase<pg8::EpiWin, pg8::StaticOrder, true, true>(F.lds, g, S, E, F.tid);
            PHASE_END
            PHASE_BEGIN m1_phase(F, l, (F.MISC[20] & 2u) != 0u); PHASE_END
            PHASE_BEGIN m2_phase(F, l); PHASE_END
            PHASE_BEGIN m3_phase(F, l); PHASE_END
            PHASE_BEGIN
                if (!rerun) sample_wout(F, (const float*)(F.ws + WS_MIXS) + (size_t)l * NS * D, (const bf16*)(wl + WL_OUT), sacc(F, l, SA_O));
                pg8::Gemm g{MIX, (const bf16*)(wl + WL_OUT), MP, D, D}; pg8::StaticOrder S; S.init(MP, D, F.G, F.bid);
                pg8::EpiResid E{X, XB, rerun ? nullptr : ssarr(F, 3 * l + 2), rerun ? 0.0f : 1.0f};
                pg8::gemm_phase<pg8::EpiResid, pg8::StaticOrder, true, true>(F.lds, g, S, E, F.tid);
            PHASE_END
        }
    }
    PHASE_BEGIN final_phase(F); PHASE_END
#undef rerun
#undef sonly
#undef PHASE_BEGIN
#undef PHASE_END
}

static int g_grid = 0;
static bool fast_setup() {
    if (g_grid != 0) return g_grid > 0;
    int dev = 0, cus = 0, per_cu = 0;
    if (hipGetDevice(&dev) != hipSuccess || hipDeviceGetAttribute(&cus, hipDeviceAttributeMultiprocessorCount, dev) != hipSuccess) { fprintf(stderr, "fast_setup: device query failed\n"); g_grid = -1; return false; }
    if (hipFuncSetAttribute((const void*)mega, hipFuncAttributeMaxDynamicSharedMemorySize, LDS_BYTES) != hipSuccess) { fprintf(stderr, "fast_setup: hipFuncSetAttribute failed\n"); g_grid = -1; return false; }
    if (hipOccupancyMaxActiveBlocksPerMultiprocessor(&per_cu, (const void*)mega, NTHREADS, LDS_BYTES) != hipSuccess || per_cu < 1) fprintf(stderr, "fast_setup: occupancy query reports %d blocks per CU\n", per_cu);
    (void)hipGetLastError();
    g_grid = cus;
    fprintf(stderr, "fast_setup: grid %d, occupancy %d\n", g_grid, per_cu);
    return true;
}
static void launch_range(void* const* d_in, float* out, void* d_ws, int lo, int hi, hipStream_t stream, int flags = 0) {
    Args a; memset(&a, 0, sizeof(a));
    for (int i = 0; i < 33; ++i) a.in[i] = (const float*)d_in[i];
    a.out = out; a.ws = (unsigned char*)d_ws; a.ph_lo = lo; a.ph_hi = hi; a.flags = flags;
    hipLaunchKernelGGL(mega, dim3(g_grid), dim3(NTHREADS), LDS_BYTES, stream, a);
    const hipError_t le = hipPeekAtLastError();
    if (le != hipSuccess) fprintf(stderr, "launch_range [%d,%d) failed: %s\n", lo, hi, hipGetErrorName(le));
}
}
#ifndef KMODE
#define KMODE 1
#endif
#ifndef PROBE_ONE_LAUNCH
#define PROBE_ONE_LAUNCH 0
#endif
extern "C" void kernel_launch(void* const* d_in, const int* in_sizes, int n_in, void* d_out, int out_size, void* d_ws, size_t ws_size, hipStream_t stream) {
    constexpr size_t MiB = 1u << 20;
    if (n_in != 33 || out_size != (int)fk::O_END || ws_size < fk::WS_FAST_END) { fprintf(stderr, "kernel_launch: unexpected sizes n_in %d out %d ws %zu\n", n_in, out_size, ws_size); return; }
    if (!fk::fast_setup()) return;
#if KMODE == 2
    constexpr size_t OFF_OUT2 = 1137 * MiB, OFF_SNAP = 1340 * MiB, OFF_FMIX = 1405 * MiB, OFF_END = 1440 * MiB;
    static_assert(OFF_OUT2 >= fk::WS_FAST_END && OFF_OUT2 + fk::O_END * 4 <= OFF_SNAP && OFF_SNAP + (size_t)nv::R * 2048 * 4 <= OFF_FMIX && OFF_FMIX + (size_t)8192 * 2048 * 2 <= OFF_END, "probe map");
    if (ws_size < OFF_END) { fprintf(stderr, "kernel_launch: PROBE needs %zu bytes of workspace, got %zu\n", (size_t)OFF_END, ws_size); return; }
    float* out2 = (float*)((char*)d_ws + OFF_OUT2); float* snap = (float*)((char*)d_ws + OFF_SNAP); unsigned short* fmix = (unsigned short*)((char*)d_ws + OFF_FMIX);
    nv::forward(d_in, (float*)d_out, (float*)d_ws, stream, snap);
    float* fout = out2;
#else
    float* fout = (float*)d_out;
#endif
    hipMemsetAsync((char*)d_ws + fk::WS_CTL, 0, fk::CTL_ZERO_BYTES, stream);
#ifndef REP_CLASS
#define REP_CLASS 0
#endif
#ifndef REP_FLAGS
#define REP_FLAGS 1
#endif
#ifndef REP_COUNT
#define REP_COUNT 1
#endif
#if KMODE == 0 || (KMODE == 2 && PROBE_ONE_LAUNCH)
    fk::launch_range(d_in, fout, d_ws, 0, fk::N_PHASES, stream);
#if KMODE == 2
#endif
#else
    for (int p = 0; p < fk::N_PHASES; ++p) {
        fk::launch_range(d_in, fout, d_ws, p, p + 1, stream);
#if KMODE == 3
        {
            int cls = -1, layer = 0;
            if (p == 0) cls = 0; else if (p < fk::N_PHASES - 1) { const int q = (p - 1) % 9; layer = (p - 1) / 9; cls = q == 0 ? 1 : q == 1 ? 2 : q == 2 ? 3 : q == 3 ? 4 : q == 4 ? 5 : q == 5 ? 6 : q == 6 ? 7 : q == 7 ? 1 : 2; }
            if (cls == REP_CLASS) { for (int r = 0; r < REP_COUNT; ++r) {
                if (cls == 5) hipMemsetAsync((char*)d_ws + fk::WS_CTL + (fk::CW_QUEUE + 64 * layer) * 4, 0, 4, stream);
                fk::launch_range(d_in, fout, d_ws, p, p + 1, stream, REP_FLAGS); } }
        }
#endif
#if KMODE == 2
        if (p == 1 + 2 + 4 - 1) hipMemcpyAsync(fmix, (char*)d_ws + fk::WS_MIX, (size_t)8192 * 2048 * 2, hipMemcpyDeviceToDevice, stream);
#endif
    }
#endif
#if KMODE == 2
    {   float* slots = (float*)((char*)d_ws + fk::WS_CTL) + 12288;
        const float* o = (const float*)d_out; int s = 0;
        auto cmpo = [&](size_t off, size_t n) { pb::cmp(false, out2 + off, n, o + off, n, 1, (int)n, slots, s++, stream); };
        for (int l = 0; l < 4; ++l) {
            cmpo(fk::O_PK + (size_t)l * 8192 * 512, (size_t)8192 * 512); cmpo(fk::O_PV + (size_t)l * 8192 * 512, (size_t)8192 * 512);
            cmpo(fk::O_SK + (size_t)l * 8 * 512, 8 * 512); cmpo(fk::O_SV + (size_t)l * 8 * 512, 8 * 512);
            cmpo(fk::O_PSH + (size_t)l * 4 * 2560, 4 * 2560); cmpo(fk::O_SSH + (size_t)l * 8 * 2560, 8 * 2560);
            cmpo(fk::O_PCV + (size_t)l * 4 * 1536, 4 * 1536); cmpo(fk::O_SCV + (size_t)l * 8 * 1536, 8 * 1536);
            cmpo(fk::O_PWKV + (size_t)l * 4 * 12 * 4096, (size_t)4 * 12 * 4096); cmpo(fk::O_SWKV + (size_t)l * 8 * 12 * 4096, (size_t)8 * 12 * 4096);
            if (l == 0) {
#if !PROBE_ONE_LAUNCH
                pb::cmp(true, fmix, 2048, snap, 2048, 8192, 512, slots, s++, stream);
                pb::cmp(true, fmix + 512, 2048, snap + 512, 2048, 8192, 768, slots, s++, stream);
                pb::cmp(true, fmix + 1280, 2048, snap + 1280, 2048, 8192, 768, slots, s++, stream);
#else
                s += 3;
#endif
                pb::cmp(false, (const float*)((char*)d_ws + fk::WS_MIXS), 2048, snap + (size_t)8192 * 2048, 2048, 8, 2048, slots, s++, stream);
            }
        }
        cmpo(fk::O_Y, (size_t)8192 * 2048); cmpo(fk::O_YS, 8 * 2048);
        pb::k_encode<<<1, 256, 0, stream>>>(slots, s, (float*)d_out + fk::O_YS, 8 * 2048, 1e-3f);
    }
#endif
}
```
